# Optimizing an MI355X kernel written in HIP

```python
import jax, jax.numpy as jnp
from jax import lax
import numpy as np

D_MODEL = 1024
BATCH = 8
SEQ = 2048
DEPTH = 2
DEC_BATCH = 128
DEC_SEQ = 8
PAST_LEN = 16384
PAGE_SIZE = 128

N_META = 16
EPS = 1e-6
D_FF = 2816
N_BRANCH = 4
BRANCH_WIDTH = 256

DN_HEADS = 4
DN_DK = 64
DN_DV = 64
DN_QK = DN_HEADS * DN_DK
DN_VW = DN_HEADS * DN_DV
DN_CONV = 4
DN_CHUNK = 64

S5_WIDTH = 256
S5_GROUP = 16
S5_GROUPS = S5_WIDTH // S5_GROUP
S5_STATE = 64

LRU_WIDTH = 256
LRU_BLOCKS = 4
LRU_BLOCK = LRU_WIDTH // LRU_BLOCKS
LRU_CONV = 4
LRU_C = 8.0

CV_WIDTH = 256
CV_KERNEL = 31

IN_SIZES = (DN_QK, DN_QK, DN_VW, DN_VW, DN_HEADS, DN_HEADS, S5_WIDTH, LRU_WIDTH, LRU_WIDTH, CV_WIDTH, CV_WIDTH, N_BRANCH * D_MODEL)
N_IN = 2 * DN_QK + 2 * DN_VW + 2 * DN_HEADS + S5_WIDTH + 2 * LRU_WIDTH + 2 * CV_WIDTH + N_BRANCH * D_MODEL

kernel_name = 'hybrid_gated_parallel_decoder_step'


def rmsnorm(x, g):
    xf = x.astype(jnp.float32)
    y = xf * lax.rsqrt(jnp.mean(xf * xf, axis=-1, keepdims=True) + EPS)
    return (y * g.astype(jnp.float32)).astype(x.dtype)


def layernorm(x, g, b):
    xf = x.astype(jnp.float32)
    xc = xf - jnp.mean(xf, axis=-1, keepdims=True)
    y = xc * lax.rsqrt(jnp.mean(xc * xc, axis=-1, keepdims=True) + EPS)
    return (y * g.astype(jnp.float32) + b.astype(jnp.float32)).astype(x.dtype)


def l2norm(x):
    return x * lax.rsqrt(jnp.sum(x * x, axis=-1, keepdims=True) + EPS)


def swiglu(x, w_gu, w_down):
    gate, up = jnp.split(x @ w_gu, 2, axis=-1)
    return (jax.nn.silu(gate) * up) @ w_down


def causal_dwconv(buf, x, w):
    k_width, ch = w.shape
    xf = jnp.concatenate([buf.astype(x.dtype), x], axis=1)
    y = lax.conv_general_dilated(xf, w[:, None, :].astype(x.dtype), window_strides=(1,), padding='VALID',
                                 dimension_numbers=('NWC', 'WIO', 'NWC'), feature_group_count=ch)
    return y, xf[:, xf.shape[1] - (k_width - 1):]


def linear_scan(a, b):
    def combine(e1, e2):
        a1, b1 = e1
        a2, b2 = e2
        return a1 * a2, a2 * b1 + b2
    return lax.associative_scan(combine, (a, b), axis=1)[1]


def to_chunks(a, n, c):
    bsz, _, h = a.shape[:3]
    a = a.reshape(bsz, n, c, h, *a.shape[3:])
    return jnp.moveaxis(jnp.moveaxis(a, 1, 0), 3, 2)


def gated_delta_rule(q, k, v, g, beta, s0):
    bsz, t, h, dk = q.shape
    dv = v.shape[-1]
    c = min(DN_CHUNK, t)
    pad = (-t) % c
    n = (t + pad) // c

    def lpad(a):
        return jnp.pad(a, [(0, 0), (pad, 0)] + [(0, 0)] * (a.ndim - 2))

    qc = to_chunks(lpad(q * dk ** -0.5), n, c)
    kc = to_chunks(lpad(k), n, c)
    vc = to_chunks(lpad(v), n, c)
    bc = to_chunks(lpad(beta), n, c)
    gc = jnp.cumsum(to_chunks(lpad(g), n, c), axis=-1)
    causal = jnp.tril(jnp.ones((c, c), bool))
    strict = jnp.tril(jnp.ones((c, c), bool), -1)
    diff = gc[..., :, None] - gc[..., None, :]
    decay = jnp.where(causal, jnp.exp(jnp.where(causal, diff, 0.0)), 0.0)
    kb = kc * bc[..., None]
    lower = jnp.where(strict, jnp.einsum('nbhid,nbhjd->nbhij', kb, kc) * decay, 0.0)
    rhs = jnp.concatenate([vc * bc[..., None], kb * jnp.exp(gc)[..., None]], axis=-1)
    sol = lax.linalg.triangular_solve(lower + jnp.eye(c, dtype=q.dtype), rhs, left_side=True, lower=True)
    u_c, w_c = sol[..., :dv], sol[..., dv:]
    intra = jnp.where(causal, jnp.einsum('nbhid,nbhjd->nbhij', qc, kc) * decay, 0.0)

    def step(s, inp):
        qi, ki, ui, wi, ai, gi = inp
        v_new = ui - jnp.einsum('bhck,bhkv->bhcv', wi, s)
        o = (jnp.einsum('bhck,bhkv->bhcv', qi * jnp.exp(gi)[..., None], s)
             + jnp.einsum('bhij,bhjv->bhiv', ai, v_new))
        g_last = gi[..., -1]
        k_dec = ki * jnp.exp(g_last[..., None] - gi)[..., None]
        s = s * jnp.exp(g_last)[..., None, None] + jnp.einsum('bhck,bhcv->bhkv', k_dec, v_new)
        return s, o

    s_fin, o = lax.scan(step, s0, (qc, kc, u_c, w_c, intra, gc))
    o = jnp.moveaxis(jnp.moveaxis(o, 2, 3), 0, 1).reshape(bsz, n * c, h, dv)[:, pad:]
    return o, s_fin


def delta_branch(q_in, k_in, v_in, z, b_in, a_in, conv_buf, s0, conv_w, a_log, dt_bias, norm_g):
    bsz, t, _ = q_in.shape
    f32 = jnp.float32
    qkv, new_buf = causal_dwconv(conv_buf, jnp.concatenate([q_in, k_in, v_in], axis=-1), conv_w)
    qkv = jax.nn.silu(qkv.astype(f32))
    q, k, v = jnp.split(qkv, [DN_QK, 2 * DN_QK], axis=-1)
    q = l2norm(q.reshape(bsz, t, DN_HEADS, DN_DK))
    k = l2norm(k.reshape(bsz, t, DN_HEADS, DN_DK))
    v = v.reshape(bsz, t, DN_HEADS, DN_DV)
    beta = jax.nn.sigmoid(b_in.astype(f32))
    g = -jnp.exp(a_log.astype(f32)) * jax.nn.softplus(a_in.astype(f32) + dt_bias.astype(f32))
    o, s_new = gated_delta_rule(q, k, v, g, beta, s0.astype(f32))
    o = o * lax.rsqrt(jnp.mean(o * o, axis=-1, keepdims=True) + EPS) * norm_g.astype(f32)
    o = o * jax.nn.silu(z.astype(f32).reshape(bsz, t, DN_HEADS, DN_DV))
    return o.reshape(bsz, t, DN_VW).astype(q_in.dtype), new_buf, s_new.astype(s0.dtype)


def s5_branch(u, h0_re, h0_im, lam_re, lam_im, log_step, b_re, b_im, c_re, c_im, d_skip, w_glu, b_glu):
    bsz, t, _ = u.shape
    f32 = jnp.float32
    uf = u.astype(f32).reshape(bsz, t, S5_GROUPS, S5_GROUP)
    lam_re = lam_re.astype(f32)
    lam_im = lam_im.astype(f32)
    dt = jnp.exp(log_step.astype(f32))[:, None]
    mag = jnp.exp(lam_re * dt)
    lb_re = mag * jnp.cos(lam_im * dt)
    lb_im = mag * jnp.sin(lam_im * dt)
    den = lam_re * lam_re + lam_im * lam_im
    cf_re = ((lb_re - 1.0) * lam_re + lb_im * lam_im) / den
    cf_im = (lb_im * lam_re - (lb_re - 1.0) * lam_im) / den
    bu_re = jnp.einsum('btgc,gpc->btgp', uf, b_re.astype(f32))
    bu_im = jnp.einsum('btgc,gpc->btgp', uf, b_im.astype(f32))
    x_re = cf_re * bu_re - cf_im * bu_im
    x_im = cf_re * bu_im + cf_im * bu_re
    h0r = h0_re.astype(f32)
    h0i = h0_im.astype(f32)
    x_re = x_re.at[:, 0].add(lb_re * h0r - lb_im * h0i)
    x_im = x_im.at[:, 0].add(lb_re * h0i + lb_im * h0r)
    a_re = jnp.broadcast_to(lb_re, x_re.shape)
    a_im = jnp.broadcast_to(lb_im, x_im.shape)

    def combine(e1, e2):
        a1r, a1i, b1r, b1i = e1
        a2r, a2i, b2r, b2i = e2
        return (a1r * a2r - a1i * a2i, a1r * a2i + a1i * a2r,
                a2r * b1r - a2i * b1i + b2r, a2r * b1i + a2i * b1r + b2i)

    _, _, h_re, h_im = lax.associative_scan(combine, (a_re, a_im, x_re, x_im), axis=1)
    y = (jnp.einsum('btgp,gcp->btgc', h_re, c_re.astype(f32)) - jnp.einsum('btgp,gcp->btgc', h_im, c_im.astype(f32))
         + d_skip.astype(f32).reshape(S5_GROUPS, S5_GROUP) * uf)
    y = jax.nn.gelu(y.reshape(bsz, t, S5_WIDTH))
    ga, gb = jnp.split(y @ w_glu.astype(f32) + b_glu.astype(f32), 2, axis=-1)
    out = ga * jax.nn.sigmoid(gb)
    return out.astype(u.dtype), h_re[:, -1].astype(h0_re.dtype), h_im[:, -1].astype(h0_im.dtype)


def lru_branch(x_in, gate_in, conv_buf, h0, conv_w, conv_b, w_a, b_a, w_x, b_x, lam):
    bsz, t, _ = x_in.shape
    f32 = jnp.float32
    xc, new_buf = causal_dwconv(conv_buf, x_in, conv_w)
    xf = xc.astype(f32) + conv_b.astype(f32)
    xb = xf.reshape(bsz, t, LRU_BLOCKS, LRU_BLOCK)
    r = jax.nn.sigmoid(jnp.einsum('btnc,ncd->btnd', xb, w_a.astype(f32)).reshape(bsz, t, LRU_WIDTH) + b_a.astype(f32))
    i = jax.nn.sigmoid(jnp.einsum('btnc,ncd->btnd', xb, w_x.astype(f32)).reshape(bsz, t, LRU_WIDTH) + b_x.astype(f32))
    log_a = -LRU_C * r * jax.nn.softplus(-lam.astype(f32))
    a = jnp.exp(log_a)
    b = jnp.sqrt(-jnp.expm1(2.0 * log_a)) * (i * xf)
    b = b.at[:, 0].add(a[:, 0] * h0.astype(f32))
    h = linear_scan(a, b)
    out = h * jax.nn.gelu(gate_in.astype(f32))
    return out.astype(x_in.dtype), new_buf, h[:, -1].astype(h0.dtype)


def conv_branch(val, gate, conv_buf, conv_w, conv_b, ln_g, ln_b):
    glu = val * jax.nn.sigmoid(gate)
    y, new_buf = causal_dwconv(conv_buf, glu, conv_w)
    y = layernorm(y + conv_b.astype(y.dtype), ln_g, ln_b)
    return jax.nn.silu(y), new_buf


def decoder_layer(x, st, p):
    s_dn, s_dnc, s_re, s_im, s_lru, s_lruc, s_cv = st
    x = x + 0.5 * swiglu(rmsnorm(x, p['ffn1_norm']), p['ffn1_w_gu'], p['ffn1_w_down'])
    u = rmsnorm(x, p['mix_norm'])
    z = u @ p['w_in']
    dq, dk, dv, dz, db, da, su, lx, lg, cval, cgate, zg = jnp.split(z, np.cumsum(IN_SIZES)[:-1].tolist(), axis=-1)
    oa, n_dnc, n_dn = delta_branch(dq, dk, dv, dz, db, da, s_dnc, s_dn, p['dn_conv_w'], p['dn_a_log'],
                                   p['dn_dt_bias'], p['dn_norm'])
    ob, n_re, n_im = s5_branch(su, s_re, s_im, p['s5_lam_re'], p['s5_lam_im'], p['s5_log_step'], p['s5_b_re'],
                               p['s5_b_im'], p['s5_c_re'], p['s5_c_im'], p['s5_d'], p['s5_w_glu'], p['s5_b_glu'])
    oc, n_lruc, n_lru = lru_branch(lx, lg, s_lruc, s_lru, p['lru_conv_w'], p['lru_conv_b'], p['lru_w_a'],
                                   p['lru_b_a'], p['lru_w_x'], p['lru_b_x'], p['lru_lam'])
    od, n_cv = conv_branch(cval, cgate, s_cv, p['cv_conv_w'], p['cv_conv_b'], p['cv_ln_g'], p['cv_ln_b'])
    branches = jnp.stack([oa, ob, oc, od], axis=-2)
    proj = jnp.einsum('btnc,ncd->btnd', branches, p['w_branch'])
    gates = jax.nn.sigmoid(zg.reshape(*zg.shape[:-1], N_BRANCH, D_MODEL))
    x = x + jnp.sum(gates * proj, axis=-2) @ p['w_out']
    x = x + 0.5 * swiglu(rmsnorm(x, p['ffn2_norm']), p['ffn2_w_gu'], p['ffn2_w_down'])
    return x, (n_dn, n_dnc, n_re, n_im, n_lru, n_lruc, n_cv)


def empty_state(batch, dtype):
    return (jnp.zeros((batch, DN_HEADS, DN_DK, DN_DV), dtype),
            jnp.zeros((batch, DN_CONV - 1, 2 * DN_QK + DN_VW), dtype),
            jnp.zeros((batch, S5_GROUPS, S5_STATE), dtype),
            jnp.zeros((batch, S5_GROUPS, S5_STATE), dtype),
            jnp.zeros((batch, LRU_WIDTH), dtype),
            jnp.zeros((batch, LRU_CONV - 1, LRU_WIDTH), dtype),
            jnp.zeros((batch, CV_KERNEL - 1, CV_WIDTH), dtype))


def setup_inputs(seed: int = 0) -> dict:
    key = jax.random.key(seed)
    ks = iter(jax.random.split(key, 64))

    def nrm(shape, scale):
        return scale * jax.random.normal(next(ks), shape, jnp.float32)

    def unif(shape, lo, hi):
        return jax.random.uniform(next(ks), shape, jnp.float32, lo, hi)

    L = DEPTH
    cw = 2 * DN_QK + DN_VW
    dt = jnp.exp(unif((L, DN_HEADS), float(np.log(1e-3)), float(np.log(1e-1))))
    a0 = unif((L, LRU_WIDTH), 0.9, 0.999) ** (1.0 / LRU_C)
    lam_im = jnp.broadcast_to(jnp.pi * jnp.arange(S5_STATE, dtype=jnp.float32), (L, S5_GROUPS, S5_STATE))
    return {
        'x_prompt': nrm((BATCH, SEQ, D_MODEL), 1.0),
        'x_sample': nrm((DEC_BATCH, DEC_SEQ, D_MODEL), 1.0),
        'state_delta': nrm((L, DEC_BATCH, DN_HEADS, DN_DK, DN_DV), 0.1),
        'state_delta_conv': nrm((L, DEC_BATCH, DN_CONV - 1, cw), 1.0),
        'state_s5_re': nrm((L, DEC_BATCH, S5_GROUPS, S5_STATE), 0.1),
        'state_s5_im': nrm((L, DEC_BATCH, S5_GROUPS, S5_STATE), 0.1),
        'state_lru': nrm((L, DEC_BATCH, LRU_WIDTH), 0.5),
        'state_lru_conv': nrm((L, DEC_BATCH, LRU_CONV - 1, LRU_WIDTH), 1.0),
        'state_conv': nrm((L, DEC_BATCH, CV_KERNEL - 1, CV_WIDTH), 0.5),
        'meta_tokens': nrm((N_META, D_MODEL), 1.0),
        'ffn1_norm': 1.0 + nrm((L, D_MODEL), 0.01),
        'ffn1_w_gu': nrm((L, D_MODEL, 2 * D_FF), D_MODEL ** -0.5),
        'ffn1_w_down': nrm((L, D_FF, D_MODEL), D_FF ** -0.5),
        'mix_norm': 1.0 + nrm((L, D_MODEL), 0.01),
        'w_in': nrm((L, D_MODEL, N_IN), D_MODEL ** -0.5),
        'dn_conv_w': nrm((L, DN_CONV, cw), 0.5),
        'dn_a_log': jnp.log(unif((L, DN_HEADS), 1.0, 16.0)),
        'dn_dt_bias': dt + jnp.log(-jnp.expm1(-dt)),
        'dn_norm': 1.0 + nrm((L, DN_DV), 0.01),
        's5_lam_re': -0.5 + nrm((L, S5_GROUPS, S5_STATE), 0.01),
        's5_lam_im': lam_im + nrm((L, S5_GROUPS, S5_STATE), 0.01),
        's5_log_step': unif((L, S5_GROUPS), float(np.log(1e-3)), float(np.log(1e-1))),
        's5_b_re': nrm((L, S5_GROUPS, S5_STATE, S5_GROUP), (2.0 * S5_GROUP) ** -0.5),
        's5_b_im': nrm((L, S5_GROUPS, S5_STATE, S5_GROUP), (2.0 * S5_GROUP) ** -0.5),
        's5_c_re': nrm((L, S5_GROUPS, S5_GROUP, S5_STATE), 0.5),
        's5_c_im': nrm((L, S5_GROUPS, S5_GROUP, S5_STATE), 0.5),
        's5_d': nrm((L, S5_WIDTH), 1.0),
        's5_w_glu': nrm((L, S5_WIDTH, 2 * S5_WIDTH), S5_WIDTH ** -0.5),
        's5_b_glu': nrm((L, 2 * S5_WIDTH), 0.01),
        'lru_conv_w': nrm((L, LRU_CONV, LRU_WIDTH), 0.5),
        'lru_conv_b': nrm((L, LRU_WIDTH), 0.01),
        'lru_w_a': nrm((L, LRU_BLOCKS, LRU_BLOCK, LRU_BLOCK), LRU_BLOCK ** -0.5),
        'lru_b_a': nrm((L, LRU_WIDTH), 0.01),
        'lru_w_x': nrm((L, LRU_BLOCKS, LRU_BLOCK, LRU_BLOCK), LRU_BLOCK ** -0.5),
        'lru_b_x': nrm((L, LRU_WIDTH), 0.01),
        'lru_lam': jnp.log(a0) - jnp.log1p(-a0),
        'cv_conv_w': nrm((L, CV_KERNEL, CV_WIDTH), CV_KERNEL ** -0.5),
        'cv_conv_b': nrm((L, CV_WIDTH), 0.01),
        'cv_ln_g': 1.0 + nrm((L, CV_WIDTH), 0.01),
        'cv_ln_b': nrm((L, CV_WIDTH), 0.01),
        'w_branch': nrm((L, N_BRANCH, BRANCH_WIDTH, D_MODEL), BRANCH_WIDTH ** -0.5),
        'w_out': nrm((L, D_MODEL, D_MODEL), D_MODEL ** -0.5),
        'ffn2_norm': 1.0 + nrm((L, D_MODEL), 0.01),
        'ffn2_w_gu': nrm((L, D_MODEL, 2 * D_FF), D_MODEL ** -0.5),
        'ffn2_w_down': nrm((L, D_FF, D_MODEL), D_FF ** -0.5),
        'final_norm': 1.0 + nrm((D_MODEL,), 0.01),
    }


def stack_layers(states, i):
    return jnp.stack([st[i] for st in states], axis=0)


def reference(x_prompt, x_sample, state_delta, state_delta_conv, state_s5_re, state_s5_im, state_lru,
              state_lru_conv, state_conv, meta_tokens, ffn1_norm, ffn1_w_gu, ffn1_w_down, mix_norm, w_in,
              dn_conv_w, dn_a_log, dn_dt_bias, dn_norm, s5_lam_re, s5_lam_im, s5_log_step, s5_b_re, s5_b_im,
              s5_c_re, s5_c_im, s5_d, s5_w_glu, s5_b_glu, lru_conv_w, lru_conv_b, lru_w_a, lru_b_a, lru_w_x,
              lru_b_x, lru_lam, cv_conv_w, cv_conv_b, cv_ln_g, cv_ln_b, w_branch, w_out, ffn2_norm, ffn2_w_gu,
              ffn2_w_down, final_norm):
    bp = x_prompt.shape[0]
    meta = jnp.broadcast_to(meta_tokens.astype(x_prompt.dtype)[None], (bp, N_META, D_MODEL))
    xp = jnp.concatenate([meta, x_prompt], axis=1)
    xs = x_sample
    prompt_new = []
    sample_new = []
    for l in range(DEPTH):
        p = {'ffn1_norm': ffn1_norm[l], 'ffn1_w_gu': ffn1_w_gu[l], 'ffn1_w_down': ffn1_w_down[l],
             'mix_norm': mix_norm[l], 'w_in': w_in[l], 'dn_conv_w': dn_conv_w[l], 'dn_a_log': dn_a_log[l],
             'dn_dt_bias': dn_dt_bias[l], 'dn_norm': dn_norm[l], 's5_lam_re': s5_lam_re[l],
             's5_lam_im': s5_lam_im[l], 's5_log_step': s5_log_step[l], 's5_b_re': s5_b_re[l],
             's5_b_im': s5_b_im[l], 's5_c_re': s5_c_re[l], 's5_c_im': s5_c_im[l], 's5_d': s5_d[l],
             's5_w_glu': s5_w_glu[l], 's5_b_glu': s5_b_glu[l], 'lru_conv_w': lru_conv_w[l],
             'lru_conv_b': lru_conv_b[l], 'lru_w_a': lru_w_a[l], 'lru_b_a': lru_b_a[l], 'lru_w_x': lru_w_x[l],
             'lru_b_x': lru_b_x[l], 'lru_lam': lru_lam[l], 'cv_conv_w': cv_conv_w[l], 'cv_conv_b': cv_conv_b[l],
             'cv_ln_g': cv_ln_g[l], 'cv_ln_b': cv_ln_b[l], 'w_branch': w_branch[l], 'w_out': w_out[l],
             'ffn2_norm': ffn2_norm[l], 'ffn2_w_gu': ffn2_w_gu[l], 'ffn2_w_down': ffn2_w_down[l]}
        xp, st_p = decoder_layer(xp, empty_state(bp, xp.dtype), p)
        xs, st_s = decoder_layer(xs, (state_delta[l], state_delta_conv[l], state_s5_re[l], state_s5_im[l],
                                      state_lru[l], state_lru_conv[l], state_conv[l]), p)
        prompt_new.append(st_p)
        sample_new.append(st_s)
    y_prompt = rmsnorm(xp[:, N_META:], final_norm)
    y_sample = rmsnorm(xs, final_norm)
    p_delta = stack_layers(prompt_new, 0)
    p_delta_conv = stack_layers(prompt_new, 1)
    p_s5_re = stack_layers(prompt_new, 2)
    p_s5_im = stack_layers(prompt_new, 3)
    p_lru = stack_layers(prompt_new, 4)
    p_lru_conv = stack_layers(prompt_new, 5)
    p_conv = stack_layers(prompt_new, 6)
    s_delta = stack_layers(sample_new, 0)
    s_delta_conv = stack_layers(sample_new, 1)
    s_s5_re = stack_layers(sample_new, 2)
    s_s5_im = stack_layers(sample_new, 3)
    s_lru = stack_layers(sample_new, 4)
    s_lru_conv = stack_layers(sample_new, 5)
    s_conv = stack_layers(sample_new, 6)
    return (y_prompt, y_sample, p_delta, p_delta_conv, p_s5_re, p_s5_im, p_lru, p_lru_conv, p_conv,
            s_delta, s_delta_conv, s_s5_re, s_s5_im, s_lru, s_lru_conv, s_conv)
```

```cpp
#include <hip/hip_runtime.h>
#include <hip/hip_bf16.h>
#include <hip/hip_cooperative_groups.h>
#include <cstdio>
namespace cg = cooperative_groups;

typedef unsigned short u16;
using bf16x8 = __attribute__((ext_vector_type(8))) short;
using f32x4 = __attribute__((ext_vector_type(4))) float;
using u32x4 = __attribute__((ext_vector_type(4))) unsigned int;
#define DEV __device__ __forceinline__

struct P { const float* in[46]; float* out; char* ws; };

constexpr int NTOK = 17536, TP = 2064, NPR = 16512, ZW = 2304, MT = 137;
constexpr size_t OFF_X = 65536;
constexpr size_t OFF_W = OFF_X + (size_t)NTOK * 1024 * 4;
constexpr size_t W_GU1 = 0, W_DN1 = 5767168, W_INM = 8650752, W_ING = 11010048, W_BR = 15204352, W_OUT = 16252928,
                 W_GLU = 17301504, W_GU2 = 17432576, W_DN2 = 23199744, W_END = 26083328;
constexpr size_t OFF_XN = OFF_W + W_END * 2;
constexpr size_t OFF_BA = OFF_XN + (size_t)NTOK * 1024 * 2;
constexpr size_t OFF_D = OFF_BA + (size_t)NTOK * 8 * 4;
constexpr size_t D_H = 0, D_ZM = 0, D_M = 0, D_BR = 80805888, D_LA = 116719616, D_LB = 125698048, D_Y5 = 134676480;
constexpr size_t WS_NEED = OFF_D + 143654912;
constexpr size_t OFF_GAMMA = 1024;
constexpr size_t O_YS = 16777216, O_PDELTA = 17825792, O_PDCONV = 18087936, O_PS5RE = 18124800, O_PS5IM = 18141184,
                 O_PLRU = 18157568, O_PLRUC = 18161664, O_PCONV = 18173952, O_SDELTA = 18296832, O_SDCONV = 22491136,
                 O_SS5RE = 23080960, O_SS5IM = 23343104, O_SLRU = 23605248, O_SLRUC = 23670784, O_SCONV = 23867392;

DEV u16 f2bf(float f) { unsigned u = __float_as_uint(f); u += 0x7fffu + ((u >> 16) & 1u); return (u16)(u >> 16); }
DEV float bf2f(u16 h) { return __uint_as_float(((unsigned)h) << 16); }
DEV float bflo(unsigned u) { return __uint_as_float(u << 16); }
DEV float bfhi(unsigned u) { return __uint_as_float(u & 0xffff0000u); }
DEV unsigned pack2(float a, float b) { return (unsigned)f2bf(a) | ((unsigned)f2bf(b) << 16); }
DEV float sigm(float x) { return 1.f / (1.f + __expf(-x)); }
DEV float siluf_(float x) { return x / (1.f + __expf(-x)); }
DEV float softplusf_(float x) { return fmaxf(x, 0.f) + log1pf(__expf(-fabsf(x))); }
DEV float geluf_(float x) { float u = 0.7978845608028654f * (x + 0.044715f * x * x * x); return 0.5f * x * (1.f + tanhf(u)); }
DEV float wave_sum(float v) {
#pragma unroll
  for (int o = 32; o > 0; o >>= 1) v += __shfl_xor(v, o, 64);
  return v;
}
DEV void unpack16(uint4 a, uint4 b, float (&x)[16]) {
  x[0] = bflo(a.x); x[1] = bfhi(a.x); x[2] = bflo(a.y); x[3] = bfhi(a.y); x[4] = bflo(a.z); x[5] = bfhi(a.z); x[6] = bflo(a.w); x[7] = bfhi(a.w);
  x[8] = bflo(b.x); x[9] = bfhi(b.x); x[10] = bflo(b.y); x[11] = bfhi(b.y); x[12] = bflo(b.z); x[13] = bfhi(b.z); x[14] = bflo(b.w); x[15] = bfhi(b.w);
}
DEV float* st_out(const P& p, size_t offP, size_t offS, int l, int s, int sz) {
  return s < 8 ? p.out + offP + (size_t)(l * 8 + s) * sz : p.out + offS + (size_t)(l * 128 + (s - 8)) * sz;
}
DEV int tid_() { int t = threadIdx.x; asm volatile("" : "+v"(t)); return t; }
DEV int rowbase_of(int s) { return s < 8 ? s * TP : NPR + (s - 8) * 8; }

DEV void phase_norm(const P& p, int l, int kind) {
  const int tid0 = tid_(); const int lane = tid0 & 63, w = tid0 >> 6;
  float* X = (float*)(p.ws + OFF_X);
  u16* XN = (u16*)(p.ws + OFF_XN);
  float* BA = (float*)(p.ws + OFF_BA);
  const float* gain = kind == 0 ? p.in[10] + l * 1024 : kind == 1 ? p.in[13] + l * 1024 : kind == 2 ? p.in[42] + l * 1024 : p.in[45];
  float4 g4[4];
#pragma unroll
  for (int i = 0; i < 4; ++i) g4[i] = *(const float4*)(gain + i * 256 + lane * 4);
  const bool first = (kind == 0 && l == 0);
  for (int r = blockIdx.x * 4 + w; r < NTOK; r += gridDim.x * 4) {
    const float* src;
    int b = 0, t = 0;
    if (r < NPR) { b = r / TP; t = r - b * TP; }
    if (first) {
      if (r < NPR) src = t < 16 ? p.in[9] + t * 1024 : p.in[0] + ((size_t)b * 2048 + (t - 16)) * 1024;
      else src = p.in[1] + (size_t)(r - NPR) * 1024;
    } else src = X + (size_t)r * 1024;
    float4 v[4];
    float ss = 0.f;
#pragma unroll
    for (int i = 0; i < 4; ++i) {
      v[i] = *(const float4*)(src + i * 256 + lane * 4);
      ss += v[i].x * v[i].x + v[i].y * v[i].y + v[i].z * v[i].z + v[i].w * v[i].w;
    }
    ss = wave_sum(ss);
    const float inv = rsqrtf(ss * (1.f / 1024.f) + 1e-6f);
    if (first) {
#pragma unroll
      for (int i = 0; i < 4; ++i) *(float4*)(X + (size_t)r * 1024 + i * 256 + lane * 4) = v[i];
    }
#pragma unroll
    for (int i = 0; i < 4; ++i) {
      v[i].x *= inv * g4[i].x; v[i].y *= inv * g4[i].y; v[i].z *= inv * g4[i].z; v[i].w *= inv * g4[i].w;
    }
    if (kind == 3) {
      float* dst;
      if (r < NPR) { if (t < 16) continue; dst = p.out + ((size_t)b * 2048 + (t - 16)) * 1024; }
      else dst = p.out + O_YS + (size_t)(r - NPR) * 1024;
#pragma unroll
      for (int i = 0; i < 4; ++i) *(float4*)(dst + i * 256 + lane * 4) = v[i];
    } else {
#pragma unroll
      for (int i = 0; i < 4; ++i) {
        uint2 o; o.x = pack2(v[i].x, v[i].y); o.y = pack2(v[i].z, v[i].w);
        *(uint2*)(XN + (size_t)r * 1024 + i * 256 + lane * 4) = o;
      }
      if (kind == 1) {
        const float* wi = p.in[14] + (size_t)l * 1024 * 6408 + 1024;
        float acc[8];
#pragma unroll
        for (int j = 0; j < 8; ++j) acc[j] = 0.f;
#pragma unroll
        for (int i = 0; i < 4; ++i) {
          const float yv[4] = {v[i].x, v[i].y, v[i].z, v[i].w};
#pragma unroll
          for (int e = 0; e < 4; ++e) {
            const float4* wr = (const float4*)(wi + (size_t)(i * 256 + lane * 4 + e) * 6408);
            float4 a = wr[0], c = wr[1];
            acc[0] += yv[e] * a.x; acc[1] += yv[e] * a.y; acc[2] += yv[e] * a.z; acc[3] += yv[e] * a.w;
            acc[4] += yv[e] * c.x; acc[5] += yv[e] * c.y; acc[6] += yv[e] * c.z; acc[7] += yv[e] * c.w;
          }
        }
#pragma unroll
        for (int j = 0; j < 8; ++j) acc[j] = wave_sum(acc[j]);
        if (lane == 0) {
          *(float4*)(BA + (size_t)r * 8) = make_float4(acc[0], acc[1], acc[2], acc[3]);
          *(float4*)(BA + (size_t)r * 8 + 4) = make_float4(acc[4], acc[5], acc[6], acc[7]);
        }
      }
    }
  }
}

DEV int wmap(int mode, int R, int c0, int half) {
  if (mode == 0) return c0 + R;
  if (mode == 1) { int tile = R >> 7, r = R & 127; int type = (r >> 4) & 1; return type * half + tile * 64 + (r >> 5) * 16 + (r & 15); }
  return R < 1024 ? R : R + 8;
}
DEV void convT(const float* __restrict__ src, int ld, int K, int NR, u16* __restrict__ dst, int mode, int c0, int half,
               int& tbase, float* smem) {
  const int tid = tid_(), G = gridDim.x;
  const int kt = K >> 6, ntile = kt * (NR >> 6);
  int start = ((int)blockIdx.x - tbase) % G;
  if (start < 0) start += G;
  for (int t = start; t < ntile; t += G) {
    const int rt = t / kt, k0 = (t - rt * kt) * 64, R0 = rt * 64;
    __syncthreads();
    const int rr = tid & 63;
    const int col = wmap(mode, R0 + rr, c0, half);
#pragma unroll
    for (int i = 0; i < 16; ++i) {
      int kk = i * 4 + (tid >> 6);
      smem[kk * 65 + rr] = src[(size_t)(k0 + kk) * ld + col];
    }
    __syncthreads();
    const int r2 = tid >> 2, seg = (tid & 3) * 16;
    unsigned o[8];
#pragma unroll
    for (int e = 0; e < 8; ++e) o[e] = pack2(smem[(seg + 2 * e) * 65 + r2], smem[(seg + 2 * e + 1) * 65 + r2]);
    uint4* d = (uint4*)(dst + (size_t)(R0 + r2) * K + k0 + seg);
    d[0] = make_uint4(o[0], o[1], o[2], o[3]);
    d[1] = make_uint4(o[4], o[5], o[6], o[7]);
  }
  tbase = (tbase + ntile) % G;
}
DEV void phase_convw(const P& p, int l, float* smem) {
  u16* W = (u16*)(p.ws + OFF_W);
  int tb = 0;
  convT(p.in[11] + (size_t)l * 1024 * 5632, 5632, 1024, 5632, W + W_GU1, 1, 0, 2816, tb, smem);
  convT(p.in[12] + (size_t)l * 2816 * 1024, 1024, 2816, 1024, W + W_DN1, 0, 0, 0, tb, smem);
  convT(p.in[14] + (size_t)l * 1024 * 6408, 6408, 1024, 2304, W + W_INM, 2, 0, 0, tb, smem);
  convT(p.in[14] + (size_t)l * 1024 * 6408, 6408, 1024, 4096, W + W_ING, 0, 2312, 0, tb, smem);
  for (int n = 0; n < 4; ++n)
    convT(p.in[40] + (size_t)(l * 4 + n) * 256 * 1024, 1024, 256, 1024, W + W_BR + (size_t)n * 1024 * 256, 0, 0, 0, tb, smem);
  convT(p.in[41] + (size_t)l * 1024 * 1024, 1024, 1024, 1024, W + W_OUT, 0, 0, 0, tb, smem);
  convT(p.in[27] + (size_t)l * 256 * 512, 512, 256, 512, W + W_GLU, 1, 0, 256, tb, smem);
  convT(p.in[43] + (size_t)l * 1024 * 5632, 5632, 1024, 5632, W + W_GU2, 1, 0, 2816, tb, smem);
  convT(p.in[44] + (size_t)l * 2816 * 1024, 1024, 2816, 1024, W + W_DN2, 0, 0, 0, tb, smem);
}

template <int BN>
DEV void gemm_acc(const u16* __restrict__ A, int lda, const u16* __restrict__ Bt, int ldb, int K, f32x4 (&acc)[4][BN / 32],
                  u16* sA, u16* sB) {
  constexpr int NI = BN / 32;
  const int tid = tid_(), lane = tid & 63, w = tid >> 6, wm = w >> 1, wn = w & 1;
  const int lrow = tid >> 3, lseg = (tid & 7) * 8;
  const u16* ga = A + (size_t)lrow * lda + lseg;
  const u16* gb = Bt + (size_t)lrow * ldb + lseg;
  u16* wa = sA + lrow * 72 + lseg;
  u16* wb = sB + lrow * 72 + lseg;
  const u16* fa = sA + (wm * 64 + (lane & 15)) * 72 + (lane >> 4) * 8;
  const u16* fb = sB + (wn * (BN / 2) + (lane & 15)) * 72 + (lane >> 4) * 8;
  u32x4 pa0, pa1, pa2, pa3, pb0, pb1, pb2, pb3, qa0, qa1, qa2, qa3, qb0, qb1, qb2, qb3;
#define GA_LOAD(X, koff) do { const u16* _ga = ga + (koff); const u16* _gb = gb + (koff); \
    X##a0 = *(const u32x4*)(_ga); X##a1 = *(const u32x4*)(_ga + (size_t)32 * lda); X##a2 = *(const u32x4*)(_ga + (size_t)64 * lda); X##a3 = *(const u32x4*)(_ga + (size_t)96 * lda); \
    X##b0 = *(const u32x4*)(_gb); X##b1 = *(const u32x4*)(_gb + (size_t)32 * ldb); \
    if (BN == 128) { X##b2 = *(const u32x4*)(_gb + (size_t)64 * ldb); X##b3 = *(const u32x4*)(_gb + (size_t)96 * ldb); } } while (0)
#define GA_WRITE(X) do { *(u32x4*)(wa) = X##a0; *(u32x4*)(wa + 32 * 72) = X##a1; *(u32x4*)(wa + 64 * 72) = X##a2; *(u32x4*)(wa + 96 * 72) = X##a3; \
    *(u32x4*)(wb) = X##b0; *(u32x4*)(wb + 32 * 72) = X##b1; \
    if (BN == 128) { *(u32x4*)(wb + 64 * 72) = X##b2; *(u32x4*)(wb + 96 * 72) = X##b3; } } while (0)
#define GA_COMPUTE() do { _Pragma("unroll") for (int kk = 0; kk < 64; kk += 32) { bf16x8 a[4], b[NI]; \
    _Pragma("unroll") for (int mi = 0; mi < 4; ++mi) a[mi] = *(const bf16x8*)(fa + mi * 16 * 72 + kk); \
    _Pragma("unroll") for (int ni = 0; ni < NI; ++ni) b[ni] = *(const bf16x8*)(fb + ni * 16 * 72 + kk); \
    _Pragma("unroll") for (int mi = 0; mi < 4; ++mi) _Pragma("unroll") for (int ni = 0; ni < NI; ++ni) \
      acc[mi][ni] = __builtin_amdgcn_mfma_f32_16x16x32_bf16(a[mi], b[ni], acc[mi][ni], 0, 0, 0); } } while (0)
  GA_LOAD(p, 0);
  if (K > 64) GA_LOAD(q, 64);
  for (int k0 = 0; k0 < K; k0 += 128) {
    __syncthreads();
    GA_WRITE(p);
    __syncthreads();
    if (k0 + 128 < K) GA_LOAD(p, k0 + 128);
    GA_COMPUTE();
    if (k0 + 64 >= K) break;
    __syncthreads();
    GA_WRITE(q);
    __syncthreads();
    if (k0 + 192 < K) GA_LOAD(q, k0 + 192);
    GA_COMPUTE();
  }
#undef GA_LOAD
#undef GA_WRITE
#undef GA_COMPUTE
}

template <int MODE>
DEV void dual_tile(const u16* A, int lda, int K, const u16* Wt, int mt, int nt, u16* out, int ldo, int ocol0, const float* bias,
                   u16* sA, u16* sB) {
  f32x4 acc[4][4];
#pragma unroll
  for (int i = 0; i < 4; ++i)
#pragma unroll
    for (int j = 0; j < 4; ++j) acc[i][j] = (f32x4){0.f, 0.f, 0.f, 0.f};
  gemm_acc<128>(A + (size_t)mt * 128 * lda, lda, Wt + (size_t)nt * 128 * K, K, K, acc, sA, sB);
  const int tid0 = tid_(); const int lane = tid0 & 63, w = tid0 >> 6, wm = w >> 1, wn = w & 1;
#pragma unroll
  for (int mi = 0; mi < 4; ++mi)
#pragma unroll
    for (int np = 0; np < 2; ++np) {
      const int col = nt * 64 + (wn * 2 + np) * 16 + (lane & 15);
      float b0 = 0.f, b1 = 0.f;
      if (MODE == 1) { b0 = bias[col]; b1 = bias[256 + col]; }
#pragma unroll
      for (int j = 0; j < 4; ++j) {
        const int row = mt * 128 + wm * 64 + mi * 16 + (lane >> 4) * 4 + j;
        float g = acc[mi][2 * np][j], u = acc[mi][2 * np + 1][j];
        float v = (MODE == 0) ? siluf_(g) * u : (g + b0) * sigm(u + b1);
        out[(size_t)row * ldo + ocol0 + col] = f2bf(v);
      }
    }
}
DEV void resid_tile(const u16* A, int lda, int K, const u16* Wt, int mt, int nt, float* X, float scale, u16* sA, u16* sB) {
  f32x4 acc[4][4];
#pragma unroll
  for (int i = 0; i < 4; ++i)
#pragma unroll
    for (int j = 0; j < 4; ++j) acc[i][j] = (f32x4){0.f, 0.f, 0.f, 0.f};
  gemm_acc<128>(A + (size_t)mt * 128 * lda, lda, Wt + (size_t)nt * 128 * K, K, K, acc, sA, sB);
  const int tid0 = tid_(); const int lane = tid0 & 63, w = tid0 >> 6, wm = w >> 1, wn = w & 1;
#pragma unroll
  for (int mi = 0; mi < 4; ++mi)
#pragma unroll
    for (int ni = 0; ni < 4; ++ni) {
      const int col = nt * 128 + wn * 64 + ni * 16 + (lane & 15);
#pragma unroll
      for (int j = 0; j < 4; ++j) {
        const int row = mt * 128 + wm * 64 + mi * 16 + (lane >> 4) * 4 + j;
        X[(size_t)row * 1024 + col] += scale * acc[mi][ni][j];
      }
    }
}
DEV void zm_tile(const u16* A, const u16* Wt, int mt, int nt, u16* Zm, u16* sA, u16* sB) {
  f32x4 acc[4][4];
#pragma unroll
  for (int i = 0; i < 4; ++i)
#pragma unroll
    for (int j = 0; j < 4; ++j) acc[i][j] = (f32x4){0.f, 0.f, 0.f, 0.f};
  gemm_acc<128>(A + (size_t)mt * 128 * 1024, 1024, Wt + (size_t)nt * 128 * 1024, 1024, 1024, acc, sA, sB);
  const int tid0 = tid_(); const int lane = tid0 & 63, w = tid0 >> 6, wm = w >> 1, wn = w & 1;
#pragma unroll
  for (int mi = 0; mi < 4; ++mi)
#pragma unroll
    for (int ni = 0; ni < 4; ++ni) {
      const int col = nt * 128 + wn * 64 + ni * 16 + (lane & 15);
#pragma unroll
      for (int j = 0; j < 4; ++j) {
        const int row = mt * 128 + wm * 64 + mi * 16 + (lane >> 4) * 4 + j;
        Zm[(size_t)row * ZW + col] = f2bf(acc[mi][ni][j]);
      }
    }
}

DEV void gemm_acc256(const u16* __restrict__ A, int lda, const u16* __restrict__ Bt, int ldb, int K, f32x4 (&acc)[4][8],
                     u16* sA, u16* sB) {
  const int tid = tid_(), lane = tid & 63, w = tid >> 6, wm = w >> 1, wn = w & 1;
  const int lrow = tid >> 3, lseg = (tid & 7) * 8;
  const u16* ga = A + (size_t)lrow * lda + lseg;
  const u16* gb = Bt + (size_t)lrow * ldb + lseg;
  u16* wa = sA + lrow * 72 + lseg;
  u16* wb = sB + lrow * 72 + lseg;
  const u16* fa = sA + (wm * 64 + (lane & 15)) * 72 + (lane >> 4) * 8;
  const u16* fb = sB + (wn * 128 + (lane & 15)) * 72 + (lane >> 4) * 8;
  u32x4 ra0, ra1, ra2, ra3, rb0, rb1, rb2, rb3, rb4, rb5, rb6, rb7;
  ra0 = *(const u32x4*)(ga);
  ra1 = *(const u32x4*)(ga + (size_t)32 * lda);
  ra2 = *(const u32x4*)(ga + (size_t)64 * lda);
  ra3 = *(const u32x4*)(ga + (size_t)96 * lda);
  rb0 = *(const u32x4*)(gb);
  rb1 = *(const u32x4*)(gb + (size_t)32 * ldb);
  rb2 = *(const u32x4*)(gb + (size_t)64 * ldb);
  rb3 = *(const u32x4*)(gb + (size_t)96 * ldb);
  rb4 = *(const u32x4*)(gb + (size_t)128 * ldb);
  rb5 = *(const u32x4*)(gb + (size_t)160 * ldb);
  rb6 = *(const u32x4*)(gb + (size_t)192 * ldb);
  rb7 = *(const u32x4*)(gb + (size_t)224 * ldb);
  for (int k0 = 0; k0 < K; k0 += 64) {
    __syncthreads();
    *(u32x4*)(wa) = ra0; *(u32x4*)(wa + 32 * 72) = ra1; *(u32x4*)(wa + 64 * 72) = ra2; *(u32x4*)(wa + 96 * 72) = ra3;
    *(u32x4*)(wb) = rb0; *(u32x4*)(wb + 32 * 72) = rb1; *(u32x4*)(wb + 64 * 72) = rb2; *(u32x4*)(wb + 96 * 72) = rb3;
    *(u32x4*)(wb + 128 * 72) = rb4; *(u32x4*)(wb + 160 * 72) = rb5; *(u32x4*)(wb + 192 * 72) = rb6; *(u32x4*)(wb + 224 * 72) = rb7;
    __syncthreads();
    if (k0 + 64 < K) {
      const u16* ga2 = ga + k0 + 64;
      const u16* gb2 = gb + k0 + 64;
      ra0 = *(const u32x4*)(ga2);
      ra1 = *(const u32x4*)(ga2 + (size_t)32 * lda);
      ra2 = *(const u32x4*)(ga2 + (size_t)64 * lda);
      ra3 = *(const u32x4*)(ga2 + (size_t)96 * lda);
      rb0 = *(const u32x4*)(gb2);
      rb1 = *(const u32x4*)(gb2 + (size_t)32 * ldb);
      rb2 = *(const u32x4*)(gb2 + (size_t)64 * ldb);
      rb3 = *(const u32x4*)(gb2 + (size_t)96 * ldb);
      rb4 = *(const u32x4*)(gb2 + (size_t)128 * ldb);
      rb5 = *(const u32x4*)(gb2 + (size_t)160 * ldb);
      rb6 = *(const u32x4*)(gb2 + (size_t)192 * ldb);
      rb7 = *(const u32x4*)(gb2 + (size_t)224 * ldb);
    }
#pragma unroll
    for (int kk = 0; kk < 64; kk += 32) {
      bf16x8 a[4];
#pragma unroll
      for (int mi = 0; mi < 4; ++mi) a[mi] = *(const bf16x8*)(fa + mi * 16 * 72 + kk);
#pragma unroll
      for (int nh = 0; nh < 2; ++nh) {
        bf16x8 b[4];
#pragma unroll
        for (int ni = 0; ni < 4; ++ni) b[ni] = *(const bf16x8*)(fb + (nh * 4 + ni) * 16 * 72 + kk);
#pragma unroll
        for (int mi = 0; mi < 4; ++mi)
#pragma unroll
          for (int ni = 0; ni < 4; ++ni)
            acc[mi][nh * 4 + ni] = __builtin_amdgcn_mfma_f32_16x16x32_bf16(a[mi], b[ni], acc[mi][nh * 4 + ni], 0, 0, 0);
      }
    }
  }
}
DEV void dual_tile256(const u16* A, const u16* Wt, int mt, int nt, u16* out, u16* sA, u16* sB) {
  f32x4 acc[4][8];
#pragma unroll
  for (int i = 0; i < 4; ++i)
#pragma unroll
    for (int j = 0; j < 8; ++j) acc[i][j] = (f32x4){0.f, 0.f, 0.f, 0.f};
  gemm_acc256(A + (size_t)mt * 128 * 1024, 1024, Wt + (size_t)nt * 256 * 1024, 1024, 1024, acc, sA, sB);
  const int tid0 = tid_(); const int lane = tid0 & 63, w = tid0 >> 6, wm = w >> 1, wn = w & 1;
#pragma unroll
  for (int mi = 0; mi < 4; ++mi)
#pragma unroll
    for (int np = 0; np < 4; ++np) {
      const int col = (nt * 2 + wn) * 64 + np * 16 + (lane & 15);
#pragma unroll
      for (int j = 0; j < 4; ++j) {
        const int row = mt * 128 + wm * 64 + mi * 16 + (lane >> 4) * 4 + j;
        out[(size_t)row * 2816 + col] = f2bf(siluf_(acc[mi][2 * np][j]) * acc[mi][2 * np + 1][j]);
      }
    }
}
DEV void zm_tile256(const u16* A, const u16* Wt, int mt, int nt, u16* Zm, u16* sA, u16* sB) {
  f32x4 acc[4][8];
#pragma unroll
  for (int i = 0; i < 4; ++i)
#pragma unroll
    for (int j = 0; j < 8; ++j) acc[i][j] = (f32x4){0.f, 0.f, 0.f, 0.f};
  gemm_acc256(A + (size_t)mt * 128 * 1024, 1024, Wt + (size_t)nt * 256 * 1024, 1024, 1024, acc, sA, sB);
  const int tid0 = tid_(); const int lane = tid0 & 63, w = tid0 >> 6, wm = w >> 1, wn = w & 1;
#pragma unroll
  for (int mi = 0; mi < 4; ++mi)
#pragma unroll
    for (int ni = 0; ni < 8; ++ni) {
      const int col = nt * 256 + wn * 128 + ni * 16 + (lane & 15);
#pragma unroll
      for (int j = 0; j < 4; ++j) {
        const int row = mt * 128 + wm * 64 + mi * 16 + (lane >> 4) * 4 + j;
        Zm[(size_t)row * ZW + col] = f2bf(acc[mi][ni][j]);
      }
    }
}
DEV void g4_tile(const P& p, int mt, int nt, u16* sA, u16* sB) {
  const u16* BR = (const u16*)(p.ws + OFF_D + D_BR);
  const u16* XN = (const u16*)(p.ws + OFF_XN);
  const u16* Wb = (const u16*)(p.ws + OFF_W) + W_BR;
  const u16* Wg = (const u16*)(p.ws + OFF_W) + W_ING;
  u16* M = (u16*)(p.ws + OFF_D + D_M);
  f32x4 accM[4][2];
#pragma unroll
  for (int i = 0; i < 4; ++i)
#pragma unroll
    for (int j = 0; j < 2; ++j) accM[i][j] = (f32x4){0.f, 0.f, 0.f, 0.f};
#pragma unroll 1
  for (int n = 0; n < 4; ++n) {
    unsigned gate[4][2][2];
    {
      f32x4 accG[4][2];
#pragma unroll
      for (int i = 0; i < 4; ++i)
#pragma unroll
        for (int j = 0; j < 2; ++j) accG[i][j] = (f32x4){0.f, 0.f, 0.f, 0.f};
      gemm_acc<64>(XN + (size_t)mt * 128 * 1024, 1024, Wg + ((size_t)n * 1024 + nt * 64) * 1024, 1024, 1024, accG, sA, sB);
#pragma unroll
      for (int i = 0; i < 4; ++i)
#pragma unroll
        for (int j = 0; j < 2; ++j) {
          gate[i][j][0] = pack2(sigm(accG[i][j][0]), sigm(accG[i][j][1]));
          gate[i][j][1] = pack2(sigm(accG[i][j][2]), sigm(accG[i][j][3]));
        }
    }
    f32x4 accP[4][2];
#pragma unroll
    for (int i = 0; i < 4; ++i)
#pragma unroll
      for (int j = 0; j < 2; ++j) accP[i][j] = (f32x4){0.f, 0.f, 0.f, 0.f};
    gemm_acc<64>(BR + (size_t)mt * 128 * 1024 + n * 256, 1024, Wb + ((size_t)n * 1024 + nt * 64) * 256, 256, 256, accP, sA, sB);
#pragma unroll
    for (int i = 0; i < 4; ++i)
#pragma unroll
      for (int j = 0; j < 2; ++j) {
        accM[i][j][0] += bflo(gate[i][j][0]) * accP[i][j][0];
        accM[i][j][1] += bfhi(gate[i][j][0]) * accP[i][j][1];
        accM[i][j][2] += bflo(gate[i][j][1]) * accP[i][j][2];
        accM[i][j][3] += bfhi(gate[i][j][1]) * accP[i][j][3];
      }
  }
  const int tid0 = tid_(); const int lane = tid0 & 63, w = tid0 >> 6, wm = w >> 1, wn = w & 1;
#pragma unroll
  for (int mi = 0; mi < 4; ++mi)
#pragma unroll
    for (int ni = 0; ni < 2; ++ni) {
      const int col = nt * 64 + wn * 32 + ni * 16 + (lane & 15);
#pragma unroll
      for (int j = 0; j < 4; ++j) {
        const int row = mt * 128 + wm * 64 + mi * 16 + (lane >> 4) * 4 + j;
        M[(size_t)row * 1024 + col] = f2bf(accM[mi][ni][j]);
      }
    }
}

DEV void dn_conv16(const u16* __restrict__ Zm, const float* __restrict__ buf, const float* __restrict__ cw, int rowbase, int t, int c,
                   float (&o)[16]) {
#pragma unroll
  for (int e = 0; e < 16; ++e) o[e] = 0.f;
#pragma unroll
  for (int tap = 0; tap < 4; ++tap) {
    const int tau = t - 3 + tap;
    float x[16];
    if (tau >= 0) {
      const uint4* z = (const uint4*)(Zm + (size_t)(rowbase + tau) * ZW + c);
      unpack16(z[0], z[1], x);
    } else if (buf) {
      const float4* bb = (const float4*)(buf + (3 + tau) * 768 + c);
#pragma unroll
      for (int q = 0; q < 4; ++q) { float4 f = bb[q]; x[q * 4] = f.x; x[q * 4 + 1] = f.y; x[q * 4 + 2] = f.z; x[q * 4 + 3] = f.w; }
    } else {
#pragma unroll
      for (int e = 0; e < 16; ++e) x[e] = 0.f;
    }
    const float4* w4 = (const float4*)(cw + tap * 768 + c);
#pragma unroll
    for (int q = 0; q < 4; ++q) {
      float4 f = w4[q];
      o[q * 4] += f.x * x[q * 4]; o[q * 4 + 1] += f.y * x[q * 4 + 1]; o[q * 4 + 2] += f.z * x[q * 4 + 2]; o[q * 4 + 3] += f.w * x[q * 4 + 3];
    }
  }
#pragma unroll
  for (int e = 0; e < 16; ++e) o[e] = siluf_(o[e]);
}

DEV void delta_pre(const P& p, int l, int idx, float* smem) {
  float* sq = smem;
  float* sk = smem + 64 * 68;
  float* sL = smem + 2 * 64 * 68;
  float* sbeta = sL + 4096;
  float* sg = sbeta + 64;
  float* sgc = sg + 64;
  int s, h, j, pad, T;
  if (idx < 1056) { s = idx / 132; int r = idx - s * 132; h = r / 33; j = r - h * 33; pad = 48; T = TP; }
  else { int r = idx - 1056; s = 8 + (r >> 2); h = r & 3; j = 0; pad = 56; T = 8; }
  const int tid = tid_();
  const u16* Zm = (const u16*)(p.ws + OFF_D + D_ZM);
  const float* BA = (const float*)(p.ws + OFF_BA);
  const float* cw = p.in[15] + l * 4 * 768;
  const float* buf = (s >= 8) ? p.in[3] + (size_t)(l * 128 + (s - 8)) * 3 * 768 : nullptr;
  const int rowbase = rowbase_of(s);
  u16* wsb = (u16*)p.out + (size_t)idx * 20480;
  float* gamma = (float*)(p.ws + OFF_GAMMA);
  {
    const int i = tid >> 2, dq = (tid & 3) * 16;
    const int t = j * 64 + i - pad;
    float qv[16], kv[16];
    float sq_ = 0.f, sk_ = 0.f;
    if (t >= 0) {
      dn_conv16(Zm, buf, cw, rowbase, t, h * 64 + dq, qv);
      dn_conv16(Zm, buf, cw, rowbase, t, 256 + h * 64 + dq, kv);
#pragma unroll
      for (int e = 0; e < 16; ++e) { sq_ += qv[e] * qv[e]; sk_ += kv[e] * kv[e]; }
    } else {
#pragma unroll
      for (int e = 0; e < 16; ++e) { qv[e] = 0.f; kv[e] = 0.f; }
    }
    sq_ += __shfl_xor(sq_, 1, 64); sq_ += __shfl_xor(sq_, 2, 64);
    sk_ += __shfl_xor(sk_, 1, 64); sk_ += __shfl_xor(sk_, 2, 64);
    const float qs = rsqrtf(sq_ + 1e-6f) * 0.125f, ks = rsqrtf(sk_ + 1e-6f);
#pragma unroll
    for (int e = 0; e < 16; ++e) { sq[i * 68 + dq + e] = qv[e] * qs; sk[i * 68 + dq + e] = kv[e] * ks; }
  }
  if (tid < 64) {
    const int t = j * 64 + tid - pad;
    float be = 0.f, g = 0.f;
    if (t >= 0) {
      const float* ba = BA + (size_t)(rowbase + t) * 8;
      be = sigm(ba[h]);
      float a = ba[4 + h] + p.in[17][l * 4 + h];
      g = -expf(p.in[16][l * 4 + h]) * softplusf_(a);
    }
    sbeta[tid] = be;
    sg[tid] = g;
  }
  __syncthreads();
  if (tid < 64) {
    float c = 0.f;
    for (int i2 = 0; i2 <= tid; ++i2) c += sg[i2];
    sgc[tid] = c;
  }
  __syncthreads();
  {
    const int ti = tid >> 4, tj = tid & 15;
    float aL[4][4], aI[4][4];
#pragma unroll
    for (int a = 0; a < 4; ++a)
#pragma unroll
      for (int b = 0; b < 4; ++b) { aL[a][b] = 0.f; aI[a][b] = 0.f; }
    for (int d = 0; d < 64; d += 4) {
      float4 qa[4], ka[4], kb[4];
#pragma unroll
      for (int a = 0; a < 4; ++a) { qa[a] = *(const float4*)&sq[(ti + 16 * a) * 68 + d]; ka[a] = *(const float4*)&sk[(ti + 16 * a) * 68 + d]; }
#pragma unroll
      for (int b = 0; b < 4; ++b) kb[b] = *(const float4*)&sk[(tj + 16 * b) * 68 + d];
#pragma unroll
      for (int a = 0; a < 4; ++a)
#pragma unroll
        for (int b = 0; b < 4; ++b) {
          aL[a][b] += ka[a].x * kb[b].x + ka[a].y * kb[b].y + ka[a].z * kb[b].z + ka[a].w * kb[b].w;
          aI[a][b] += qa[a].x * kb[b].x + qa[a].y * kb[b].y + qa[a].z * kb[b].z + qa[a].w * kb[b].w;
        }
    }
#pragma unroll
    for (int a = 0; a < 4; ++a)
#pragma unroll
      for (int b = 0; b < 4; ++b) {
        const int i = ti + 16 * a, jj = tj + 16 * b;
        const float dec = (jj <= i) ? __expf(sgc[i] - sgc[jj]) : 0.f;
        sL[i * 64 + jj] = (jj < i) ? aL[a][b] * sbeta[i] * dec : 0.f;
        wsb[3 * 4096 + i * 64 + jj] = f2bf(aI[a][b] * dec);
      }
  }
  for (int e = tid; e < 4096; e += 256) {
    const int i = e >> 6, d = e & 63;
    wsb[2 * 4096 + e] = f2bf(sq[i * 68 + d] * __expf(sgc[i]));
  }
  for (int e = tid; e < 4096; e += 256) {
    const int d = e >> 6, i = e & 63;
    wsb[4 * 4096 + e] = f2bf(sk[i * 68 + d] * __expf(sgc[63] - sgc[i]));
  }
  if (tid == 0) gamma[idx] = __expf(sgc[63]);
  __syncthreads();
  {
    const int i = tid >> 2, dq = (tid & 3) * 16;
    const int t = j * 64 + i - pad;
    float vv[16];
    if (t >= 0) dn_conv16(Zm, buf, cw, rowbase, t, 512 + h * 64 + dq, vv);
    else {
#pragma unroll
      for (int e = 0; e < 16; ++e) vv[e] = 0.f;
    }
    const float be = sbeta[i], eg = be * __expf(sgc[i]);
#pragma unroll
    for (int e = 0; e < 16; ++e) { sq[i * 68 + dq + e] = vv[e] * be; sk[i * 68 + dq + e] *= eg; }
  }
  __syncthreads();
  {
    float* arr = (tid < 128) ? sq : sk;
    const int col = (tid >> 1) & 63, hf = tid & 1;
    for (int i = 1; i < 64; ++i) {
      float acc = 0.f;
      for (int j0 = hf * 4; j0 < i; j0 += 8) {
        const float4 l4 = *(const float4*)&sL[i * 64 + j0];
        acc -= l4.x * arr[j0 * 68 + col] + l4.y * arr[(j0 + 1) * 68 + col] + l4.z * arr[(j0 + 2) * 68 + col] + l4.w * arr[(j0 + 3) * 68 + col];
      }
      acc += __shfl_xor(acc, 1, 64);
      if (hf == 0) arr[i * 68 + col] += acc;
    }
  }
  __syncthreads();
  for (int e = tid; e < 4096; e += 256) {
    const int i = e >> 6, d = e & 63;
    wsb[e] = f2bf(sq[i * 68 + d]);
    wsb[4096 + e] = f2bf(sk[i * 68 + d]);
  }
  if (h == 0 && j == (s < 8 ? 32 : 0)) {
    float* o = st_out(p, O_PDCONV, O_SDCONV, l, s, 3 * 768);
    for (int e = tid; e < 3 * 768; e += 256) {
      const int r = e / 768, c = e - r * 768;
      o[e] = bf2f(Zm[(size_t)(rowbase + T - 3 + r) * ZW + c]);
    }
  }
}

DEV void mm64(const float* __restrict__ A, const float* __restrict__ B, float (&acc)[4][4], int ti, int tj) {
#pragma unroll 4
  for (int kk = 0; kk < 64; kk += 4) {
    float4 a[4], b[4];
#pragma unroll
    for (int x = 0; x < 4; ++x) a[x] = *(const float4*)&A[(ti + 16 * x) * 68 + kk];
#pragma unroll
    for (int y = 0; y < 4; ++y) b[y] = *(const float4*)&B[(kk + y) * 64 + tj * 4];
#pragma unroll
    for (int x = 0; x < 4; ++x) {
      acc[x][0] += a[x].x * b[0].x + a[x].y * b[1].x + a[x].z * b[2].x + a[x].w * b[3].x;
      acc[x][1] += a[x].x * b[0].y + a[x].y * b[1].y + a[x].z * b[2].y + a[x].w * b[3].y;
      acc[x][2] += a[x].x * b[0].z + a[x].y * b[1].z + a[x].z * b[2].z + a[x].w * b[3].z;
      acc[x][3] += a[x].x * b[0].w + a[x].y * b[1].w + a[x].z * b[2].w + a[x].w * b[3].w;
    }
  }
}
DEV void storeA16(float* sA, uint4 r0, uint4 r1) {
  const int tid = tid_();
  float x[16];
  unpack16(r0, r1, x);
  float* d = sA + (tid >> 2) * 68 + (tid & 3) * 16;
#pragma unroll
  for (int q = 0; q < 4; ++q) *(float4*)(d + q * 4) = make_float4(x[q * 4], x[q * 4 + 1], x[q * 4 + 2], x[q * 4 + 3]);
}

DEV void delta_seq(const P& p, int l, int s, int h, float* smem) {
  float* sS = smem;
  float* sV = smem + 4096;
  float* sA = smem + 8192;
  const int tid = tid_(), ti = tid >> 4, tj = tid & 15;
  const int n = (s < 8) ? 33 : 1, pad = (s < 8) ? 48 : 56;
  const int item0 = (s < 8) ? (s * 4 + h) * 33 : 1056 + (s - 8) * 4 + h;
  const int rowbase = rowbase_of(s);
  const float* s0 = (s >= 8) ? p.in[2] + (size_t)((l * 128 + (s - 8)) * 4 + h) * 4096 : nullptr;
  for (int e = tid; e < 4096; e += 256) sS[e] = s0 ? s0[e] : 0.f;
  const u16* wsb = (const u16*)p.out + (size_t)item0 * 20480;
  const float* gamma = (const float*)(p.ws + OFF_GAMMA) + item0;
  const u16* Zm = (const u16*)(p.ws + OFF_D + D_ZM);
  u16* BR = (u16*)(p.ws + OFF_D + D_BR);
  const float4 ng = *(const float4*)(p.in[18] + l * 64 + tj * 4);
  uint4 r0, r1;
  { const uint4* src = (const uint4*)(wsb + 4096 + tid * 16); r0 = src[0]; r1 = src[1]; }
  for (int j = 0; j < n; ++j) {
    const u16* it = wsb + (size_t)j * 20480;
    __syncthreads();
    storeA16(sA, r0, r1);
    __syncthreads();
    { const uint4* src = (const uint4*)(it + 2 * 4096 + tid * 16); r0 = src[0]; r1 = src[1]; }
    float acc[4][4];
#pragma unroll
    for (int a = 0; a < 4; ++a)
#pragma unroll
      for (int c = 0; c < 4; ++c) acc[a][c] = 0.f;
    mm64(sA, sS, acc, ti, tj);
#pragma unroll
    for (int a = 0; a < 4; ++a) {
      const int i = ti + 16 * a;
      uint2 uu = *(const uint2*)(it + i * 64 + tj * 4);
      *(float4*)&sV[i * 64 + tj * 4] = make_float4(bflo(uu.x) - acc[a][0], bfhi(uu.x) - acc[a][1], bflo(uu.y) - acc[a][2], bfhi(uu.y) - acc[a][3]);
    }
    __syncthreads();
    storeA16(sA, r0, r1);
    __syncthreads();
    { const uint4* src = (const uint4*)(it + 3 * 4096 + tid * 16); r0 = src[0]; r1 = src[1]; }
    float o[4][4];
#pragma unroll
    for (int a = 0; a < 4; ++a)
#pragma unroll
      for (int c = 0; c < 4; ++c) o[a][c] = 0.f;
    mm64(sA, sS, o, ti, tj);
    __syncthreads();
    storeA16(sA, r0, r1);
    __syncthreads();
    { const uint4* src = (const uint4*)(it + 4 * 4096 + tid * 16); r0 = src[0]; r1 = src[1]; }
    mm64(sA, sV, o, ti, tj);
#pragma unroll
    for (int a = 0; a < 4; ++a) {
      const int i = ti + 16 * a;
      const int t = j * 64 + i - pad;
      float ss = o[a][0] * o[a][0] + o[a][1] * o[a][1] + o[a][2] * o[a][2] + o[a][3] * o[a][3];
      ss += __shfl_xor(ss, 1, 64); ss += __shfl_xor(ss, 2, 64); ss += __shfl_xor(ss, 4, 64); ss += __shfl_xor(ss, 8, 64);
      if (t >= 0) {
        const float inv = rsqrtf(ss * (1.f / 64.f) + 1e-6f);
        const size_t row = (size_t)(rowbase + t);
        uint2 zz = *(const uint2*)(Zm + row * ZW + 768 + h * 64 + tj * 4);
        float y0 = o[a][0] * inv * ng.x * siluf_(bflo(zz.x));
        float y1 = o[a][1] * inv * ng.y * siluf_(bfhi(zz.x));
        float y2 = o[a][2] * inv * ng.z * siluf_(bflo(zz.y));
        float y3 = o[a][3] * inv * ng.w * siluf_(bfhi(zz.y));
        uint2 ov; ov.x = pack2(y0, y1); ov.y = pack2(y2, y3);
        *(uint2*)(BR + row * 1024 + h * 64 + tj * 4) = ov;
      }
    }
    __syncthreads();
    storeA16(sA, r0, r1);
    __syncthreads();
    if (j + 1 < n) { const uint4* src = (const uint4*)(it + 20480 + 4096 + tid * 16); r0 = src[0]; r1 = src[1]; }
#pragma unroll
    for (int a = 0; a < 4; ++a)
#pragma unroll
      for (int c = 0; c < 4; ++c) acc[a][c] = 0.f;
    mm64(sA, sV, acc, ti, tj);
    const float gm = gamma[j];
#pragma unroll
    for (int a = 0; a < 4; ++a) {
      float4* sp = (float4*)&sS[(ti + 16 * a) * 64 + tj * 4];
      float4 old = *sp;
      *sp = make_float4(gm * old.x + acc[a][0], gm * old.y + acc[a][1], gm * old.z + acc[a][2], gm * old.w + acc[a][3]);
    }
  }
  __syncthreads();
  float* so = st_out(p, O_PDELTA, O_SDELTA, l, s, 4 * 4096) + h * 4096;
  for (int e = tid; e < 4096; e += 256) so[e] = sS[e];
}

DEV void s5_block(const P& p, int l, int s, int gq, float* smem) {
  const int tid = tid_(), lane = tid & 63;
  const int w = __builtin_amdgcn_readfirstlane(tid >> 6);
  const int g = gq * 4 + w;
  float* sC = smem + w * 3248;
  float* sH = sC + 2080;
  float* sU = sH + 1040;
  const int T = (s < 8) ? TP : 8;
  const int rowbase = rowbase_of(s);
  const u16* Zm = (const u16*)(p.ws + OFF_D + D_ZM);
  u16* Y5 = (u16*)(p.ws + OFF_D + D_Y5);
  const int lg_ = l * 16 + g;
  const float lr = p.in[19][lg_ * 64 + lane], li = p.in[20][lg_ * 64 + lane];
  const float dt = expf(p.in[21][lg_]);
  const float mag = expf(lr * dt);
  const float lbr = mag * cosf(li * dt), lbi = mag * sinf(li * dt);
  const float den = lr * lr + li * li;
  const float cfr = ((lbr - 1.f) * lr + lbi * li) / den, cfi = (lbi * lr - (lbr - 1.f) * li) / den;
  float xr_c[16], xi_c[16];
  {
    const float4* br4 = (const float4*)(p.in[22] + ((size_t)lg_ * 64 + lane) * 16);
    const float4* bi4 = (const float4*)(p.in[23] + ((size_t)lg_ * 64 + lane) * 16);
#pragma unroll
    for (int q = 0; q < 4; ++q) {
      float4 a = br4[q], b = bi4[q];
      xr_c[q * 4] = cfr * a.x - cfi * b.x; xi_c[q * 4] = cfr * b.x + cfi * a.x;
      xr_c[q * 4 + 1] = cfr * a.y - cfi * b.y; xi_c[q * 4 + 1] = cfr * b.y + cfi * a.y;
      xr_c[q * 4 + 2] = cfr * a.z - cfi * b.z; xi_c[q * 4 + 2] = cfr * b.z + cfi * a.z;
      xr_c[q * 4 + 3] = cfr * a.w - cfi * b.w; xi_c[q * 4 + 3] = cfr * b.w + cfi * a.w;
    }
  }
  for (int e = lane; e < 1024; e += 64) {
    const int c = e >> 6, pp = e & 63;
    sC[(c * 65 + pp) * 2] = p.in[24][(size_t)lg_ * 1024 + e];
    sC[(c * 65 + pp) * 2 + 1] = p.in[25][(size_t)lg_ * 1024 + e];
  }
  float hr = 0.f, hi = 0.f;
  if (s >= 8) {
    hr = p.in[4][((size_t)(l * 128 + (s - 8)) * 16 + g) * 64 + lane];
    hi = p.in[5][((size_t)(l * 128 + (s - 8)) * 16 + g) * 64 + lane];
  }
  const int ytt = lane >> 3, cp = (lane & 7) * 2;
  const float d0 = p.in[26][l * 256 + g * 16 + cp], d1 = p.in[26][l * 256 + g * 16 + cp + 1];
  const u16* ubase = Zm + (size_t)rowbase * ZW + 1024 + g * 16 + (size_t)(lane >> 1) * ZW + (lane & 1) * 8;
  uint4 pu = make_uint4(0u, 0u, 0u, 0u);
  if (lane < 16) pu = *(const uint4*)(ubase);
  if (lane < 16) {
    float* d = sU + (lane >> 1) * 16 + (lane & 1) * 8;
    *(float4*)(d) = make_float4(bflo(pu.x), bfhi(pu.x), bflo(pu.y), bfhi(pu.y));
    *(float4*)(d + 4) = make_float4(bflo(pu.z), bfhi(pu.z), bflo(pu.w), bfhi(pu.w));
  }
  for (int t0 = 0; t0 < T; t0 += 8) {
    __syncthreads();
    if (lane < 16 && t0 + 8 < T) pu = *(const uint4*)(ubase + (size_t)(t0 + 8) * ZW);
#pragma unroll 2
    for (int tt = 0; tt < 8; ++tt) {
      const float4 u0 = *(const float4*)(sU + tt * 16), u1 = *(const float4*)(sU + tt * 16 + 4), u2 = *(const float4*)(sU + tt * 16 + 8),
                   u3 = *(const float4*)(sU + tt * 16 + 12);
      const float u[16] = {u0.x, u0.y, u0.z, u0.w, u1.x, u1.y, u1.z, u1.w, u2.x, u2.y, u2.z, u2.w, u3.x, u3.y, u3.z, u3.w};
      float xr = 0.f, xi = 0.f;
#pragma unroll
      for (int c = 0; c < 16; ++c) { xr += xr_c[c] * u[c]; xi += xi_c[c] * u[c]; }
      const float nr = lbr * hr - lbi * hi + xr;
      const float ni = lbr * hi + lbi * hr + xi;
      hr = nr; hi = ni;
      *(float2*)&sH[(tt * 65 + lane) * 2] = make_float2(hr, hi);
    }
    __syncthreads();
    float y0 = 0.f, y1 = 0.f;
#pragma unroll 8
    for (int pp = 0; pp < 64; ++pp) {
      const float2 hv = *(const float2*)&sH[(ytt * 65 + pp) * 2];
      const float2 c0 = *(const float2*)&sC[(cp * 65 + pp) * 2];
      const float2 c1 = *(const float2*)&sC[((cp + 1) * 65 + pp) * 2];
      y0 += hv.x * c0.x - hv.y * c0.y;
      y1 += hv.x * c1.x - hv.y * c1.y;
    }
    const size_t row = (size_t)(rowbase + t0 + ytt);
    const float2 uy = *(const float2*)(sU + ytt * 16 + cp);
    y0 = geluf_(y0 + d0 * uy.x);
    y1 = geluf_(y1 + d1 * uy.y);
    *(unsigned*)(Y5 + row * 256 + g * 16 + cp) = pack2(y0, y1);
    if (lane < 16 && t0 + 8 < T) {
      float* d = sU + (lane >> 1) * 16 + (lane & 1) * 8;
      *(float4*)(d) = make_float4(bflo(pu.x), bfhi(pu.x), bflo(pu.y), bfhi(pu.y));
      *(float4*)(d + 4) = make_float4(bflo(pu.z), bfhi(pu.z), bflo(pu.w), bfhi(pu.w));
    }
  }
  st_out(p, O_PS5RE, O_SS5RE, l, s, 1024)[g * 64 + lane] = hr;
  st_out(p, O_PS5IM, O_SS5IM, l, s, 1024)[g * 64 + lane] = hi;
}


DEV void s5_prompt(const P& p, int l, int s, int g, float* smem) {
  const int tid = tid_(), lane = tid & 63;
  const int w = __builtin_amdgcn_readfirstlane(tid >> 6);
  float* sC = smem;
  float* sE = smem + 2080;
  float* sH = smem + 2080 + 512 + w * 1168;
  float* sU = sH + 1040;
  const int rowbase = rowbase_of(s);
  const int tbeg = w * 512, tend = (w == 3) ? TP : tbeg + 512;
  const u16* Zm = (const u16*)(p.ws + OFF_D + D_ZM);
  u16* Y5 = (u16*)(p.ws + OFF_D + D_Y5);
  const int lg_ = l * 16 + g;
  const float lr = p.in[19][lg_ * 64 + lane], li = p.in[20][lg_ * 64 + lane];
  const float dt = expf(p.in[21][lg_]);
  const float mag = expf(lr * dt);
  const float lbr = mag * cosf(li * dt), lbi = mag * sinf(li * dt);
  const float den = lr * lr + li * li;
  const float cfr = ((lbr - 1.f) * lr + lbi * li) / den, cfi = (lbi * lr - (lbr - 1.f) * li) / den;
  float xr_c[16], xi_c[16];
  {
    const float4* br4 = (const float4*)(p.in[22] + ((size_t)lg_ * 64 + lane) * 16);
    const float4* bi4 = (const float4*)(p.in[23] + ((size_t)lg_ * 64 + lane) * 16);
#pragma unroll
    for (int q = 0; q < 4; ++q) {
      float4 a = br4[q], b = bi4[q];
      xr_c[q * 4] = cfr * a.x - cfi * b.x; xi_c[q * 4] = cfr * b.x + cfi * a.x;
      xr_c[q * 4 + 1] = cfr * a.y - cfi * b.y; xi_c[q * 4 + 1] = cfr * b.y + cfi * a.y;
      xr_c[q * 4 + 2] = cfr * a.z - cfi * b.z; xi_c[q * 4 + 2] = cfr * b.z + cfi * a.z;
      xr_c[q * 4 + 3] = cfr * a.w - cfi * b.w; xi_c[q * 4 + 3] = cfr * b.w + cfi * a.w;
    }
  }
  for (int e = tid; e < 1024; e += 256) {
    const int c = e >> 6, pp = e & 63;
    sC[(c * 65 + pp) * 2] = p.in[24][(size_t)lg_ * 1024 + e];
    sC[(c * 65 + pp) * 2 + 1] = p.in[25][(size_t)lg_ * 1024 + e];
  }
  const u16* ubase = Zm + (size_t)rowbase * ZW + 1024 + g * 16 + (size_t)(lane >> 1) * ZW + (lane & 1) * 8;
  float hr = 0.f, hi = 0.f;
  if (w < 3) {
    uint4 pu = make_uint4(0u, 0u, 0u, 0u);
    if (lane < 16) pu = *(const uint4*)(ubase + (size_t)tbeg * ZW);
    for (int t0 = tbeg; t0 < tend; t0 += 8) {
      if (lane < 16) {
        float* d = sU + (lane >> 1) * 16 + (lane & 1) * 8;
        *(float4*)(d) = make_float4(bflo(pu.x), bfhi(pu.x), bflo(pu.y), bfhi(pu.y));
        *(float4*)(d + 4) = make_float4(bflo(pu.z), bfhi(pu.z), bflo(pu.w), bfhi(pu.w));
      }
      if (lane < 16 && t0 + 8 < tend) pu = *(const uint4*)(ubase + (size_t)(t0 + 8) * ZW);
      __builtin_amdgcn_wave_barrier();
#pragma unroll 2
      for (int tt = 0; tt < 8; ++tt) {
        const float4 u0 = *(const float4*)(sU + tt * 16), u1 = *(const float4*)(sU + tt * 16 + 4), u2 = *(const float4*)(sU + tt * 16 + 8),
                     u3 = *(const float4*)(sU + tt * 16 + 12);
        const float u[16] = {u0.x, u0.y, u0.z, u0.w, u1.x, u1.y, u1.z, u1.w, u2.x, u2.y, u2.z, u2.w, u3.x, u3.y, u3.z, u3.w};
        float xr = 0.f, xi = 0.f;
#pragma unroll
        for (int c = 0; c < 16; ++c) { xr += xr_c[c] * u[c]; xi += xi_c[c] * u[c]; }
        const float nr = lbr * hr - lbi * hi + xr;
        const float ni = lbr * hi + lbi * hr + xi;
        hr = nr; hi = ni;
      }
      __builtin_amdgcn_wave_barrier();
    }
    *(float2*)&sE[(w * 64 + lane) * 2] = make_float2(hr, hi);
  }
  __syncthreads();
  {
    const float m512 = expf(lr * dt * 512.f);
    const float pr = m512 * cosf(li * dt * 512.f), pi = m512 * sinf(li * dt * 512.f);
    float Hr = 0.f, Hi = 0.f;
    for (int k = 0; k < w; ++k) {
      const float2 e = *(const float2*)&sE[(k * 64 + lane) * 2];
      const float nr = pr * Hr - pi * Hi + e.x, ni = pr * Hi + pi * Hr + e.y;
      Hr = nr; Hi = ni;
    }
    hr = Hr; hi = Hi;
  }
  const int ytt = lane >> 3, cp = (lane & 7) * 2;
  const float d0 = p.in[26][l * 256 + g * 16 + cp], d1 = p.in[26][l * 256 + g * 16 + cp + 1];
  {
    uint4 pu = make_uint4(0u, 0u, 0u, 0u);
    if (lane < 16) pu = *(const uint4*)(ubase + (size_t)tbeg * ZW);
    for (int t0 = tbeg; t0 < tend; t0 += 8) {
      if (lane < 16) {
        float* d = sU + (lane >> 1) * 16 + (lane & 1) * 8;
        *(float4*)(d) = make_float4(bflo(pu.x), bfhi(pu.x), bflo(pu.y), bfhi(pu.y));
        *(float4*)(d + 4) = make_float4(bflo(pu.z), bfhi(pu.z), bflo(pu.w), bfhi(pu.w));
      }
      if (lane < 16 && t0 + 8 < tend) pu = *(const uint4*)(ubase + (size_t)(t0 + 8) * ZW);
      __builtin_amdgcn_wave_barrier();
#pragma unroll 2
      for (int tt = 0; tt < 8; ++tt) {
        const float4 u0 = *(const float4*)(sU + tt * 16), u1 = *(const float4*)(sU + tt * 16 + 4), u2 = *(const float4*)(sU + tt * 16 + 8),
                     u3 = *(const float4*)(sU + tt * 16 + 12);
        const float u[16] = {u0.x, u0.y, u0.z, u0.w, u1.x, u1.y, u1.z, u1.w, u2.x, u2.y, u2.z, u2.w, u3.x, u3.y, u3.z, u3.w};
        float xr = 0.f, xi = 0.f;
#pragma unroll
        for (int c = 0; c < 16; ++c) { xr += xr_c[c] * u[c]; xi += xi_c[c] * u[c]; }
        const float nr = lbr * hr - lbi * hi + xr;
        const float ni = lbr * hi + lbi * hr + xi;
        hr = nr; hi = ni;
        *(float2*)&sH[(tt * 65 + lane) * 2] = make_float2(hr, hi);
      }
      __builtin_amdgcn_wave_barrier();
      float y0 = 0.f, y1 = 0.f;
#pragma unroll 8
      for (int pp = 0; pp < 64; ++pp) {
        const float2 hv = *(const float2*)&sH[(ytt * 65 + pp) * 2];
        const float2 c0 = *(const float2*)&sC[(cp * 65 + pp) * 2];
        const float2 c1 = *(const float2*)&sC[((cp + 1) * 65 + pp) * 2];
        y0 += hv.x * c0.x - hv.y * c0.y;
        y1 += hv.x * c1.x - hv.y * c1.y;
      }
      const size_t row = (size_t)(rowbase + t0 + ytt);
      const float2 uy = *(const float2*)(sU + ytt * 16 + cp);
      y0 = geluf_(y0 + d0 * uy.x);
      y1 = geluf_(y1 + d1 * uy.y);
      *(unsigned*)(Y5 + row * 256 + g * 16 + cp) = pack2(y0, y1);
      __builtin_amdgcn_wave_barrier();
    }
  }
  if (w == 3) {
    st_out(p, O_PS5RE, O_SS5RE, l, s, 1024)[g * 64 + lane] = hr;
    st_out(p, O_PS5IM, O_SS5IM, l, s, 1024)[g * 64 + lane] = hi;
  }
}

DEV float lru_xin(const P& p, const u16* Zm, int l, int s, int rowbase, int tau, int c) {
  if (tau >= 0) return bf2f(Zm[(size_t)(rowbase + tau) * ZW + 1280 + c]);
  if (s >= 8) return p.in[7][((size_t)(l * 128 + (s - 8)) * 3 + (3 + tau)) * 256 + c];
  return 0.f;
}
DEV void lru_pass1(const P& p, int l, int s, int t0, float* smem) {
  float* sX = smem;
  const int c = tid_();
  const int T = (s < 8) ? TP : 8;
  const int nT = min(32, T - t0);
  const int rowbase = rowbase_of(s);
  const u16* Zm = (const u16*)(p.ws + OFF_D + D_ZM);
  u16* LA = (u16*)(p.ws + OFF_D + D_LA);
  u16* LB = (u16*)(p.ws + OFF_D + D_LB);
  const float w0 = p.in[29][(l * 4 + 0) * 256 + c], w1 = p.in[29][(l * 4 + 1) * 256 + c], w2 = p.in[29][(l * 4 + 2) * 256 + c],
              w3 = p.in[29][(l * 4 + 3) * 256 + c];
  const float cb = p.in[30][l * 256 + c];
  float xm3 = lru_xin(p, Zm, l, s, rowbase, t0 - 3, c), xm2 = lru_xin(p, Zm, l, s, rowbase, t0 - 2, c),
        xm1 = lru_xin(p, Zm, l, s, rowbase, t0 - 1, c);
  u16 xin[32];
#pragma unroll
  for (int tt = 0; tt < 32; ++tt) xin[tt] = (tt < nT) ? Zm[(size_t)(rowbase + t0 + tt) * ZW + 1280 + c] : (u16)0;
#pragma unroll
  for (int tt = 0; tt < 32; ++tt) {
    const float x0 = bf2f(xin[tt]);
    sX[tt * 256 + c] = (tt < nT) ? (w0 * xm3 + w1 * xm2 + w2 * xm1 + w3 * x0 + cb) : 0.f;
    xm3 = xm2; xm2 = xm1; xm1 = x0;
  }
  __syncthreads();
  const int blk = __builtin_amdgcn_readfirstlane(c >> 6), d = c & 63;
  const float* wa = p.in[31] + (size_t)(l * 4 + blk) * 4096;
  const float* wx = p.in[33] + (size_t)(l * 4 + blk) * 4096;
  const float ba = p.in[32][l * 256 + c], bx = p.in[34][l * 256 + c];
  const float sp = softplusf_(-p.in[35][l * 256 + c]);
  for (int b8 = 0; b8 * 8 < nT; ++b8) {
    float ra[8], ia[8];
#pragma unroll
    for (int tt = 0; tt < 8; ++tt) { ra[tt] = 0.f; ia[tt] = 0.f; }
#pragma unroll 4
    for (int k = 0; k < 64; ++k) {
      const float wav = wa[k * 64 + d], wxv = wx[k * 64 + d];
#pragma unroll
      for (int tt = 0; tt < 8; ++tt) {
        const float xv = sX[(b8 * 8 + tt) * 256 + blk * 64 + k];
        ra[tt] += xv * wav; ia[tt] += xv * wxv;
      }
    }
#pragma unroll
    for (int tt = 0; tt < 8; ++tt) {
      const int t = b8 * 8 + tt;
      if (t < nT) {
        const float r = sigm(ra[tt] + ba), ig = sigm(ia[tt] + bx);
        const float la = -8.f * r * sp;
        const float bb = sqrtf(-expm1f(2.f * la)) * (ig * sX[t * 256 + c]);
        const size_t row = (size_t)(rowbase + t0 + t);
        LA[row * 256 + c] = f2bf(la);
        LB[row * 256 + c] = f2bf(bb);
      }
    }
  }
  if (t0 + nT == T) {
    float* o = st_out(p, O_PLRUC, O_SLRUC, l, s, 3 * 256);
#pragma unroll
    for (int r = 0; r < 3; ++r) o[r * 256 + c] = lru_xin(p, Zm, l, s, rowbase, T - 3 + r, c);
  }
}
DEV void lru_pass2(const P& p, int l, int s) {
  const int c = tid_();
  const int T = (s < 8) ? TP : 8;
  const int rowbase = rowbase_of(s);
  const u16* Zm = (const u16*)(p.ws + OFF_D + D_ZM);
  const u16* LA = (const u16*)(p.ws + OFF_D + D_LA);
  const u16* LB = (const u16*)(p.ws + OFF_D + D_LB);
  u16* BR = (u16*)(p.ws + OFF_D + D_BR);
  float h = (s >= 8) ? p.in[6][(size_t)(l * 128 + (s - 8)) * 256 + c] : 0.f;
  u16 na[8], nb[8], ng[8];
#pragma unroll
  for (int tt = 0; tt < 8; ++tt) {
    const size_t row = (size_t)(rowbase + tt);
    na[tt] = LA[row * 256 + c]; nb[tt] = LB[row * 256 + c]; ng[tt] = Zm[row * ZW + 1536 + c];
  }
  for (int t0 = 0; t0 < T; t0 += 8) {
    float la[8], lb[8], lg[8];
#pragma unroll
    for (int tt = 0; tt < 8; ++tt) { la[tt] = bf2f(na[tt]); lb[tt] = bf2f(nb[tt]); lg[tt] = bf2f(ng[tt]); }
    if (t0 + 8 < T) {
#pragma unroll
      for (int tt = 0; tt < 8; ++tt) {
        const size_t row = (size_t)(rowbase + t0 + 8 + tt);
        na[tt] = LA[row * 256 + c]; nb[tt] = LB[row * 256 + c]; ng[tt] = Zm[row * ZW + 1536 + c];
      }
    }
#pragma unroll
    for (int tt = 0; tt < 8; ++tt) {
      h = __expf(la[tt]) * h + lb[tt];
      BR[(size_t)(rowbase + t0 + tt) * 1024 + 512 + c] = f2bf(h * geluf_(lg[tt]));
    }
  }
  st_out(p, O_PLRU, O_SLRU, l, s, 256)[c] = h;
}

DEV void conv_item(const P& p, int l, int s, int t0, float* smem) {
  float* sG = smem;
  const int c = tid_(), lane = c & 63, w = c >> 6;
  const int T = (s < 8) ? TP : 8;
  const int nT = min(32, T - t0);
  const int rowbase = rowbase_of(s);
  const u16* Zm = (const u16*)(p.ws + OFF_D + D_ZM);
  u16* BR = (u16*)(p.ws + OFF_D + D_BR);
#pragma unroll 8
  for (int rr = 0; rr < 30 + nT; ++rr) {
    const int tau = t0 - 30 + rr;
    float gl = 0.f;
    if (tau >= 0) {
      const size_t row = (size_t)(rowbase + tau);
      gl = bf2f(Zm[row * ZW + 1792 + c]) * sigm(bf2f(Zm[row * ZW + 2048 + c]));
    } else if (s >= 8) gl = p.in[8][((size_t)(l * 128 + (s - 8)) * 30 + (30 + tau)) * 256 + c];
    sG[rr * 256 + c] = gl;
  }
  if (t0 + nT == T) {
    float* o = st_out(p, O_PCONV, O_SCONV, l, s, 30 * 256);
    for (int r = 0; r < 30; ++r) o[r * 256 + c] = sG[(nT + r) * 256 + c];
  }
  float wv[31];
#pragma unroll
  for (int j = 0; j < 31; ++j) wv[j] = p.in[36][(size_t)(l * 31 + j) * 256 + c];
  const float cb = p.in[37][l * 256 + c];
  for (int tt = 0; tt < nT; ++tt) {
    float y = cb;
#pragma unroll
    for (int j = 0; j < 31; ++j) y += wv[j] * sG[(tt + j) * 256 + c];
    sG[tt * 256 + c] = y;
  }
  __syncthreads();
  const float4 lg4 = *(const float4*)(p.in[38] + l * 256 + lane * 4);
  const float4 lb4 = *(const float4*)(p.in[39] + l * 256 + lane * 4);
  for (int tt = w; tt < nT; tt += 4) {
    const float4 v = *(const float4*)&sG[tt * 256 + lane * 4];
    float s1 = v.x + v.y + v.z + v.w;
    s1 = wave_sum(s1);
    const float mean = s1 * (1.f / 256.f);
    const float a0 = v.x - mean, a1 = v.y - mean, a2 = v.z - mean, a3 = v.w - mean;
    float s2 = a0 * a0 + a1 * a1 + a2 * a2 + a3 * a3;
    s2 = wave_sum(s2);
    const float rstd = rsqrtf(s2 * (1.f / 256.f) + 1e-6f);
    uint2 ov;
    ov.x = pack2(siluf_(a0 * rstd * lg4.x + lb4.x), siluf_(a1 * rstd * lg4.y + lb4.y));
    ov.y = pack2(siluf_(a2 * rstd * lg4.z + lb4.z), siluf_(a3 * rstd * lg4.w + lb4.w));
    *(uint2*)(BR + (size_t)(rowbase + t0 + tt) * 1024 + 768 + lane * 4) = ov;
  }
}

__global__ void __launch_bounds__(256, 2) mega(P p) {
  __shared__ __attribute__((aligned(16))) float smem[16128];
  __shared__ int s_item;
  cg::grid_group grid = cg::this_grid();
  u16* sA = (u16*)smem;
  u16* sB = sA + 128 * 72;
  const u16* W = (const u16*)(p.ws + OFF_W);
  const u16* XN = (const u16*)(p.ws + OFF_XN);
  float* X = (float*)(p.ws + OFF_X);
  u16* H = (u16*)(p.ws + OFF_D + D_H);
  u16* Zm = (u16*)(p.ws + OFF_D + D_ZM);
  const u16* M = (const u16*)(p.ws + OFF_D + D_M);
  int* ctr = (int*)p.ws;
  const int G = gridDim.x, B = blockIdx.x;

  for (int l = 0; l < 2; ++l) {
    phase_norm(p, l, 0);
    phase_convw(p, l, smem);
    grid.sync();
    for (int t = B; t < MT * 22; t += G) dual_tile256(XN, W + W_GU1, t % MT, t / MT, H, sA, sB);
    grid.sync();
    for (int t = B; t < MT * 8; t += G) resid_tile(H, 2816, 2816, W + W_DN1, t % MT, t / MT, X, 0.5f, sA, sB);
    grid.sync();
    phase_norm(p, l, 1);
    grid.sync();
    for (int t = B; t < MT * 9; t += G) zm_tile256(XN, W + W_INM, t % MT, t / MT, Zm, sA, sB);
    grid.sync();
    for (;;) {
      __syncthreads();
      if (threadIdx.x == 0) s_item = atomicAdd(&ctr[l * 2], 1);
      __syncthreads();
      const int it = s_item;
      if (it >= 3504) break;
      int ll = l;
      asm volatile("" : "+s"(ll));
      if (it < 128) s5_prompt(p, ll, it >> 4, it & 15, smem);
      else if (it < 1696) delta_pre(p, ll, it - 128, smem);
      else if (it < 2216) { int i = it - 1696; conv_item(p, ll, i / 65, (i % 65) * 32, smem); }
      else if (it < 2344) conv_item(p, ll, 8 + (it - 2216), 0, smem);
      else if (it < 2864) { int i = it - 2344; lru_pass1(p, ll, i / 65, (i % 65) * 32, smem); }
      else if (it < 2992) lru_pass1(p, ll, 8 + (it - 2864), 0, smem);
      else { int i = it - 2992; s5_block(p, ll, 8 + (i >> 2), i & 3, smem); }
    }
    grid.sync();
    for (;;) {
      __syncthreads();
      if (threadIdx.x == 0) s_item = atomicAdd(&ctr[l * 2 + 1], 1);
      __syncthreads();
      const int it = s_item;
      if (it >= 1228) break;
      int ll = l;
      asm volatile("" : "+s"(ll));
      if (it < 32) delta_seq(p, ll, it >> 2, it & 3, smem);
      else if (it < 40) lru_pass2(p, ll, it - 32);
      else if (it < 588) { int i = it - 40; dual_tile<1>((const u16*)(p.ws + OFF_D + D_Y5), 256, 256, W + W_GLU, i % MT, i / MT, (u16*)(p.ws + OFF_D + D_BR), 1024, 256, p.in[28] + ll * 512, sA, sB); }
      else if (it < 1100) { int i = it - 588; delta_seq(p, ll, 8 + (i >> 2), i & 3, smem); }
      else lru_pass2(p, ll, 8 + (it - 1100));
    }
    grid.sync();
    for (int t = B; t < MT * 16; t += G) g4_tile(p, t % MT, t / MT, sA, sB);
    grid.sync();
    for (int t = B; t < MT * 8; t += G) resid_tile(M, 1024, 1024, W + W_OUT, t % MT, t / MT, X, 1.0f, sA, sB);
    grid.sync();
    phase_norm(p, l, 2);
    grid.sync();
    for (int t = B; t < MT * 22; t += G) dual_tile256(XN, W + W_GU2, t % MT, t / MT, H, sA, sB);
    grid.sync();
    for (int t = B; t < MT * 8; t += G) resid_tile(H, 2816, 2816, W + W_DN2, t % MT, t / MT, X, 0.5f, sA, sB);
    grid.sync();
  }
  phase_norm(p, 0, 3);
}

extern "C" void kernel_launch(void* const* d_in, const int* in_sizes, int n_in, void* d_out, int out_size, void* d_ws,
                              size_t ws_size, hipStream_t stream) {
  P p{};
  for (int i = 0; i < 46; ++i) p.in[i] = (const float*)d_in[i];
  p.out = (float*)d_out;
  p.ws = (char*)d_ws;
  static int grid_blocks = 0;
  if (!grid_blocks) {
    int dev = 0, cus = 0, per = 0;
    hipGetDevice(&dev);
    hipDeviceGetAttribute(&cus, hipDeviceAttributeMultiprocessorCount, dev);
    hipOccupancyMaxActiveBlocksPerMultiprocessor(&per, mega, 256, 0);
    if (per > 2) per = 2;
    if (per < 1) per = 1;
    grid_blocks = cus * per;
  }
  if (ws_size < WS_NEED) fprintf(stderr, "workspace too small: %zu < %zu\n", ws_size, (size_t)WS_NEED);
  hipMemsetAsync(d_ws, 0, 256, stream);
  void* args[] = {&p};
  hipError_t e = hipLaunchCooperativeKernel((void*)mega, dim3(grid_blocks), dim3(256), args, 0, stream);
  if (e != hipSuccess) fprintf(stderr, "cooperative launch failed: %s (grid %d)\n", hipGetErrorString(e), grid_blocks);
}
```

```cpp
#include <hip/hip_runtime.h>
#include <hip/hip_bf16.h>
#include <hip/hip_cooperative_groups.h>
#include <cstdio>
namespace cg = cooperative_groups;

typedef unsigned short u16;
using bf16x8 = __attribute__((ext_vector_type(8))) short;
using f32x4 = __attribute__((ext_vector_type(4))) float;
using u32x4 = __attribute__((ext_vector_type(4))) unsigned int;
#define DEV __device__ __forceinline__

struct P { const float* in[46]; float* out; char* ws; };

constexpr int NTOK = 17536, TP = 2064, NPR = 16512, ZW = 2304, MT = 137;
constexpr size_t OFF_X = 65536;
constexpr size_t OFF_W = OFF_X + (size_t)NTOK * 1024 * 4;
constexpr size_t W_GU1 = 0, W_DN1 = 5767168, W_INM = 8650752, W_ING = 11010048, W_BR = 15204352, W_OUT = 16252928,
                 W_GLU = 17301504, W_GU2 = 17432576, W_DN2 = 23199744, W_END = 26083328;
constexpr size_t OFF_XN = OFF_W + W_END * 2;
constexpr size_t OFF_BA = OFF_XN + (size_t)NTOK * 1024 * 2;
constexpr size_t OFF_D = OFF_BA + (size_t)NTOK * 8 * 4;
constexpr size_t D_H = 0, D_ZM = 0, D_M = 0, D_BR = 80805888, D_LA = 116719616, D_LB = 125698048, D_Y5 = 134676480;
constexpr size_t WS_NEED = OFF_D + 143654912;
constexpr size_t OFF_GAMMA = 1024;
constexpr size_t O_YS = 16777216, O_PDELTA = 17825792, O_PDCONV = 18087936, O_PS5RE = 18124800, O_PS5IM = 18141184,
                 O_PLRU = 18157568, O_PLRUC = 18161664, O_PCONV = 18173952, O_SDELTA = 18296832, O_SDCONV = 22491136,
                 O_SS5RE = 23080960, O_SS5IM = 23343104, O_SLRU = 23605248, O_SLRUC = 23670784, O_SCONV = 23867392;

DEV u16 f2bf(float f) { unsigned u = __float_as_uint(f); u += 0x7fffu + ((u >> 16) & 1u); return (u16)(u >> 16); }
DEV float bf2f(u16 h) { return __uint_as_float(((unsigned)h) << 16); }
DEV float bflo(unsigned u) { return __uint_as_float(u << 16); }
DEV float bfhi(unsigned u) { return __uint_as_float(u & 0xffff0000u); }
DEV unsigned pack2(float a, float b) { return (unsigned)f2bf(a) | ((unsigned)f2bf(b) << 16); }
DEV float sigm(float x) { return 1.f / (1.f + __expf(-x)); }
DEV float siluf_(float x) { return x / (1.f + __expf(-x)); }
DEV float softplusf_(float x) { return fmaxf(x, 0.f) + log1pf(__expf(-fabsf(x))); }
DEV float geluf_(float x) { float u = 0.7978845608028654f * (x + 0.044715f * x * x * x); return 0.5f * x * (1.f + tanhf(u)); }
DEV float wave_sum(float v) {
#pragma unroll
  for (int o = 32; o > 0; o >>= 1) v += __shfl_xor(v, o, 64);
  return v;
}
DEV void unpack16(uint4 a, uint4 b, float (&x)[16]) {
  x[0] = bflo(a.x); x[1] = bfhi(a.x); x[2] = bflo(a.y); x[3] = bfhi(a.y); x[4] = bflo(a.z); x[5] = bfhi(a.z); x[6] = bflo(a.w); x[7] = bfhi(a.w);
  x[8] = bflo(b.x); x[9] = bfhi(b.x); x[10] = bflo(b.y); x[11] = bfhi(b.y); x[12] = bflo(b.z); x[13] = bfhi(b.z); x[14] = bflo(b.w); x[15] = bfhi(b.w);
}
DEV float* st_out(const P& p, size_t offP, size_t offS, int l, int s, int sz) {
  return s < 8 ? p.out + offP + (size_t)(l * 8 + s) * sz : p.out + offS + (size_t)(l * 128 + (s - 8)) * sz;
}
DEV int tid_() { int t = threadIdx.x; asm volatile("" : "+v"(t)); return t; }
DEV int rowbase_of(int s) { return s < 8 ? s * TP : NPR + (s - 8) * 8; }

DEV void phase_norm(const P& p, int l, int kind) {
  const int tid0 = tid_(); const int lane = tid0 & 63, w = tid0 >> 6;
  float* X = (float*)(p.ws + OFF_X);
  u16* XN = (u16*)(p.ws + OFF_XN);
  float* BA = (float*)(p.ws + OFF_BA);
  const float* gain = kind == 0 ? p.in[10] + l * 1024 : kind == 1 ? p.in[13] + l * 1024 : kind == 2 ? p.in[42] + l * 1024 : p.in[45];
  float4 g4[4];
#pragma unroll
  for (int i = 0; i < 4; ++i) g4[i] = *(const float4*)(gain + i * 256 + lane * 4);
  const bool first = (kind == 0 && l == 0);
  for (int r = blockIdx.x * 4 + w; r < NTOK; r += gridDim.x * 4) {
    const float* src;
    int b = 0, t = 0;
    if (r < NPR) { b = r / TP; t = r - b * TP; }
    if (first) {
      if (r < NPR) src = t < 16 ? p.in[9] + t * 1024 : p.in[0] + ((size_t)b * 2048 + (t - 16)) * 1024;
      else src = p.in[1] + (size_t)(r - NPR) * 1024;
    } else src = X + (size_t)r * 1024;
    float4 v[4];
    float ss = 0.f;
#pragma unroll
    for (int i = 0; i < 4; ++i) {
      v[i] = *(const float4*)(src + i * 256 + lane * 4);
      ss += v[i].x * v[i].x + v[i].y * v[i].y + v[i].z * v[i].z + v[i].w * v[i].w;
    }
    ss = wave_sum(ss);
    const float inv = rsqrtf(ss * (1.f / 1024.f) + 1e-6f);
    if (first) {
#pragma unroll
      for (int i = 0; i < 4; ++i) *(float4*)(X + (size_t)r * 1024 + i * 256 + lane * 4) = v[i];
    }
#pragma unroll
    for (int i = 0; i < 4; ++i) {
      v[i].x *= inv * g4[i].x; v[i].y *= inv * g4[i].y; v[i].z *= inv * g4[i].z; v[i].w *= inv * g4[i].w;
    }
    if (kind == 3) {
      float* dst;
      if (r < NPR) { if (t < 16) continue; dst = p.out + ((size_t)b * 2048 + (t - 16)) * 1024; }
      else dst = p.out + O_YS + (size_t)(r - NPR) * 1024;
#pragma unroll
      for (int i = 0; i < 4; ++i) *(float4*)(dst + i * 256 + lane * 4) = v[i];
    } else {
#pragma unroll
      for (int i = 0; i < 4; ++i) {
        uint2 o; o.x = pack2(v[i].x, v[i].y); o.y = pack2(v[i].z, v[i].w);
        *(uint2*)(XN + (size_t)r * 1024 + i * 256 + lane * 4) = o;
      }
      if (kind == 1) {
        const float* wi = p.in[14] + (size_t)l * 1024 * 6408 + 1024;
        float acc[8];
#pragma unroll
        for (int j = 0; j < 8; ++j) acc[j] = 0.f;
#pragma unroll
        for (int i = 0; i < 4; ++i) {
          const float yv[4] = {v[i].x, v[i].y, v[i].z, v[i].w};
#pragma unroll
          for (int e = 0; e < 4; ++e) {
            const float4* wr = (const float4*)(wi + (size_t)(i * 256 + lane * 4 + e) * 6408);
            float4 a = wr[0], c = wr[1];
            acc[0] += yv[e] * a.x; acc[1] += yv[e] * a.y; acc[2] += yv[e] * a.z; acc[3] += yv[e] * a.w;
            acc[4] += yv[e] * c.x; acc[5] += yv[e] * c.y; acc[6] += yv[e] * c.z; acc[7] += yv[e] * c.w;
          }
        }
#pragma unroll
        for (int j = 0; j < 8; ++j) acc[j] = wave_sum(acc[j]);
        if (lane == 0) {
          *(float4*)(BA + (size_t)r * 8) = make_float4(acc[0], acc[1], acc[2], acc[3]);
          *(float4*)(BA + (size_t)r * 8 + 4) = make_float4(acc[4], acc[5], acc[6], acc[7]);
        }
      }
    }
  }
}

DEV int wmap(int mode, int R, int c0, int half) {
  if (mode == 0) return c0 + R;
  if (mode == 1) { int tile = R >> 7, r = R & 127; int type = (r >> 4) & 1; return type * half + tile * 64 + (r >> 5) * 16 + (r & 15); }
  return R < 1024 ? R : R + 8;
}
DEV void convT(const float* __restrict__ src, int ld, int K, int NR, u16* __restrict__ dst, int mode, int c0, int half,
               int& tbase, float* smem) {
  const int tid = tid_(), G = gridDim.x;
  const int kt = K >> 6, ntile = kt * (NR >> 6);
  int start = ((int)blockIdx.x - tbase) % G;
  if (start < 0) start += G;
  for (int t = start; t < ntile; t += G) {
    const int rt = t / kt, k0 = (t - rt * kt) * 64, R0 = rt * 64;
    __syncthreads();
    const int rr = tid & 63;
    const int col = wmap(mode, R0 + rr, c0, half);
#pragma unroll
    for (int i = 0; i < 16; ++i) {
      int kk = i * 4 + (tid >> 6);
      smem[kk * 65 + rr] = src[(size_t)(k0 + kk) * ld + col];
    }
    __syncthreads();
    const int r2 = tid >> 2, seg = (tid & 3) * 16;
    unsigned o[8];
#pragma unroll
    for (int e = 0; e < 8; ++e) o[e] = pack2(smem[(seg + 2 * e) * 65 + r2], smem[(seg + 2 * e + 1) * 65 + r2]);
    uint4* d = (uint4*)(dst + (size_t)(R0 + r2) * K + k0 + seg);
    d[0] = make_uint4(o[0], o[1], o[2], o[3]);
    d[1] = make_uint4(o[4], o[5], o[6], o[7]);
  }
  tbase = (tbase + ntile) % G;
}
DEV void phase_convw(const P& p, int l, float* smem) {
  u16* W = (u16*)(p.ws + OFF_W);
  int tb = 0;
  convT(p.in[11] + (size_t)l * 1024 * 5632, 5632, 1024, 5632, W + W_GU1, 1, 0, 2816, tb, smem);
  convT(p.in[12] + (size_t)l * 2816 * 1024, 1024, 2816, 1024, W + W_DN1, 0, 0, 0, tb, smem);
  convT(p.in[14] + (size_t)l * 1024 * 6408, 6408, 1024, 2304, W + W_INM, 2, 0, 0, tb, smem);
  convT(p.in[14] + (size_t)l * 1024 * 6408, 6408, 1024, 4096, W + W_ING, 0, 2312, 0, tb, smem);
  for (int n = 0; n < 4; ++n)
    convT(p.in[40] + (size_t)(l * 4 + n) * 256 * 1024, 1024, 256, 1024, W + W_BR + (size_t)n * 1024 * 256, 0, 0, 0, tb, smem);
  convT(p.in[41] + (size_t)l * 1024 * 1024, 1024, 1024, 1024, W + W_OUT, 0, 0, 0, tb, smem);
  convT(p.in[27] + (size_t)l * 256 * 512, 512, 256, 512, W + W_GLU, 1, 0, 256, tb, smem);
  convT(p.in[43] + (size_t)l * 1024 * 5632, 5632, 1024, 5632, W + W_GU2, 1, 0, 2816, tb, smem);
  convT(p.in[44] + (size_t)l * 2816 * 1024, 1024, 2816, 1024, W + W_DN2, 0, 0, 0, tb, smem);
}

template <int BN>
DEV void gemm_acc(const u16* __restrict__ A, int lda, const u16* __restrict__ Bt, int ldb, int K, f32x4 (&acc)[4][BN / 32],
                  u16* sA, u16* sB) {
  constexpr int NI = BN / 32;
  const int tid = tid_(), lane = tid & 63, w = tid >> 6, wm = w >> 1, wn = w & 1;
  const int lrow = tid >> 3, lseg = (tid & 7) * 8;
  const u16* ga = A + (size_t)lrow * lda + lseg;
  const u16* gb = Bt + (size_t)lrow * ldb + lseg;
  u16* wa = sA + lrow * 72 + lseg;
  u16* wb = sB + lrow * 72 + lseg;
  const u16* fa = sA + (wm * 64 + (lane & 15)) * 72 + (lane >> 4) * 8;
  const u16* fb = sB + (wn * (BN / 2) + (lane & 15)) * 72 + (lane >> 4) * 8;
  u32x4 pa0, pa1, pa2, pa3, pb0, pb1, pb2, pb3, qa0, qa1, qa2, qa3, qb0, qb1, qb2, qb3;
#define GA_LOAD(X, koff) do { const u16* _ga = ga + (koff); const u16* _gb = gb + (koff); \
    X##a0 = *(const u32x4*)(_ga); X##a1 = *(const u32x4*)(_ga + (size_t)32 * lda); X##a2 = *(const u32x4*)(_ga + (size_t)64 * lda); X##a3 = *(const u32x4*)(_ga + (size_t)96 * lda); \
    X##b0 = *(const u32x4*)(_gb); X##b1 = *(const u32x4*)(_gb + (size_t)32 * ldb); \
    if (BN == 128) { X##b2 = *(const u32x4*)(_gb + (size_t)64 * ldb); X##b3 = *(const u32x4*)(_gb + (size_t)96 * ldb); } } while (0)
#define GA_WRITE(X) do { *(u32x4*)(wa) = X##a0; *(u32x4*)(wa + 32 * 72) = X##a1; *(u32x4*)(wa + 64 * 72) = X##a2; *(u32x4*)(wa + 96 * 72) = X##a3; \
    *(u32x4*)(wb) = X##b0; *(u32x4*)(wb + 32 * 72) = X##b1; \
    if (BN == 128) { *(u32x4*)(wb + 64 * 72) = X##b2; *(u32x4*)(wb + 96 * 72) = X##b3; } } while (0)
#define GA_COMPUTE() do { _Pragma("unroll") for (int kk = 0; kk < 64; kk += 32) { bf16x8 a[4], b[NI]; \
    _Pragma("unroll") for (int mi = 0; mi < 4; ++mi) a[mi] = *(const bf16x8*)(fa + mi * 16 * 72 + kk); \
    _Pragma("unroll") for (int ni = 0; ni < NI; ++ni) b[ni] = *(const bf16x8*)(fb + ni * 16 * 72 + kk); \
    _Pragma("unroll") for (int mi = 0; mi < 4; ++mi) _Pragma("unroll") for (int ni = 0; ni < NI; ++ni) \
      acc[mi][ni] = __builtin_amdgcn_mfma_f32_16x16x32_bf16(a[mi], b[ni], acc[mi][ni], 0, 0, 0); } } while (0)
  GA_LOAD(p, 0);
  if (K > 64) GA_LOAD(q, 64);
  for (int k0 = 0; k0 < K; k0 += 128) {
    __syncthreads();
    GA_WRITE(p);
    __syncthreads();
    if (k0 + 128 < K) GA_LOAD(p, k0 + 128);
    GA_COMPUTE();
    if (k0 + 64 >= K) break;
    __syncthreads();
    GA_WRITE(q);
    __syncthreads();
    if (k0 + 192 < K) GA_LOAD(q, k0 + 192);
    GA_COMPUTE();
  }
#undef GA_LOAD
#undef GA_WRITE
#undef GA_COMPUTE
}

template <int MODE>
DEV void dual_tile(const u16* A, int lda, int K, const u16* Wt, int mt, int nt, u16* out, int ldo, int ocol0, const float* bias,
                   u16* sA, u16* sB) {
  f32x4 acc[4][4];
#pragma unroll
  for (int i = 0; i < 4; ++i)
#pragma unroll
    for (int j = 0; j < 4; ++j) acc[i][j] = (f32x4){0.f, 0.f, 0.f, 0.f};
  gemm_acc<128>(A + (size_t)mt * 128 * lda, lda, Wt + (size_t)nt * 128 * K, K, K, acc, sA, sB);
  const int tid0 = tid_(); const int lane = tid0 & 63, w = tid0 >> 6, wm = w >> 1, wn = w & 1;
#pragma unroll
  for (int mi = 0; mi < 4; ++mi)
#pragma unroll
    for (int np = 0; np < 2; ++np) {
      const int col = nt * 64 + (wn * 2 + np) * 16 + (lane & 15);
      float b0 = 0.f, b1 = 0.f;
      if (MODE == 1) { b0 = bias[col]; b1 = bias[256 + col]; }
#pragma unroll
      for (int j = 0; j < 4; ++j) {
        const int row = mt * 128 + wm * 64 + mi * 16 + (lane >> 4) * 4 + j;
        float g = acc[mi][2 * np][j], u = acc[mi][2 * np + 1][j];
        float v = (MODE == 0) ? siluf_(g) * u : (g + b0) * sigm(u + b1);
        out[(size_t)row * ldo + ocol0 + col] = f2bf(v);
      }
    }
}
DEV void resid_tile(const u16* A, int lda, int K, const u16* Wt, int mt, int nt, float* X, float scale, u16* sA, u16* sB) {
  f32x4 acc[4][4];
#pragma unroll
  for (int i = 0; i < 4; ++i)
#pragma unroll
    for (int j = 0; j < 4; ++j) acc[i][j] = (f32x4){0.f, 0.f, 0.f, 0.f};
  gemm_acc<128>(A + (size_t)mt * 128 * lda, lda, Wt + (size_t)nt * 128 * K, K, K, acc, sA, sB);
  const int tid0 = tid_(); const int lane = tid0 & 63, w = tid0 >> 6, wm = w >> 1, wn = w & 1;
#pragma unroll
  for (int mi = 0; mi < 4; ++mi)
#pragma unroll
    for (int ni = 0; ni < 4; ++ni) {
      const int col = nt * 128 + wn * 64 + ni * 16 + (lane & 15);
#pragma unroll
      for (int j = 0; j < 4; ++j) {
        const int row = mt * 128 + wm * 64 + mi * 16 + (lane >> 4) * 4 + j;
        X[(size_t)row * 1024 + col] += scale * acc[mi][ni][j];
      }
    }
}
DEV void zm_tile(const u16* A, const u16* Wt, int mt, int nt, u16* Zm, u16* sA, u16* sB) {
  f32x4 acc[4][4];
#pragma unroll
  for (int i = 0; i < 4; ++i)
#pragma unroll
    for (int j = 0; j < 4; ++j) acc[i][j] = (f32x4){0.f, 0.f, 0.f, 0.f};
  gemm_acc<128>(A + (size_t)mt * 128 * 1024, 1024, Wt + (size_t)nt * 128 * 1024, 1024, 1024, acc, sA, sB);
  const int tid0 = tid_(); const int lane = tid0 & 63, w = tid0 >> 6, wm = w >> 1, wn = w & 1;
#pragma unroll
  for (int mi = 0; mi < 4; ++mi)
#pragma unroll
    for (int ni = 0; ni < 4; ++ni) {
      const int col = nt * 128 + wn * 64 + ni * 16 + (lane & 15);
#pragma unroll
      for (int j = 0; j < 4; ++j) {
        const int row = mt * 128 + wm * 64 + mi * 16 + (lane >> 4) * 4 + j;
        Zm[(size_t)row * ZW + col] = f2bf(acc[mi][ni][j]);
      }
    }
}

DEV void gemm_acc256(const u16* __restrict__ A, int lda, const u16* __restrict__ Bt, int ldb, int K, f32x4 (&acc)[4][8],
                     u16* sA, u16* sB) {
  const int tid = tid_(), lane = tid & 63, w = tid >> 6, wm = w >> 1, wn = w & 1;
  const int lrow = tid >> 3, lseg = (tid & 7) * 8;
  const u16* ga = A + (size_t)lrow * lda + lseg;
  const u16* gb = Bt + (size_t)lrow * ldb + lseg;
  u16* wa = sA + lrow * 72 + lseg;
  u16* wb = sB + lrow * 72 + lseg;
  const u16* fa = sA + (wm * 64 + (lane & 15)) * 72 + (lane >> 4) * 8;
  const u16* fb = sB + (wn * 128 + (lane & 15)) * 72 + (lane >> 4) * 8;
  u32x4 ra0, ra1, ra2, ra3, rb0, rb1, rb2, rb3, rb4, rb5, rb6, rb7;
  ra0 = *(const u32x4*)(ga);
  ra1 = *(const u32x4*)(ga + (size_t)32 * lda);
  ra2 = *(const u32x4*)(ga + (size_t)64 * lda);
  ra3 = *(const u32x4*)(ga + (size_t)96 * lda);
  rb0 = *(const u32x4*)(gb);
  rb1 = *(const u32x4*)(gb + (size_t)32 * ldb);
  rb2 = *(const u32x4*)(gb + (size_t)64 * ldb);
  rb3 = *(const u32x4*)(gb + (size_t)96 * ldb);
  rb4 = *(const u32x4*)(gb + (size_t)128 * ldb);
  rb5 = *(const u32x4*)(gb + (size_t)160 * ldb);
  rb6 = *(const u32x4*)(gb + (size_t)192 * ldb);
  rb7 = *(const u32x4*)(gb + (size_t)224 * ldb);
  for (int k0 = 0; k0 < K; k0 += 64) {
    __syncthreads();
    *(u32x4*)(wa) = ra0; *(u32x4*)(wa + 32 * 72) = ra1; *(u32x4*)(wa + 64 * 72) = ra2; *(u32x4*)(wa + 96 * 72) = ra3;
    *(u32x4*)(wb) = rb0; *(u32x4*)(wb + 32 * 72) = rb1; *(u32x4*)(wb + 64 * 72) = rb2; *(u32x4*)(wb + 96 * 72) = rb3;
    *(u32x4*)(wb + 128 * 72) = rb4; *(u32x4*)(wb + 160 * 72) = rb5; *(u32x4*)(wb + 192 * 72) = rb6; *(u32x4*)(wb + 224 * 72) = rb7;
    __syncthreads();
    if (k0 + 64 < K) {
      const u16* ga2 = ga + k0 + 64;
      const u16* gb2 = gb + k0 + 64;
      ra0 = *(const u32x4*)(ga2);
      ra1 = *(const u32x4*)(ga2 + (size_t)32 * lda);
      ra2 = *(const u32x4*)(ga2 + (size_t)64 * lda);
      ra3 = *(const u32x4*)(ga2 + (size_t)96 * lda);
      rb0 = *(const u32x4*)(gb2);
      rb1 = *(const u32x4*)(gb2 + (size_t)32 * ldb);
      rb2 = *(const u32x4*)(gb2 + (size_t)64 * ldb);
      rb3 = *(const u32x4*)(gb2 + (size_t)96 * ldb);
      rb4 = *(const u32x4*)(gb2 + (size_t)128 * ldb);
      rb5 = *(const u32x4*)(gb2 + (size_t)160 * ldb);
      rb6 = *(const u32x4*)(gb2 + (size_t)192 * ldb);
      rb7 = *(const u32x4*)(gb2 + (size_t)224 * ldb);
    }
#pragma unroll
    for (int kk = 0; kk < 64; kk += 32) {
      bf16x8 a[4];
#pragma unroll
      for (int mi = 0; mi < 4; ++mi) a[mi] = *(const bf16x8*)(fa + mi * 16 * 72 + kk);
#pragma unroll
      for (int nh = 0; nh < 2; ++nh) {
        bf16x8 b[4];
#pragma unroll
        for (int ni = 0; ni < 4; ++ni) b[ni] = *(const bf16x8*)(fb + (nh * 4 + ni) * 16 * 72 + kk);
#pragma unroll
        for (int mi = 0; mi < 4; ++mi)
#pragma unroll
          for (int ni = 0; ni < 4; ++ni)
            acc[mi][nh * 4 + ni] = __builtin_amdgcn_mfma_f32_16x16x32_bf16(a[mi], b[ni], acc[mi][nh * 4 + ni], 0, 0, 0);
      }
    }
  }
}
DEV void dual_tile256(const u16* A, const u16* Wt, int mt, int nt, u16* out, u16* sA, u16* sB) {
  f32x4 acc[4][8];
#pragma unroll
  for (int i = 0; i < 4; ++i)
#pragma unroll
    for (int j = 0; j < 8; ++j) acc[i][j] = (f32x4){0.f, 0.f, 0.f, 0.f};
  gemm_acc256(A + (size_t)mt * 128 * 1024, 1024, Wt + (size_t)nt * 256 * 1024, 1024, 1024, acc, sA, sB);
  const int tid0 = tid_(); const int lane = tid0 & 63, w = tid0 >> 6, wm = w >> 1, wn = w & 1;
#pragma unroll
  for (int mi = 0; mi < 4; ++mi)
#pragma unroll
    for (int np = 0; np < 4; ++np) {
      const int col = (nt * 2 + wn) * 64 + np * 16 + (lane & 15);
#pragma unroll
      for (int j = 0; j < 4; ++j) {
        const int row = mt * 128 + wm * 64 + mi * 16 + (lane >> 4) * 4 + j;
        out[(size_t)row * 2816 + col] = f2bf(siluf_(acc[mi][2 * np][j]) * acc[mi][2 * np + 1][j]);
      }
    }
}
DEV void zm_tile256(const u16* A, const u16* Wt, int mt, int nt, u16* Zm, u16* sA, u16* sB) {
  f32x4 acc[4][8];
#pragma unroll
  for (int i = 0; i < 4; ++i)
#pragma unroll
    for (int j = 0; j < 8; ++j) acc[i][j] = (f32x4){0.f, 0.f, 0.f, 0.f};
  gemm_acc256(A + (size_t)mt * 128 * 1024, 1024, Wt + (size_t)nt * 256 * 1024, 1024, 1024, acc, sA, sB);
  const int tid0 = tid_(); const int lane = tid0 & 63, w = tid0 >> 6, wm = w >> 1, wn = w & 1;
#pragma unroll
  for (int mi = 0; mi < 4; ++mi)
#pragma unroll
    for (int ni = 0; ni < 8; ++ni) {
      const int col = nt * 256 + wn * 128 + ni * 16 + (lane & 15);
#pragma unroll
      for (int j = 0; j < 4; ++j) {
        const int row = mt * 128 + wm * 64 + mi * 16 + (lane >> 4) * 4 + j;
        Zm[(size_t)row * ZW + col] = f2bf(acc[mi][ni][j]);
      }
    }
}
DEV void g4_tile(const P& p, int mt, int nt, u16* sA, u16* sB) {
  const u16* BR = (const u16*)(p.ws + OFF_D + D_BR);
  const u16* XN = (const u16*)(p.ws + OFF_XN);
  const u16* Wb = (const u16*)(p.ws + OFF_W) + W_BR;
  const u16* Wg = (const u16*)(p.ws + OFF_W) + W_ING;
  u16* M = (u16*)(p.ws + OFF_D + D_M);
  f32x4 accM[4][2];
#pragma unroll
  for (int i = 0; i < 4; ++i)
#pragma unroll
    for (int j = 0; j < 2; ++j) accM[i][j] = (f32x4){0.f, 0.f, 0.f, 0.f};
#pragma unroll 1
  for (int n = 0; n < 4; ++n) {
    unsigned gate[4][2][2];
    {
      f32x4 accG[4][2];
#pragma unroll
      for (int i = 0; i < 4; ++i)
#pragma unroll
        for (int j = 0; j < 2; ++j) accG[i][j] = (f32x4){0.f, 0.f, 0.f, 0.f};
      gemm_acc<64>(XN + (size_t)mt * 128 * 1024, 1024, Wg + ((size_t)n * 1024 + nt * 64) * 1024, 1024, 1024, accG, sA, sB);
#pragma unroll
      for (int i = 0; i < 4; ++i)
#pragma unroll
        for (int j = 0; j < 2; ++j) {
          gate[i][j][0] = pack2(sigm(accG[i][j][0]), sigm(accG[i][j][1]));
          gate[i][j][1] = pack2(sigm(accG[i][j][2]), sigm(accG[i][j][3]));
        }
    }
    f32x4 accP[4][2];
#pragma unroll
    for (int i = 0; i < 4; ++i)
#pragma unroll
      for (int j = 0; j < 2; ++j) accP[i][j] = (f32x4){0.f, 0.f, 0.f, 0.f};
    gemm_acc<64>(BR + (size_t)mt * 128 * 1024 + n * 256, 1024, Wb + ((size_t)n * 1024 + nt * 64) * 256, 256, 256, accP, sA, sB);
#pragma unroll
    for (int i = 0; i < 4; ++i)
#pragma unroll
      for (int j = 0; j < 2; ++j) {
        accM[i][j][0] += bflo(gate[i][j][0]) * accP[i][j][0];
        accM[i][j][1] += bfhi(gate[i][j][0]) * accP[i][j][1];
        accM[i][j][2] += bflo(gate[i][j][1]) * accP[i][j][2];
        accM[i][j][3] += bfhi(gate[i][j][1]) * accP[i][j][3];
      }
  }
  const int tid0 = tid_(); const int lane = tid0 & 63, w = tid0 >> 6, wm = w >> 1, wn = w & 1;
#pragma unroll
  for (int mi = 0; mi < 4; ++mi)
#pragma unroll
    for (int ni = 0; ni < 2; ++ni) {
      const int col = nt * 64 + wn * 32 + ni * 16 + (lane & 15);
#pragma unroll
      for (int j = 0; j < 4; ++j) {
        const int row = mt * 128 + wm * 64 + mi * 16 + (lane >> 4) * 4 + j;
        M[(size_t)row * 1024 + col] = f2bf(accM[mi][ni][j]);
      }
    }
}

DEV void dn_conv16(const u16* __restrict__ Zm, const float* __restrict__ buf, const float* __restrict__ cw, int rowbase, int t, int c,
                   float (&o)[16]) {
#pragma unroll
  for (int e = 0; e < 16; ++e) o[e] = 0.f;
#pragma unroll
  for (int tap = 0; tap < 4; ++tap) {
    const int tau = t - 3 + tap;
    float x[16];
    if (tau >= 0) {
      const uint4* z = (const uint4*)(Zm + (size_t)(rowbase + tau) * ZW + c);
      unpack16(z[0], z[1], x);
    } else if (buf) {
      const float4* bb = (const float4*)(buf + (3 + tau) * 768 + c);
#pragma unroll
      for (int q = 0; q < 4; ++q) { float4 f = bb[q]; x[q * 4] = f.x; x[q * 4 + 1] = f.y; x[q * 4 + 2] = f.z; x[q * 4 + 3] = f.w; }
    } else {
#pragma unroll
      for (int e = 0; e < 16; ++e) x[e] = 0.f;
    }
    const float4* w4 = (const float4*)(cw + tap * 768 + c);
#pragma unroll
    for (int q = 0; q < 4; ++q) {
      float4 f = w4[q];
      o[q * 4] += f.x * x[q * 4]; o[q * 4 + 1] += f.y * x[q * 4 + 1]; o[q * 4 + 2] += f.z * x[q * 4 + 2]; o[q * 4 + 3] += f.w * x[q * 4 + 3];
    }
  }
#pragma unroll
  for (int e = 0; e < 16; ++e) o[e] = siluf_(o[e]);
}

DEV void delta_pre(const P& p, int l, int idx, float* smem) {
  float* sq = smem;
  float* sk = smem + 64 * 68;
  float* sL = smem + 2 * 64 * 68;
  float* sbeta = sL + 4096;
  float* sg = sbeta + 64;
  float* sgc = sg + 64;
  int s, h, j, pad, T;
  if (idx < 1056) { s = idx / 132; int r = idx - s * 132; h = r / 33; j = r - h * 33; pad = 48; T = TP; }
  else { int r = idx - 1056; s = 8 + (r >> 2); h = r & 3; j = 0; pad = 56; T = 8; }
  const int tid = tid_();
  const u16* Zm = (const u16*)(p.ws + OFF_D + D_ZM);
  const float* BA = (const float*)(p.ws + OFF_BA);
  const float* cw = p.in[15] + l * 4 * 768;
  const float* buf = (s >= 8) ? p.in[3] + (size_t)(l * 128 + (s - 8)) * 3 * 768 : nullptr;
  const int rowbase = rowbase_of(s);
  u16* wsb = (u16*)p.out + (size_t)idx * 20480;
  float* gamma = (float*)(p.ws + OFF_GAMMA);
  {
    const int i = tid >> 2, dq = (tid & 3) * 16;
    const int t = j * 64 + i - pad;
    float qv[16], kv[16];
    float sq_ = 0.f, sk_ = 0.f;
    if (t >= 0) {
      dn_conv16(Zm, buf, cw, rowbase, t, h * 64 + dq, qv);
      dn_conv16(Zm, buf, cw, rowbase, t, 256 + h * 64 + dq, kv);
#pragma unroll
      for (int e = 0; e < 16; ++e) { sq_ += qv[e] * qv[e]; sk_ += kv[e] * kv[e]; }
    } else {
#pragma unroll
      for (int e = 0; e < 16; ++e) { qv[e] = 0.f; kv[e] = 0.f; }
    }
    sq_ += __shfl_xor(sq_, 1, 64); sq_ += __shfl_xor(sq_, 2, 64);
    sk_ += __shfl_xor(sk_, 1, 64); sk_ += __shfl_xor(sk_, 2, 64);
    const float qs = rsqrtf(sq_ + 1e-6f) * 0.125f, ks = rsqrtf(sk_ + 1e-6f);
#pragma unroll
    for (int e = 0; e < 16; ++e) { sq[i * 68 + dq + e] = qv[e] * qs; sk[i * 68 + dq + e] = kv[e] * ks; }
  }
  if (tid < 64) {
    const int t = j * 64 + tid - pad;
    float be = 0.f, g = 0.f;
    if (t >= 0) {
      const float* ba = BA + (size_t)(rowbase + t) * 8;
      be = sigm(ba[h]);
      float a = ba[4 + h] + p.in[17][l * 4 + h];
      g = -expf(p.in[16][l * 4 + h]) * softplusf_(a);
    }
    sbeta[tid] = be;
    sg[tid] = g;
  }
  __syncthreads();
  if (tid < 64) {
    float c = 0.f;
    for (int i2 = 0; i2 <= tid; ++i2) c += sg[i2];
    sgc[tid] = c;
  }
  __syncthreads();
  {
    const int ti = tid >> 4, tj = tid & 15;
    float aL[4][4], aI[4][4];
#pragma unroll
    for (int a = 0; a < 4; ++a)
#pragma unroll
      for (int b = 0; b < 4; ++b) { aL[a][b] = 0.f; aI[a][b] = 0.f; }
    for (int d = 0; d < 64; d += 4) {
      float4 qa[4], ka[4], kb[4];
#pragma unroll
      for (int a = 0; a < 4; ++a) { qa[a] = *(const float4*)&sq[(ti + 16 * a) * 68 + d]; ka[a] = *(const float4*)&sk[(ti + 16 * a) * 68 + d]; }
#pragma unroll
      for (int b = 0; b < 4; ++b) kb[b] = *(const float4*)&sk[(tj + 16 * b) * 68 + d];
#pragma unroll
      for (int a = 0; a < 4; ++a)
#pragma unroll
        for (int b = 0; b < 4; ++b) {
          aL[a][b] += ka[a].x * kb[b].x + ka[a].y * kb[b].y + ka[a].z * kb[b].z + ka[a].w * kb[b].w;
          aI[a][b] += qa[a].x * kb[b].x + qa[a].y * kb[b].y + qa[a].z * kb[b].z + qa[a].w * kb[b].w;
        }
    }
#pragma unroll
    for (int a = 0; a < 4; ++a)
#pragma unroll
      for (int b = 0; b < 4; ++b) {
        const int i = ti + 16 * a, jj = tj + 16 * b;
        const float dec = (jj <= i) ? __expf(sgc[i] - sgc[jj]) : 0.f;
        sL[i * 64 + jj] = (jj < i) ? aL[a][b] * sbeta[i] * dec : 0.f;
        wsb[3 * 4096 + i * 64 + jj] = f2bf(aI[a][b] * dec);
      }
  }
  for (int e = tid; e < 4096; e += 256) {
    const int i = e >> 6, d = e & 63;
    wsb[2 * 4096 + e] = f2bf(sq[i * 68 + d] * __expf(sgc[i]));
  }
  for (int e = tid; e < 4096; e += 256) {
    const int d = e >> 6, i = e & 63;
    wsb[4 * 4096 + e] = f2bf(sk[i * 68 + d] * __expf(sgc[63] - sgc[i]));
  }
  if (tid == 0) gamma[idx] = __expf(sgc[63]);
  __syncthreads();
  {
    const int i = tid >> 2, dq = (tid & 3) * 16;
    const int t = j * 64 + i - pad;
    float vv[16];
    if (t >= 0) dn_conv16(Zm, buf, cw, rowbase, t, 512 + h * 64 + dq, vv);
    else {
#pragma unroll
      for (int e = 0; e < 16; ++e) vv[e] = 0.f;
    }
    const float be = sbeta[i], eg = be * __expf(sgc[i]);
#pragma unroll
    for (int e = 0; e < 16; ++e) { sq[i * 68 + dq + e] = vv[e] * be; sk[i * 68 + dq + e] *= eg; }
  }
  __syncthreads();
  {
    float* arr = (tid < 128) ? sq : sk;
    const int col = (tid >> 1) & 63, hf = tid & 1;
    for (int i = 1; i < 64; ++i) {
      float acc = 0.f;
      for (int j0 = hf * 4; j0 < i; j0 += 8) {
        const float4 l4 = *(const float4*)&sL[i * 64 + j0];
        acc -= l4.x * arr[j0 * 68 + col] + l4.y * arr[(j0 + 1) * 68 + col] + l4.z * arr[(j0 + 2) * 68 + col] + l4.w * arr[(j0 + 3) * 68 + col];
      }
      acc += __shfl_xor(acc, 1, 64);
      if (hf == 0) arr[i * 68 + col] += acc;
    }
  }
  __syncthreads();
  for (int e = tid; e < 4096; e += 256) {
    const int i = e >> 6, d = e & 63;
    wsb[e] = f2bf(sq[i * 68 + d]);
    wsb[4096 + e] = f2bf(sk[i * 68 + d]);
  }
  if (h == 0 && j == (s < 8 ? 32 : 0)) {
    float* o = st_out(p, O_PDCONV, O_SDCONV, l, s, 3 * 768);
    for (int e = tid; e < 3 * 768; e += 256) {
      const int r = e / 768, c = e - r * 768;
      o[e] = bf2f(Zm[(size_t)(rowbase + T - 3 + r) * ZW + c]);
    }
  }
}

DEV void mm64(const float* __restrict__ A, const float* __restrict__ B, float (&acc)[4][4], int ti, int tj) {
#pragma unroll 4
  for (int kk = 0; kk < 64; kk += 4) {
    float4 a[4], b[4];
#pragma unroll
    for (int x = 0; x < 4; ++x) a[x] = *(const float4*)&A[(ti + 16 * x) * 68 + kk];
#pragma unroll
    for (int y = 0; y < 4; ++y) b[y] = *(const float4*)&B[(kk + y) * 64 + tj * 4];
#pragma unroll
    for (int x = 0; x < 4; ++x) {
      acc[x][0] += a[x].x * b[0].x + a[x].y * b[1].x + a[x].z * b[2].x + a[x].w * b[3].x;
      acc[x][1] += a[x].x * b[0].y + a[x].y * b[1].y + a[x].z * b[2].y + a[x].w * b[3].y;
      acc[x][2] += a[x].x * b[0].z + a[x].y * b[1].z + a[x].z * b[2].z + a[x].w * b[3].z;
      acc[x][3] += a[x].x * b[0].w + a[x].y * b[1].w + a[x].z * b[2].w + a[x].w * b[3].w;
    }
  }
}
DEV void storeA16(float* sA, uint4 r0, uint4 r1) {
  const int tid = tid_();
  float x[16];
  unpack16(r0, r1, x);
  float* d = sA + (tid >> 2) * 68 + (tid & 3) * 16;
#pragma unroll
  for (int q = 0; q < 4; ++q) *(float4*)(d + q * 4) = make_float4(x[q * 4], x[q * 4 + 1], x[q * 4 + 2], x[q * 4 + 3]);
}

DEV void delta_seq(const P& p, int l, int s, int h, float* smem) {
  float* sS = smem;
  float* sV = smem + 4096;
  float* sA = smem + 8192;
  const int tid = tid_(), ti = tid >> 4, tj = tid & 15;
  const int n = (s < 8) ? 33 : 1, pad = (s < 8) ? 48 : 56;
  const int item0 = (s < 8) ? (s * 4 + h) * 33 : 1056 + (s - 8) * 4 + h;
  const int rowbase = rowbase_of(s);
  const float* s0 = (s >= 8) ? p.in[2] + (size_t)((l * 128 + (s - 8)) * 4 + h) * 4096 : nullptr;
  for (int e = tid; e < 4096; e += 256) sS[e] = s0 ? s0[e] : 0.f;
  const u16* wsb = (const u16*)p.out + (size_t)item0 * 20480;
  const float* gamma = (const float*)(p.ws + OFF_GAMMA) + item0;
  const u16* Zm = (const u16*)(p.ws + OFF_D + D_ZM);
  u16* BR = (u16*)(p.ws + OFF_D + D_BR);
  const float4 ng = *(const float4*)(p.in[18] + l * 64 + tj * 4);
  uint4 r0, r1;
  { const uint4* src = (const uint4*)(wsb + 4096 + tid * 16); r0 = src[0]; r1 = src[1]; }
  for (int j = 0; j < n; ++j) {
    const u16* it = wsb + (size_t)j * 20480;
    uint2 uu_pf[4], zz_pf[4];
#pragma unroll
    for (int a = 0; a < 4; ++a) {
      const int i = ti + 16 * a;
      uu_pf[a] = *(const uint2*)(it + i * 64 + tj * 4);
      const int t = j * 64 + i - pad;
      zz_pf[a] = (t >= 0) ? *(const uint2*)(Zm + (size_t)(rowbase + t) * ZW + 768 + h * 64 + tj * 4) : make_uint2(0u, 0u);
    }
    const float gm = gamma[j];
    __syncthreads();
    storeA16(sA, r0, r1);
    __syncthreads();
    { const uint4* src = (const uint4*)(it + 2 * 4096 + tid * 16); r0 = src[0]; r1 = src[1]; }
    float acc[4][4];
#pragma unroll
    for (int a = 0; a < 4; ++a)
#pragma unroll
      for (int c = 0; c < 4; ++c) acc[a][c] = 0.f;
    mm64(sA, sS, acc, ti, tj);
#pragma unroll
    for (int a = 0; a < 4; ++a) {
      const int i = ti + 16 * a;
      const uint2 uu = uu_pf[a];
      *(float4*)&sV[i * 64 + tj * 4] = make_float4(bflo(uu.x) - acc[a][0], bfhi(uu.x) - acc[a][1], bflo(uu.y) - acc[a][2], bfhi(uu.y) - acc[a][3]);
    }
    __syncthreads();
    storeA16(sA, r0, r1);
    __syncthreads();
    { const uint4* src = (const uint4*)(it + 3 * 4096 + tid * 16); r0 = src[0]; r1 = src[1]; }
    float o[4][4];
#pragma unroll
    for (int a = 0; a < 4; ++a)
#pragma unroll
      for (int c = 0; c < 4; ++c) o[a][c] = 0.f;
    mm64(sA, sS, o, ti, tj);
    __syncthreads();
    storeA16(sA, r0, r1);
    __syncthreads();
    { const uint4* src = (const uint4*)(it + 4 * 4096 + tid * 16); r0 = src[0]; r1 = src[1]; }
    mm64(sA, sV, o, ti, tj);
#pragma unroll
    for (int a = 0; a < 4; ++a) {
      const int i = ti + 16 * a;
      const int t = j * 64 + i - pad;
      float ss = o[a][0] * o[a][0] + o[a][1] * o[a][1] + o[a][2] * o[a][2] + o[a][3] * o[a][3];
      ss += __shfl_xor(ss, 1, 64); ss += __shfl_xor(ss, 2, 64); ss += __shfl_xor(ss, 4, 64); ss += __shfl_xor(ss, 8, 64);
      if (t >= 0) {
        const float inv = rsqrtf(ss * (1.f / 64.f) + 1e-6f);
        const size_t row = (size_t)(rowbase + t);
        const uint2 zz = zz_pf[a];
        float y0 = o[a][0] * inv * ng.x * siluf_(bflo(zz.x));
        float y1 = o[a][1] * inv * ng.y * siluf_(bfhi(zz.x));
        float y2 = o[a][2] * inv * ng.z * siluf_(bflo(zz.y));
        float y3 = o[a][3] * inv * ng.w * siluf_(bfhi(zz.y));
        uint2 ov; ov.x = pack2(y0, y1); ov.y = pack2(y2, y3);
        *(uint2*)(BR + row * 1024 + h * 64 + tj * 4) = ov;
      }
    }
    __syncthreads();
    storeA16(sA, r0, r1);
    __syncthreads();
    if (j + 1 < n) { const uint4* src = (const uint4*)(it + 20480 + 4096 + tid * 16); r0 = src[0]; r1 = src[1]; }
#pragma unroll
    for (int a = 0; a < 4; ++a)
#pragma unroll
      for (int c = 0; c < 4; ++c) acc[a][c] = 0.f;
    mm64(sA, sV, acc, ti, tj);
#pragma unroll
    for (int a = 0; a < 4; ++a) {
      float4* sp = (float4*)&sS[(ti + 16 * a) * 64 + tj * 4];
      float4 old = *sp;
      *sp = make_float4(gm * old.x + acc[a][0], gm * old.y + acc[a][1], gm * old.z + acc[a][2], gm * old.w + acc[a][3]);
    }
  }
  __syncthreads();
  float* so = st_out(p, O_PDELTA, O_SDELTA, l, s, 4 * 4096) + h * 4096;
  for (int e = tid; e < 4096; e += 256) so[e] = sS[e];
}

DEV void s5_block(const P& p, int l, int s, int gq, float* smem) {
  const int tid = tid_(), lane = tid & 63;
  const int w = __builtin_amdgcn_readfirstlane(tid >> 6);
  const int g = gq * 4 + w;
  float* sC = smem + w * 3248;
  float* sH = sC + 2080;
  float* sU = sH + 1040;
  const int T = (s < 8) ? TP : 8;
  const int rowbase = rowbase_of(s);
  const u16* Zm = (const u16*)(p.ws + OFF_D + D_ZM);
  u16* Y5 = (u16*)(p.ws + OFF_D + D_Y5);
  const int lg_ = l * 16 + g;
  const float lr = p.in[19][lg_ * 64 + lane], li = p.in[20][lg_ * 64 + lane];
  const float dt = expf(p.in[21][lg_]);
  const float mag = expf(lr * dt);
  const float lbr = mag * cosf(li * dt), lbi = mag * sinf(li * dt);
  const float den = lr * lr + li * li;
  const float cfr = ((lbr - 1.f) * lr + lbi * li) / den, cfi = (lbi * lr - (lbr - 1.f) * li) / den;
  float xr_c[16], xi_c[16];
  {
    const float4* br4 = (const float4*)(p.in[22] + ((size_t)lg_ * 64 + lane) * 16);
    const float4* bi4 = (const float4*)(p.in[23] + ((size_t)lg_ * 64 + lane) * 16);
#pragma unroll
    for (int q = 0; q < 4; ++q) {
      float4 a = br4[q], b = bi4[q];
      xr_c[q * 4] = cfr * a.x - cfi * b.x; xi_c[q * 4] = cfr * b.x + cfi * a.x;
      xr_c[q * 4 + 1] = cfr * a.y - cfi * b.y; xi_c[q * 4 + 1] = cfr * b.y + cfi * a.y;
      xr_c[q * 4 + 2] = cfr * a.z - cfi * b.z; xi_c[q * 4 + 2] = cfr * b.z + cfi * a.z;
      xr_c[q * 4 + 3] = cfr * a.w - cfi * b.w; xi_c[q * 4 + 3] = cfr * b.w + cfi * a.w;
    }
  }
  for (int e = lane; e < 1024; e += 64) {
    const int c = e >> 6, pp = e & 63;
    sC[(c * 65 + pp) * 2] = p.in[24][(size_t)lg_ * 1024 + e];
    sC[(c * 65 + pp) * 2 + 1] = p.in[25][(size_t)lg_ * 1024 + e];
  }
  float hr = 0.f, hi = 0.f;
  if (s >= 8) {
    hr = p.in[4][((size_t)(l * 128 + (s - 8)) * 16 + g) * 64 + lane];
    hi = p.in[5][((size_t)(l * 128 + (s - 8)) * 16 + g) * 64 + lane];
  }
  const int ytt = lane >> 3, cp = (lane & 7) * 2;
  const float d0 = p.in[26][l * 256 + g * 16 + cp], d1 = p.in[26][l * 256 + g * 16 + cp + 1];
  const u16* ubase = Zm + (size_t)rowbase * ZW + 1024 + g * 16 + (size_t)(lane >> 1) * ZW + (lane & 1) * 8;
  uint4 pu = make_uint4(0u, 0u, 0u, 0u);
  if (lane < 16) pu = *(const uint4*)(ubase);
  if (lane < 16) {
    float* d = sU + (lane >> 1) * 16 + (lane & 1) * 8;
    *(float4*)(d) = make_float4(bflo(pu.x), bfhi(pu.x), bflo(pu.y), bfhi(pu.y));
    *(float4*)(d + 4) = make_float4(bflo(pu.z), bfhi(pu.z), bflo(pu.w), bfhi(pu.w));
  }
  for (int t0 = 0; t0 < T; t0 += 8) {
    __syncthreads();
    if (lane < 16 && t0 + 8 < T) pu = *(const uint4*)(ubase + (size_t)(t0 + 8) * ZW);
#pragma unroll 2
    for (int tt = 0; tt < 8; ++tt) {
      const float4 u0 = *(const float4*)(sU + tt * 16), u1 = *(const float4*)(sU + tt * 16 + 4), u2 = *(const float4*)(sU + tt * 16 + 8),
                   u3 = *(const float4*)(sU + tt * 16 + 12);
      const float u[16] = {u0.x, u0.y, u0.z, u0.w, u1.x, u1.y, u1.z, u1.w, u2.x, u2.y, u2.z, u2.w, u3.x, u3.y, u3.z, u3.w};
      float xr = 0.f, xi = 0.f;
#pragma unroll
      for (int c = 0; c < 16; ++c) { xr += xr_c[c] * u[c]; xi += xi_c[c] * u[c]; }
      const float nr = lbr * hr - lbi * hi + xr;
      const float ni = lbr * hi + lbi * hr + xi;
      hr = nr; hi = ni;
      *(float2*)&sH[(tt * 65 + lane) * 2] = make_float2(hr, hi);
    }
    __syncthreads();
    float y0 = 0.f, y1 = 0.f;
#pragma unroll 8
    for (int pp = 0; pp < 64; ++pp) {
      const float2 hv = *(const float2*)&sH[(ytt * 65 + pp) * 2];
      const float2 c0 = *(const float2*)&sC[(cp * 65 + pp) * 2];
      const float2 c1 = *(const float2*)&sC[((cp + 1) * 65 + pp) * 2];
      y0 += hv.x * c0.x - hv.y * c0.y;
      y1 += hv.x * c1.x - hv.y * c1.y;
    }
    const size_t row = (size_t)(rowbase + t0 + ytt);
    const float2 uy = *(const float2*)(sU + ytt * 16 + cp);
    y0 = geluf_(y0 + d0 * uy.x);
    y1 = geluf_(y1 + d1 * uy.y);
    *(unsigned*)(Y5 + row * 256 + g * 16 + cp) = pack2(y0, y1);
    if (lane < 16 && t0 + 8 < T) {
      float* d = sU + (lane >> 1) * 16 + (lane & 1) * 8;
      *(float4*)(d) = make_float4(bflo(pu.x), bfhi(pu.x), bflo(pu.y), bfhi(pu.y));
      *(float4*)(d + 4) = make_float4(bflo(pu.z), bfhi(pu.z), bflo(pu.w), bfhi(pu.w));
    }
  }
  st_out(p, O_PS5RE, O_SS5RE, l, s, 1024)[g * 64 + lane] = hr;
  st_out(p, O_PS5IM, O_SS5IM, l, s, 1024)[g * 64 + lane] = hi;
}


DEV void s5_prompt(const P& p, int l, int s, int g, float* smem) {
  const int tid = tid_(), lane = tid & 63;
  const int w = __builtin_amdgcn_readfirstlane(tid >> 6);
  float* sC = smem;
  float* sE = smem + 2080;
  float* sH = smem + 2080 + 512 + w * 1168;
  float* sU = sH + 1040;
  const int rowbase = rowbase_of(s);
  const int tbeg = w * 512, tend = (w == 3) ? TP : tbeg + 512;
  const u16* Zm = (const u16*)(p.ws + OFF_D + D_ZM);
  u16* Y5 = (u16*)(p.ws + OFF_D + D_Y5);
  const int lg_ = l * 16 + g;
  const float lr = p.in[19][lg_ * 64 + lane], li = p.in[20][lg_ * 64 + lane];
  const float dt = expf(p.in[21][lg_]);
  const float mag = expf(lr * dt);
  const float lbr = mag * cosf(li * dt), lbi = mag * sinf(li * dt);
  const float den = lr * lr + li * li;
  const float cfr = ((lbr - 1.f) * lr + lbi * li) / den, cfi = (lbi * lr - (lbr - 1.f) * li) / den;
  float xr_c[16], xi_c[16];
  {
    const float4* br4 = (const float4*)(p.in[22] + ((size_t)lg_ * 64 + lane) * 16);
    const float4* bi4 = (const float4*)(p.in[23] + ((size_t)lg_ * 64 + lane) * 16);
#pragma unroll
    for (int q = 0; q < 4; ++q) {
      float4 a = br4[q], b = bi4[q];
      xr_c[q * 4] = cfr * a.x - cfi * b.x; xi_c[q * 4] = cfr * b.x + cfi * a.x;
      xr_c[q * 4 + 1] = cfr * a.y - cfi * b.y; xi_c[q * 4 + 1] = cfr * b.y + cfi * a.y;
      xr_c[q * 4 + 2] = cfr * a.z - cfi * b.z; xi_c[q * 4 + 2] = cfr * b.z + cfi * a.z;
      xr_c[q * 4 + 3] = cfr * a.w - cfi * b.w; xi_c[q * 4 + 3] = cfr * b.w + cfi * a.w;
    }
  }
  for (int e = tid; e < 1024; e += 256) {
    const int c = e >> 6, pp = e & 63;
    sC[(c * 65 + pp) * 2] = p.in[24][(size_t)lg_ * 1024 + e];
    sC[(c * 65 + pp) * 2 + 1] = p.in[25][(size_t)lg_ * 1024 + e];
  }
  const u16* ubase = Zm + (size_t)rowbase * ZW + 1024 + g * 16 + (size_t)(lane >> 1) * ZW + (lane & 1) * 8;
  float hr = 0.f, hi = 0.f;
  if (w < 3) {
    uint4 pu = make_uint4(0u, 0u, 0u, 0u);
    if (lane < 16) pu = *(const uint4*)(ubase + (size_t)tbeg * ZW);
    for (int t0 = tbeg; t0 < tend; t0 += 8) {
      if (lane < 16) {
        float* d = sU + (lane >> 1) * 16 + (lane & 1) * 8;
        *(float4*)(d) = make_float4(bflo(pu.x), bfhi(pu.x), bflo(pu.y), bfhi(pu.y));
        *(float4*)(d + 4) = make_float4(bflo(pu.z), bfhi(pu.z), bflo(pu.w), bfhi(pu.w));
      }
      if (lane < 16 && t0 + 8 < tend) pu = *(const uint4*)(ubase + (size_t)(t0 + 8) * ZW);
      __builtin_amdgcn_wave_barrier();
#pragma unroll 2
      for (int tt = 0; tt < 8; ++tt) {
        const float4 u0 = *(const float4*)(sU + tt * 16), u1 = *(const float4*)(sU + tt * 16 + 4), u2 = *(const float4*)(sU + tt * 16 + 8),
                     u3 = *(const float4*)(sU + tt * 16 + 12);
        const float u[16] = {u0.x, u0.y, u0.z, u0.w, u1.x, u1.y, u1.z, u1.w, u2.x, u2.y, u2.z, u2.w, u3.x, u3.y, u3.z, u3.w};
        float xr = 0.f, xi = 0.f;
#pragma unroll
        for (int c = 0; c < 16; ++c) { xr += xr_c[c] * u[c]; xi += xi_c[c] * u[c]; }
        const float nr = lbr * hr - lbi * hi + xr;
        const float ni = lbr * hi + lbi * hr + xi;
        hr = nr; hi = ni;
      }
      __builtin_amdgcn_wave_barrier();
    }
    *(float2*)&sE[(w * 64 + lane) * 2] = make_float2(hr, hi);
  }
  __syncthreads();
  {
    const float m512 = expf(lr * dt * 512.f);
    const float pr = m512 * cosf(li * dt * 512.f), pi = m512 * sinf(li * dt * 512.f);
    float Hr = 0.f, Hi = 0.f;
    for (int k = 0; k < w; ++k) {
      const float2 e = *(const float2*)&sE[(k * 64 + lane) * 2];
      const float nr = pr * Hr - pi * Hi + e.x, ni = pr * Hi + pi * Hr + e.y;
      Hr = nr; Hi = ni;
    }
    hr = Hr; hi = Hi;
  }
  const int ytt = lane >> 3, cp = (lane & 7) * 2;
  const float d0 = p.in[26][l * 256 + g * 16 + cp], d1 = p.in[26][l * 256 + g * 16 + cp + 1];
  {
    uint4 pu = make_uint4(0u, 0u, 0u, 0u);
    if (lane < 16) pu = *(const uint4*)(ubase + (size_t)tbeg * ZW);
    for (int t0 = tbeg; t0 < tend; t0 += 8) {
      if (lane < 16) {
        float* d = sU + (lane >> 1) * 16 + (lane & 1) * 8;
        *(float4*)(d) = make_float4(bflo(pu.x), bfhi(pu.x), bflo(pu.y), bfhi(pu.y));
        *(float4*)(d + 4) = make_float4(bflo(pu.z), bfhi(pu.z), bflo(pu.w), bfhi(pu.w));
      }
      if (lane < 16 && t0 + 8 < tend) pu = *(const uint4*)(ubase + (size_t)(t0 + 8) * ZW);
      __builtin_amdgcn_wave_barrier();
#pragma unroll 2
      for (int tt = 0; tt < 8; ++tt) {
        const float4 u0 = *(const float4*)(sU + tt * 16), u1 = *(const float4*)(sU + tt * 16 + 4), u2 = *(const float4*)(sU + tt * 16 + 8),
                     u3 = *(const float4*)(sU + tt * 16 + 12);
        const float u[16] = {u0.x, u0.y, u0.z, u0.w, u1.x, u1.y, u1.z, u1.w, u2.x, u2.y, u2.z, u2.w, u3.x, u3.y, u3.z, u3.w};
        float xr = 0.f, xi = 0.f;
#pragma unroll
        for (int c = 0; c < 16; ++c) { xr += xr_c[c] * u[c]; xi += xi_c[c] * u[c]; }
        const float nr = lbr * hr - lbi * hi + xr;
        const float ni = lbr * hi + lbi * hr + xi;
        hr = nr; hi = ni;
        *(float2*)&sH[(tt * 65 + lane) * 2] = make_float2(hr, hi);
      }
      __builtin_amdgcn_wave_barrier();
      float y0 = 0.f, y1 = 0.f;
#pragma unroll 8
      for (int pp = 0; pp < 64; ++pp) {
        const float2 hv = *(const float2*)&sH[(ytt * 65 + pp) * 2];
        const float2 c0 = *(const float2*)&sC[(cp * 65 + pp) * 2];
        const float2 c1 = *(const float2*)&sC[((cp + 1) * 65 + pp) * 2];
        y0 += hv.x * c0.x - hv.y * c0.y;
        y1 += hv.x * c1.x - hv.y * c1.y;
      }
      const size_t row = (size_t)(rowbase + t0 + ytt);
      const float2 uy = *(const float2*)(sU + ytt * 16 + cp);
      y0 = geluf_(y0 + d0 * uy.x);
      y1 = geluf_(y1 + d1 * uy.y);
      *(unsigned*)(Y5 + row * 256 + g * 16 + cp) = pack2(y0, y1);
      __builtin_amdgcn_wave_barrier();
    }
  }
  if (w == 3) {
    st_out(p, O_PS5RE, O_SS5RE, l, s, 1024)[g * 64 + lane] = hr;
    st_out(p, O_PS5IM, O_SS5IM, l, s, 1024)[g * 64 + lane] = hi;
  }
}

DEV float lru_xin(const P& p, const u16* Zm, int l, int s, int rowbase, int tau, int c) {
  if (tau >= 0) return bf2f(Zm[(size_t)(rowbase + tau) * ZW + 1280 + c]);
  if (s >= 8) return p.in[7][((size_t)(l * 128 + (s - 8)) * 3 + (3 + tau)) * 256 + c];
  return 0.f;
}
DEV void lru_pass1(const P& p, int l, int s, int t0, float* smem) {
  float* sX = smem;
  const int c = tid_();
  const int T = (s < 8) ? TP : 8;
  const int nT = min(32, T - t0);
  const int rowbase = rowbase_of(s);
  const u16* Zm = (const u16*)(p.ws + OFF_D + D_ZM);
  u16* LA = (u16*)(p.ws + OFF_D + D_LA);
  u16* LB = (u16*)(p.ws + OFF_D + D_LB);
  const float w0 = p.in[29][(l * 4 + 0) * 256 + c], w1 = p.in[29][(l * 4 + 1) * 256 + c], w2 = p.in[29][(l * 4 + 2) * 256 + c],
              w3 = p.in[29][(l * 4 + 3) * 256 + c];
  const float cb = p.in[30][l * 256 + c];
  float xm3 = lru_xin(p, Zm, l, s, rowbase, t0 - 3, c), xm2 = lru_xin(p, Zm, l, s, rowbase, t0 - 2, c),
        xm1 = lru_xin(p, Zm, l, s, rowbase, t0 - 1, c);
  u16 xin[32];
#pragma unroll
  for (int tt = 0; tt < 32; ++tt) xin[tt] = (tt < nT) ? Zm[(size_t)(rowbase + t0 + tt) * ZW + 1280 + c] : (u16)0;
#pragma unroll
  for (int tt = 0; tt < 32; ++tt) {
    const float x0 = bf2f(xin[tt]);
    sX[tt * 256 + c] = (tt < nT) ? (w0 * xm3 + w1 * xm2 + w2 * xm1 + w3 * x0 + cb) : 0.f;
    xm3 = xm2; xm2 = xm1; xm1 = x0;
  }
  __syncthreads();
  const int blk = __builtin_amdgcn_readfirstlane(c >> 6), d = c & 63;
  const float* wa = p.in[31] + (size_t)(l * 4 + blk) * 4096;
  const float* wx = p.in[33] + (size_t)(l * 4 + blk) * 4096;
  const float ba = p.in[32][l * 256 + c], bx = p.in[34][l * 256 + c];
  const float sp = softplusf_(-p.in[35][l * 256 + c]);
  for (int b8 = 0; b8 * 8 < nT; ++b8) {
    float ra[8], ia[8];
#pragma unroll
    for (int tt = 0; tt < 8; ++tt) { ra[tt] = 0.f; ia[tt] = 0.f; }
#pragma unroll 4
    for (int k = 0; k < 64; ++k) {
      const float wav = wa[k * 64 + d], wxv = wx[k * 64 + d];
#pragma unroll
      for (int tt = 0; tt < 8; ++tt) {
        const float xv = sX[(b8 * 8 + tt) * 256 + blk * 64 + k];
        ra[tt] += xv * wav; ia[tt] += xv * wxv;
      }
    }
#pragma unroll
    for (int tt = 0; tt < 8; ++tt) {
      const int t = b8 * 8 + tt;
      if (t < nT) {
        const float r = sigm(ra[tt] + ba), ig = sigm(ia[tt] + bx);
        const float la = -8.f * r * sp;
        const float bb = sqrtf(-expm1f(2.f * la)) * (ig * sX[t * 256 + c]);
        const size_t row = (size_t)(rowbase + t0 + t);
        LA[row * 256 + c] = f2bf(la);
        LB[row * 256 + c] = f2bf(bb);
      }
    }
  }
  if (t0 + nT == T) {
    float* o = st_out(p, O_PLRUC, O_SLRUC, l, s, 3 * 256);
#pragma unroll
    for (int r = 0; r < 3; ++r) o[r * 256 + c] = lru_xin(p, Zm, l, s, rowbase, T - 3 + r, c);
  }
}
DEV void lru_pass2(const P& p, int l, int s) {
  const int c = tid_();
  const int T = (s < 8) ? TP : 8;
  const int rowbase = rowbase_of(s);
  const u16* Zm = (const u16*)(p.ws + OFF_D + D_ZM);
  const u16* LA = (const u16*)(p.ws + OFF_D + D_LA);
  const u16* LB = (const u16*)(p.ws + OFF_D + D_LB);
  u16* BR = (u16*)(p.ws + OFF_D + D_BR);
  float h = (s >= 8) ? p.in[6][(size_t)(l * 128 + (s - 8)) * 256 + c] : 0.f;
  u16 na[8], nb[8], ng[8];
#pragma unroll
  for (int tt = 0; tt < 8; ++tt) {
    const size_t row = (size_t)(rowbase + tt);
    na[tt] = LA[row * 256 + c]; nb[tt] = LB[row * 256 + c]; ng[tt] = Zm[row * ZW + 1536 + c];
  }
  for (int t0 = 0; t0 < T; t0 += 8) {
    float la[8], lb[8], lg[8];
#pragma unroll
    for (int tt = 0; tt < 8; ++tt) { la[tt] = bf2f(na[tt]); lb[tt] = bf2f(nb[tt]); lg[tt] = bf2f(ng[tt]); }
    if (t0 + 8 < T) {
#pragma unroll
      for (int tt = 0; tt < 8; ++tt) {
        const size_t row = (size_t)(rowbase + t0 + 8 + tt);
        na[tt] = LA[row * 256 + c]; nb[tt] = LB[row * 256 + c]; ng[tt] = Zm[row * ZW + 1536 + c];
      }
    }
#pragma unroll
    for (int tt = 0; tt < 8; ++tt) {
      h = __expf(la[tt]) * h + lb[tt];
      BR[(size_t)(rowbase + t0 + tt) * 1024 + 512 + c] = f2bf(h * geluf_(lg[tt]));
    }
  }
  st_out(p, O_PLRU, O_SLRU, l, s, 256)[c] = h;
}


DEV void lru_prompt(const P& p, int l, int s, int cg, float* smem) {
  const int tid = tid_(), lane = tid & 63;
  const int w = __builtin_amdgcn_readfirstlane(tid >> 6);
  const int c = cg * 64 + lane;
  float* sE = smem;
  float* sL = smem + 256;
  const int rowbase = rowbase_of(s);
  const int tbeg = w * 512, tend = (w == 3) ? TP : tbeg + 512;
  const u16* Zm = (const u16*)(p.ws + OFF_D + D_ZM);
  const u16* LA = (const u16*)(p.ws + OFF_D + D_LA);
  const u16* LB = (const u16*)(p.ws + OFF_D + D_LB);
  u16* BR = (u16*)(p.ws + OFF_D + D_BR);
  {
    float h = 0.f, sl = 0.f;
    for (int t0 = tbeg; t0 < tend; t0 += 8) {
      u16 na[8], nb[8];
#pragma unroll
      for (int tt = 0; tt < 8; ++tt) { const size_t row = (size_t)(rowbase + t0 + tt); na[tt] = LA[row * 256 + c]; nb[tt] = LB[row * 256 + c]; }
#pragma unroll
      for (int tt = 0; tt < 8; ++tt) { const float la = bf2f(na[tt]); h = __expf(la) * h + bf2f(nb[tt]); sl += la; }
    }
    sE[w * 64 + lane] = h; sL[w * 64 + lane] = sl;
  }
  __syncthreads();
  float h = 0.f;
  for (int k = 0; k < w; ++k) h = __expf(sL[k * 64 + lane]) * h + sE[k * 64 + lane];
  u16 na[8], nb[8], ng[8];
#pragma unroll
  for (int tt = 0; tt < 8; ++tt) {
    const size_t row = (size_t)(rowbase + tbeg + tt);
    na[tt] = LA[row * 256 + c]; nb[tt] = LB[row * 256 + c]; ng[tt] = Zm[row * ZW + 1536 + c];
  }
  for (int t0 = tbeg; t0 < tend; t0 += 8) {
    float la[8], lb[8], lg[8];
#pragma unroll
    for (int tt = 0; tt < 8; ++tt) { la[tt] = bf2f(na[tt]); lb[tt] = bf2f(nb[tt]); lg[tt] = bf2f(ng[tt]); }
    if (t0 + 8 < tend) {
#pragma unroll
      for (int tt = 0; tt < 8; ++tt) {
        const size_t row = (size_t)(rowbase + t0 + 8 + tt);
        na[tt] = LA[row * 256 + c]; nb[tt] = LB[row * 256 + c]; ng[tt] = Zm[row * ZW + 1536 + c];
      }
    }
#pragma unroll
    for (int tt = 0; tt < 8; ++tt) {
      h = __expf(la[tt]) * h + lb[tt];
      BR[(size_t)(rowbase + t0 + tt) * 1024 + 512 + c] = f2bf(h * geluf_(lg[tt]));
    }
  }
  if (w == 3) st_out(p, O_PLRU, O_SLRU, l, s, 256)[c] = h;
}

DEV void conv_item(const P& p, int l, int s, int t0, float* smem) {
  float* sG = smem;
  const int c = tid_(), lane = c & 63, w = c >> 6;
  const int T = (s < 8) ? TP : 8;
  const int nT = min(32, T - t0);
  const int rowbase = rowbase_of(s);
  const u16* Zm = (const u16*)(p.ws + OFF_D + D_ZM);
  u16* BR = (u16*)(p.ws + OFF_D + D_BR);
#pragma unroll 8
  for (int rr = 0; rr < 30 + nT; ++rr) {
    const int tau = t0 - 30 + rr;
    float gl = 0.f;
    if (tau >= 0) {
      const size_t row = (size_t)(rowbase + tau);
      gl = bf2f(Zm[row * ZW + 1792 + c]) * sigm(bf2f(Zm[row * ZW + 2048 + c]));
    } else if (s >= 8) gl = p.in[8][((size_t)(l * 128 + (s - 8)) * 30 + (30 + tau)) * 256 + c];
    sG[rr * 256 + c] = gl;
  }
  if (t0 + nT == T) {
    float* o = st_out(p, O_PCONV, O_SCONV, l, s, 30 * 256);
    for (int r = 0; r < 30; ++r) o[r * 256 + c] = sG[(nT + r) * 256 + c];
  }
  float wv[31];
#pragma unroll
  for (int j = 0; j < 31; ++j) wv[j] = p.in[36][(size_t)(l * 31 + j) * 256 + c];
  const float cb = p.in[37][l * 256 + c];
  for (int tt = 0; tt < nT; ++tt) {
    float y = cb;
#pragma unroll
    for (int j = 0; j < 31; ++j) y += wv[j] * sG[(tt + j) * 256 + c];
    sG[tt * 256 + c] = y;
  }
  __syncthreads();
  const float4 lg4 = *(const float4*)(p.in[38] + l * 256 + lane * 4);
  const float4 lb4 = *(const float4*)(p.in[39] + l * 256 + lane * 4);
  for (int tt = w; tt < nT; tt += 4) {
    const float4 v = *(const float4*)&sG[tt * 256 + lane * 4];
    float s1 = v.x + v.y + v.z + v.w;
    s1 = wave_sum(s1);
    const float mean = s1 * (1.f / 256.f);
    const float a0 = v.x - mean, a1 = v.y - mean, a2 = v.z - mean, a3 = v.w - mean;
    float s2 = a0 * a0 + a1 * a1 + a2 * a2 + a3 * a3;
    s2 = wave_sum(s2);
    const float rstd = rsqrtf(s2 * (1.f / 256.f) + 1e-6f);
    uint2 ov;
    ov.x = pack2(siluf_(a0 * rstd * lg4.x + lb4.x), siluf_(a1 * rstd * lg4.y + lb4.y));
    ov.y = pack2(siluf_(a2 * rstd * lg4.z + lb4.z), siluf_(a3 * rstd * lg4.w + lb4.w));
    *(uint2*)(BR + (size_t)(rowbase + t0 + tt) * 1024 + 768 + lane * 4) = ov;
  }
}

__global__ void __launch_bounds__(256, 2) mega(P p) {
  __shared__ __attribute__((aligned(16))) float smem[16128];
  __shared__ int s_item;
  cg::grid_group grid = cg::this_grid();
  u16* sA = (u16*)smem;
  u16* sB = sA + 128 * 72;
  const u16* W = (const u16*)(p.ws + OFF_W);
  const u16* XN = (const u16*)(p.ws + OFF_XN);
  float* X = (float*)(p.ws + OFF_X);
  u16* H = (u16*)(p.ws + OFF_D + D_H);
  u16* Zm = (u16*)(p.ws + OFF_D + D_ZM);
  const u16* M = (const u16*)(p.ws + OFF_D + D_M);
  int* ctr = (int*)p.ws;
  const int G = gridDim.x, B = blockIdx.x;

  for (int l = 0; l < 2; ++l) {
    phase_norm(p, l, 0);
    phase_convw(p, l, smem);
    grid.sync();
    for (int t = B; t < MT * 22; t += G) dual_tile256(XN, W + W_GU1, t % MT, t / MT, H, sA, sB);
    grid.sync();
    for (int t = B; t < MT * 8; t += G) resid_tile(H, 2816, 2816, W + W_DN1, t % MT, t / MT, X, 0.5f, sA, sB);
    grid.sync();
    phase_norm(p, l, 1);
    grid.sync();
    for (int t = B; t < MT * 9; t += G) zm_tile256(XN, W + W_INM, t % MT, t / MT, Zm, sA, sB);
    grid.sync();
    for (;;) {
      __syncthreads();
      if (threadIdx.x == 0) s_item = atomicAdd(&ctr[l * 2], 1);
      __syncthreads();
      const int it = s_item;
      if (it >= 3504) break;
      int ll = l;
      asm volatile("" : "+s"(ll));
      if (it < 128) s5_prompt(p, ll, it >> 4, it & 15, smem);
      else if (it < 1696) delta_pre(p, ll, it - 128, smem);
      else if (it < 2216) { int i = it - 1696; conv_item(p, ll, i / 65, (i % 65) * 32, smem); }
      else if (it < 2344) conv_item(p, ll, 8 + (it - 2216), 0, smem);
      else if (it < 2864) { int i = it - 2344; lru_pass1(p, ll, i / 65, (i % 65) * 32, smem); }
      else if (it < 2992) lru_pass1(p, ll, 8 + (it - 2864), 0, smem);
      else { int i = it - 2992; s5_block(p, ll, 8 + (i >> 2), i & 3, smem); }
    }
    grid.sync();
    for (;;) {
      __syncthreads();
      if (threadIdx.x == 0) s_item = atomicAdd(&ctr[l * 2 + 1], 1);
      __syncthreads();
      const int it = s_item;
      if (it >= 1252) break;
      int ll = l;
      asm volatile("" : "+s"(ll));
      if (it < 32) delta_seq(p, ll, it >> 2, it & 3, smem);
      else if (it < 64) { int i = it - 32; lru_prompt(p, ll, i >> 2, i & 3, smem); }
      else if (it < 612) { int i = it - 64; dual_tile<1>((const u16*)(p.ws + OFF_D + D_Y5), 256, 256, W + W_GLU, i % MT, i / MT, (u16*)(p.ws + OFF_D + D_BR), 1024, 256, p.in[28] + ll * 512, sA, sB); }
      else if (it < 1124) { int i = it - 612; delta_seq(p, ll, 8 + (i >> 2), i & 3, smem); }
      else lru_pass2(p, ll, 8 + (it - 1124));
    }
    grid.sync();
    for (int t = B; t < MT * 16; t += G) g4_tile(p, t % MT, t / MT, sA, sB);
    grid.sync();
    for (int t = B; t < MT * 8; t += G) resid_tile(M, 1024, 1024, W + W_OUT, t % MT, t / MT, X, 1.0f, sA, sB);
    grid.sync();
    phase_norm(p, l, 2);
    grid.sync();
    for (int t = B; t < MT * 22; t += G) dual_tile256(XN, W + W_GU2, t % MT, t / MT, H, sA, sB);
    grid.sync();
    for (int t = B; t < MT * 8; t += G) resid_tile(H, 2816, 2816, W + W_DN2, t % MT, t / MT, X, 0.5f, sA, sB);
    grid.sync();
  }
  phase_norm(p, 0, 3);
}

extern "C" void kernel_launch(void* const* d_in, const int* in_sizes, int n_in, void* d_out, int out_size, void* d_ws,
                              size_t ws_size, hipStream_t stream) {
  P p{};
  for (int i = 0; i < 46; ++i) p.in[i] = (const float*)d_in[i];
  p.out = (float*)d_out;
  p.ws = (char*)d_ws;
  static int grid_blocks = 0;
  if (!grid_blocks) {
    int dev = 0, cus = 0, per = 0;
    hipGetDevice(&dev);
    hipDeviceGetAttribute(&cus, hipDeviceAttributeMultiprocessorCount, dev);
    hipOccupancyMaxActiveBlocksPerMultiprocessor(&per, mega, 256, 0);
    if (per > 2) per = 2;
    if (per < 1) per = 1;
    grid_blocks = cus * per;
  }
  if (ws_size < WS_NEED) fprintf(stderr, "workspace too small: %zu < %zu\n", ws_size, (size_t)WS_NEED);
  hipMemsetAsync(d_ws, 0, 256, stream);
  void* args[] = {&p};
  hipError_t e = hipLaunchCooperativeKernel((void*)mega, dim3(grid_blocks), dim3(256), args, 0, stream);
  if (e != hipSuccess) fprintf(stderr, "cooperative launch failed: %s (grid %d)\n", hipGetErrorString(e), grid_blocks);
}
```

```cpp
#include <hip/hip_runtime.h>
#include <hip/hip_bf16.h>
#include <hip/hip_cooperative_groups.h>
#include <cstdio>
namespace cg = cooperative_groups;

typedef unsigned short u16;
using bf16x8 = __attribute__((ext_vector_type(8))) short;
using f32x4 = __attribute__((ext_vector_type(4))) float;
using u32x4 = __attribute__((ext_vector_type(4))) unsigned int;
#define DEV __device__ __forceinline__

struct P { const float* in[46]; float* out; char* ws; };

constexpr int NTOK = 17536, TP = 2064, NPR = 16512, ZW = 2304, MT = 137;
constexpr size_t OFF_X = 65536;
constexpr size_t OFF_W = OFF_X + (size_t)NTOK * 1024 * 4;
constexpr size_t W_GU1 = 0, W_DN1 = 5767168, W_INM = 8650752, W_ING = 11010048, W_BR = 15204352, W_OUT = 16252928,
                 W_GLU = 17301504, W_GU2 = 17432576, W_DN2 = 23199744, W_END = 26083328;
constexpr size_t OFF_XN = OFF_W + W_END * 2;
constexpr size_t OFF_BA = OFF_XN + (size_t)NTOK * 1024 * 2;
constexpr size_t OFF_D = OFF_BA + (size_t)NTOK * 8 * 4;
constexpr size_t D_H = 0, D_ZM = 0, D_M = 0, D_BR = 80805888, D_LA = 116719616, D_LB = 125698048, D_Y5 = 134676480;
constexpr size_t WS_NEED = OFF_D + 143654912;
constexpr size_t OFF_GAMMA = 1024;
constexpr size_t O_YS = 16777216, O_PDELTA = 17825792, O_PDCONV = 18087936, O_PS5RE = 18124800, O_PS5IM = 18141184,
                 O_PLRU = 18157568, O_PLRUC = 18161664, O_PCONV = 18173952, O_SDELTA = 18296832, O_SDCONV = 22491136,
                 O_SS5RE = 23080960, O_SS5IM = 23343104, O_SLRU = 23605248, O_SLRUC = 23670784, O_SCONV = 23867392;

DEV u16 f2bf(float f) { unsigned u = __float_as_uint(f); u += 0x7fffu + ((u >> 16) & 1u); return (u16)(u >> 16); }
DEV float bf2f(u16 h) { return __uint_as_float(((unsigned)h) << 16); }
DEV float bflo(unsigned u) { return __uint_as_float(u << 16); }
DEV float bfhi(unsigned u) { return __uint_as_float(u & 0xffff0000u); }
DEV unsigned pack2(float a, float b) { return (unsigned)f2bf(a) | ((unsigned)f2bf(b) << 16); }
DEV float sigm(float x) { return 1.f / (1.f + __expf(-x)); }
DEV float siluf_(float x) { return x / (1.f + __expf(-x)); }
DEV float softplusf_(float x) { return fmaxf(x, 0.f) + log1pf(__expf(-fabsf(x))); }
DEV float geluf_(float x) { float u = 0.7978845608028654f * (x + 0.044715f * x * x * x); return 0.5f * x * (1.f + tanhf(u)); }
DEV float wave_sum(float v) {
#pragma unroll
  for (int o = 32; o > 0; o >>= 1) v += __shfl_xor(v, o, 64);
  return v;
}
DEV void unpack16(uint4 a, uint4 b, float (&x)[16]) {
  x[0] = bflo(a.x); x[1] = bfhi(a.x); x[2] = bflo(a.y); x[3] = bfhi(a.y); x[4] = bflo(a.z); x[5] = bfhi(a.z); x[6] = bflo(a.w); x[7] = bfhi(a.w);
  x[8] = bflo(b.x); x[9] = bfhi(b.x); x[10] = bflo(b.y); x[11] = bfhi(b.y); x[12] = bflo(b.z); x[13] = bfhi(b.z); x[14] = bflo(b.w); x[15] = bfhi(b.w);
}
DEV float* st_out(const P& p, size_t offP, size_t offS, int l, int s, int sz) {
  return s < 8 ? p.out + offP + (size_t)(l * 8 + s) * sz : p.out + offS + (size_t)(l * 128 + (s - 8)) * sz;
}
DEV int tid_() { int t = threadIdx.x; asm volatile("" : "+v"(t)); return t; }
DEV int rowbase_of(int s) { return s < 8 ? s * TP : NPR + (s - 8) * 8; }

DEV void phase_norm(const P& p, int l, int kind) {
  const int tid0 = tid_(); const int lane = tid0 & 63, w = tid0 >> 6;
  float* X = (float*)(p.ws + OFF_X);
  u16* XN = (u16*)(p.ws + OFF_XN);
  float* BA = (float*)(p.ws + OFF_BA);
  const float* gain = kind == 0 ? p.in[10] + l * 1024 : kind == 1 ? p.in[13] + l * 1024 : kind == 2 ? p.in[42] + l * 1024 : p.in[45];
  float4 g4[4];
#pragma unroll
  for (int i = 0; i < 4; ++i) g4[i] = *(const float4*)(gain + i * 256 + lane * 4);
  const bool first = (kind == 0 && l == 0);
  for (int r = blockIdx.x * 4 + w; r < NTOK; r += gridDim.x * 4) {
    const float* src;
    int b = 0, t = 0;
    if (r < NPR) { b = r / TP; t = r - b * TP; }
    if (first) {
      if (r < NPR) src = t < 16 ? p.in[9] + t * 1024 : p.in[0] + ((size_t)b * 2048 + (t - 16)) * 1024;
      else src = p.in[1] + (size_t)(r - NPR) * 1024;
    } else src = X + (size_t)r * 1024;
    float4 v[4];
    float ss = 0.f;
#pragma unroll
    for (int i = 0; i < 4; ++i) {
      v[i] = *(const float4*)(src + i * 256 + lane * 4);
      ss += v[i].x * v[i].x + v[i].y * v[i].y + v[i].z * v[i].z + v[i].w * v[i].w;
    }
    ss = wave_sum(ss);
    const float inv = rsqrtf(ss * (1.f / 1024.f) + 1e-6f);
    if (first) {
#pragma unroll
      for (int i = 0; i < 4; ++i) *(float4*)(X + (size_t)r * 1024 + i * 256 + lane * 4) = v[i];
    }
#pragma unroll
    for (int i = 0; i < 4; ++i) {
      v[i].x *= inv * g4[i].x; v[i].y *= inv * g4[i].y; v[i].z *= inv * g4[i].z; v[i].w *= inv * g4[i].w;
    }
    if (kind == 3) {
      float* dst;
      if (r < NPR) { if (t < 16) continue; dst = p.out + ((size_t)b * 2048 + (t - 16)) * 1024; }
      else dst = p.out + O_YS + (size_t)(r - NPR) * 1024;
#pragma unroll
      for (int i = 0; i < 4; ++i) *(float4*)(dst + i * 256 + lane * 4) = v[i];
    } else {
#pragma unroll
      for (int i = 0; i < 4; ++i) {
        uint2 o; o.x = pack2(v[i].x, v[i].y); o.y = pack2(v[i].z, v[i].w);
        *(uint2*)(XN + (size_t)r * 1024 + i * 256 + lane * 4) = o;
      }
      if (kind == 1) {
        const float* wi = p.in[14] + (size_t)l * 1024 * 6408 + 1024;
        float acc[8];
#pragma unroll
        for (int j = 0; j < 8; ++j) acc[j] = 0.f;
#pragma unroll
        for (int i = 0; i < 4; ++i) {
          const float yv[4] = {v[i].x, v[i].y, v[i].z, v[i].w};
#pragma unroll
          for (int e = 0; e < 4; ++e) {
            const float4* wr = (const float4*)(wi + (size_t)(i * 256 + lane * 4 + e) * 6408);
            float4 a = wr[0], c = wr[1];
            acc[0] += yv[e] * a.x; acc[1] += yv[e] * a.y; acc[2] += yv[e] * a.z; acc[3] += yv[e] * a.w;
            acc[4] += yv[e] * c.x; acc[5] += yv[e] * c.y; acc[6] += yv[e] * c.z; acc[7] += yv[e] * c.w;
          }
        }
#pragma unroll
        for (int j = 0; j < 8; ++j) acc[j] = wave_sum(acc[j]);
        if (lane == 0) {
          *(float4*)(BA + (size_t)r * 8) = make_float4(acc[0], acc[1], acc[2], acc[3]);
          *(float4*)(BA + (size_t)r * 8 + 4) = make_float4(acc[4], acc[5], acc[6], acc[7]);
        }
      }
    }
  }
}

DEV int wmap(int mode, int R, int c0, int half) {
  if (mode == 0) return c0 + R;
  if (mode == 1) { int tile = R >> 7, r = R & 127; int type = (r >> 4) & 1; return type * half + tile * 64 + (r >> 5) * 16 + (r & 15); }
  return R < 1024 ? R : R + 8;
}
DEV void convT(const float* __restrict__ src, int ld, int K, int NR, u16* __restrict__ dst, int mode, int c0, int half,
               int& tbase, float* smem) {
  const int tid = tid_(), G = gridDim.x;
  const int kt = K >> 6, ntile = kt * (NR >> 6);
  int start = ((int)blockIdx.x - tbase) % G;
  if (start < 0) start += G;
  for (int t = start; t < ntile; t += G) {
    const int rt = t / kt, k0 = (t - rt * kt) * 64, R0 = rt * 64;
    __syncthreads();
    const int rr = tid & 63;
    const int col = wmap(mode, R0 + rr, c0, half);
#pragma unroll
    for (int i = 0; i < 16; ++i) {
      int kk = i * 4 + (tid >> 6);
      smem[kk * 65 + rr] = src[(size_t)(k0 + kk) * ld + col];
    }
    __syncthreads();
    const int r2 = tid >> 2, seg = (tid & 3) * 16;
    unsigned o[8];
#pragma unroll
    for (int e = 0; e < 8; ++e) o[e] = pack2(smem[(seg + 2 * e) * 65 + r2], smem[(seg + 2 * e + 1) * 65 + r2]);
    uint4* d = (uint4*)(dst + (size_t)(R0 + r2) * K + k0 + seg);
    d[0] = make_uint4(o[0], o[1], o[2], o[3]);
    d[1] = make_uint4(o[4], o[5], o[6], o[7]);
  }
  tbase = (tbase + ntile) % G;
}
DEV void phase_convw(const P& p, int l, float* smem) {
  u16* W = (u16*)(p.ws + OFF_W);
  int tb = 0;
  convT(p.in[11] + (size_t)l * 1024 * 5632, 5632, 1024, 5632, W + W_GU1, 1, 0, 2816, tb, smem);
  convT(p.in[12] + (size_t)l * 2816 * 1024, 1024, 2816, 1024, W + W_DN1, 0, 0, 0, tb, smem);
  convT(p.in[14] + (size_t)l * 1024 * 6408, 6408, 1024, 2304, W + W_INM, 2, 0, 0, tb, smem);
  convT(p.in[14] + (size_t)l * 1024 * 6408, 6408, 1024, 4096, W + W_ING, 0, 2312, 0, tb, smem);
  for (int n = 0; n < 4; ++n)
    convT(p.in[40] + (size_t)(l * 4 + n) * 256 * 1024, 1024, 256, 1024, W + W_BR + (size_t)n * 1024 * 256, 0, 0, 0, tb, smem);
  convT(p.in[41] + (size_t)l * 1024 * 1024, 1024, 1024, 1024, W + W_OUT, 0, 0, 0, tb, smem);
  convT(p.in[27] + (size_t)l * 256 * 512, 512, 256, 512, W + W_GLU, 1, 0, 256, tb, smem);
  convT(p.in[43] + (size_t)l * 1024 * 5632, 5632, 1024, 5632, W + W_GU2, 1, 0, 2816, tb, smem);
  convT(p.in[44] + (size_t)l * 2816 * 1024, 1024, 2816, 1024, W + W_DN2, 0, 0, 0, tb, smem);
}

template <int BN>
DEV void gemm_acc(const u16* __restrict__ A, int lda, const u16* __restrict__ Bt, int ldb, int K, f32x4 (&acc)[4][BN / 32],
                  u16* sA, u16* sB) {
  constexpr int NI = BN / 32;
  const int tid = tid_(), lane = tid & 63, w = tid >> 6, wm = w >> 1, wn = w & 1;
  const int lrow = tid >> 3, lseg = (tid & 7) * 8;
  const u16* ga = A + (size_t)lrow * lda + lseg;
  const u16* gb = Bt + (size_t)lrow * ldb + lseg;
  u16* wa = sA + lrow * 72 + lseg;
  u16* wb = sB + lrow * 72 + lseg;
  const u16* fa = sA + (wm * 64 + (lane & 15)) * 72 + (lane >> 4) * 8;
  const u16* fb = sB + (wn * (BN / 2) + (lane & 15)) * 72 + (lane >> 4) * 8;
  u32x4 pa0, pa1, pa2, pa3, pb0, pb1, pb2, pb3, qa0, qa1, qa2, qa3, qb0, qb1, qb2, qb3;
#define GA_LOAD(X, koff) do { const u16* _ga = ga + (koff); const u16* _gb = gb + (koff); \
    X##a0 = *(const u32x4*)(_ga); X##a1 = *(const u32x4*)(_ga + (size_t)32 * lda); X##a2 = *(const u32x4*)(_ga + (size_t)64 * lda); X##a3 = *(const u32x4*)(_ga + (size_t)96 * lda); \
    X##b0 = *(const u32x4*)(_gb); X##b1 = *(const u32x4*)(_gb + (size_t)32 * ldb); \
    if (BN == 128) { X##b2 = *(const u32x4*)(_gb + (size_t)64 * ldb); X##b3 = *(const u32x4*)(_gb + (size_t)96 * ldb); } } while (0)
#define GA_WRITE(X) do { *(u32x4*)(wa) = X##a0; *(u32x4*)(wa + 32 * 72) = X##a1; *(u32x4*)(wa + 64 * 72) = X##a2; *(u32x4*)(wa + 96 * 72) = X##a3; \
    *(u32x4*)(wb) = X##b0; *(u32x4*)(wb + 32 * 72) = X##b1; \
    if (BN == 128) { *(u32x4*)(wb + 64 * 72) = X##b2; *(u32x4*)(wb + 96 * 72) = X##b3; } } while (0)
#define GA_COMPUTE() do { _Pragma("unroll") for (int kk = 0; kk < 64; kk += 32) { bf16x8 a[4], b[NI]; \
    _Pragma("unroll") for (int mi = 0; mi < 4; ++mi) a[mi] = *(const bf16x8*)(fa + mi * 16 * 72 + kk); \
    _Pragma("unroll") for (int ni = 0; ni < NI; ++ni) b[ni] = *(const bf16x8*)(fb + ni * 16 * 72 + kk); \
    _Pragma("unroll") for (int mi = 0; mi < 4; ++mi) _Pragma("unroll") for (int ni = 0; ni < NI; ++ni) \
      acc[mi][ni] = __builtin_amdgcn_mfma_f32_16x16x32_bf16(a[mi], b[ni], acc[mi][ni], 0, 0, 0); } } while (0)
  GA_LOAD(p, 0);
  if (K > 64) GA_LOAD(q, 64);
  for (int k0 = 0; k0 < K; k0 += 128) {
    __syncthreads();
    GA_WRITE(p);
    __syncthreads();
    if (k0 + 128 < K) GA_LOAD(p, k0 + 128);
    GA_COMPUTE();
    if (k0 + 64 >= K) break;
    __syncthreads();
    GA_WRITE(q);
    __syncthreads();
    if (k0 + 192 < K) GA_LOAD(q, k0 + 192);
    GA_COMPUTE();
  }
#undef GA_LOAD
#undef GA_WRITE
#undef GA_COMPUTE
}

template <int MODE>
DEV void dual_tile(const u16* A, int lda, int K, const u16* Wt, int mt, int nt, u16* out, int ldo, int ocol0, const float* bias,
                   u16* sA, u16* sB) {
  f32x4 acc[4][4];
#pragma unroll
  for (int i = 0; i < 4; ++i)
#pragma unroll
    for (int j = 0; j < 4; ++j) acc[i][j] = (f32x4){0.f, 0.f, 0.f, 0.f};
  gemm_acc<128>(A + (size_t)mt * 128 * lda, lda, Wt + (size_t)nt * 128 * K, K, K, acc, sA, sB);
  const int tid0 = tid_(); const int lane = tid0 & 63, w = tid0 >> 6, wm = w >> 1, wn = w & 1;
#pragma unroll
  for (int mi = 0; mi < 4; ++mi)
#pragma unroll
    for (int np = 0; np < 2; ++np) {
      const int col = nt * 64 + (wn * 2 + np) * 16 + (lane & 15);
      float b0 = 0.f, b1 = 0.f;
      if (MODE == 1) { b0 = bias[col]; b1 = bias[256 + col]; }
#pragma unroll
      for (int j = 0; j < 4; ++j) {
        const int row = mt * 128 + wm * 64 + mi * 16 + (lane >> 4) * 4 + j;
        float g = acc[mi][2 * np][j], u = acc[mi][2 * np + 1][j];
        float v = (MODE == 0) ? siluf_(g) * u : (g + b0) * sigm(u + b1);
        out[(size_t)row * ldo + ocol0 + col] = f2bf(v);
      }
    }
}
DEV void resid_tile(const u16* A, int lda, int K, const u16* Wt, int mt, int nt, float* X, float scale, u16* sA, u16* sB) {
  f32x4 acc[4][4];
#pragma unroll
  for (int i = 0; i < 4; ++i)
#pragma unroll
    for (int j = 0; j < 4; ++j) acc[i][j] = (f32x4){0.f, 0.f, 0.f, 0.f};
  gemm_acc<128>(A + (size_t)mt * 128 * lda, lda, Wt + (size_t)nt * 128 * K, K, K, acc, sA, sB);
  const int tid0 = tid_(); const int lane = tid0 & 63, w = tid0 >> 6, wm = w >> 1, wn = w & 1;
#pragma unroll
  for (int mi = 0; mi < 4; ++mi)
#pragma unroll
    for (int ni = 0; ni < 4; ++ni) {
      const int col = nt * 128 + wn * 64 + ni * 16 + (lane & 15);
#pragma unroll
      for (int j = 0; j < 4; ++j) {
        const int row = mt * 128 + wm * 64 + mi * 16 + (lane >> 4) * 4 + j;
        X[(size_t)row * 1024 + col] += scale * acc[mi][ni][j];
      }
    }
}
DEV void zm_tile(const u16* A, const u16* Wt, int mt, int nt, u16* Zm, u16* sA, u16* sB) {
  f32x4 acc[4][4];
#pragma unroll
  for (int i = 0; i < 4; ++i)
#pragma unroll
    for (int j = 0; j < 4; ++j) acc[i][j] = (f32x4){0.f, 0.f, 0.f, 0.f};
  gemm_acc<128>(A + (size_t)mt * 128 * 1024, 1024, Wt + (size_t)nt * 128 * 1024, 1024, 1024, acc, sA, sB);
  const int tid0 = tid_(); const int lane = tid0 & 63, w = tid0 >> 6, wm = w >> 1, wn = w & 1;
#pragma unroll
  for (int mi = 0; mi < 4; ++mi)
#pragma unroll
    for (int ni = 0; ni < 4; ++ni) {
      const int col = nt * 128 + wn * 64 + ni * 16 + (lane & 15);
#pragma unroll
      for (int j = 0; j < 4; ++j) {
        const int row = mt * 128 + wm * 64 + mi * 16 + (lane >> 4) * 4 + j;
        Zm[(size_t)row * ZW + col] = f2bf(acc[mi][ni][j]);
      }
    }
}

DEV void gemm_acc256(const u16* __restrict__ A, int lda, const u16* __restrict__ Bt, int ldb, int K, f32x4 (&acc)[4][8],
                     u16* sA, u16* sB) {
  const int tid = tid_(), lane = tid & 63, w = tid >> 6, wm = w >> 1, wn = w & 1;
  const int lrow = tid >> 3, lseg = (tid & 7) * 8;
  const u16* ga = A + (size_t)lrow * lda + lseg;
  const u16* gb = Bt + (size_t)lrow * ldb + lseg;
  u16* wa = sA + lrow * 72 + lseg;
  u16* wb = sB + lrow * 72 + lseg;
  const u16* fa = sA + (wm * 64 + (lane & 15)) * 72 + (lane >> 4) * 8;
  const u16* fb = sB + (wn * 128 + (lane & 15)) * 72 + (lane >> 4) * 8;
  u32x4 ra0, ra1, ra2, ra3, rb0, rb1, rb2, rb3, rb4, rb5, rb6, rb7;
  ra0 = *(const u32x4*)(ga);
  ra1 = *(const u32x4*)(ga + (size_t)32 * lda);
  ra2 = *(const u32x4*)(ga + (size_t)64 * lda);
  ra3 = *(const u32x4*)(ga + (size_t)96 * lda);
  rb0 = *(const u32x4*)(gb);
  rb1 = *(const u32x4*)(gb + (size_t)32 * ldb);
  rb2 = *(const u32x4*)(gb + (size_t)64 * ldb);
  rb3 = *(const u32x4*)(gb + (size_t)96 * ldb);
  rb4 = *(const u32x4*)(gb + (size_t)128 * ldb);
  rb5 = *(const u32x4*)(gb + (size_t)160 * ldb);
  rb6 = *(const u32x4*)(gb + (size_t)192 * ldb);
  rb7 = *(const u32x4*)(gb + (size_t)224 * ldb);
  for (int k0 = 0; k0 < K; k0 += 64) {
    __syncthreads();
    *(u32x4*)(wa) = ra0; *(u32x4*)(wa + 32 * 72) = ra1; *(u32x4*)(wa + 64 * 72) = ra2; *(u32x4*)(wa + 96 * 72) = ra3;
    *(u32x4*)(wb) = rb0; *(u32x4*)(wb + 32 * 72) = rb1; *(u32x4*)(wb + 64 * 72) = rb2; *(u32x4*)(wb + 96 * 72) = rb3;
    *(u32x4*)(wb + 128 * 72) = rb4; *(u32x4*)(wb + 160 * 72) = rb5; *(u32x4*)(wb + 192 * 72) = rb6; *(u32x4*)(wb + 224 * 72) = rb7;
    __syncthreads();
    if (k0 + 64 < K) {
      const u16* ga2 = ga + k0 + 64;
      const u16* gb2 = gb + k0 + 64;
      ra0 = *(const u32x4*)(ga2);
      ra1 = *(const u32x4*)(ga2 + (size_t)32 * lda);
      ra2 = *(const u32x4*)(ga2 + (size_t)64 * lda);
      ra3 = *(const u32x4*)(ga2 + (size_t)96 * lda);
      rb0 = *(const u32x4*)(gb2);
      rb1 = *(const u32x4*)(gb2 + (size_t)32 * ldb);
      rb2 = *(const u32x4*)(gb2 + (size_t)64 * ldb);
      rb3 = *(const u32x4*)(gb2 + (size_t)96 * ldb);
      rb4 = *(const u32x4*)(gb2 + (size_t)128 * ldb);
      rb5 = *(const u32x4*)(gb2 + (size_t)160 * ldb);
      rb6 = *(const u32x4*)(gb2 + (size_t)192 * ldb);
      rb7 = *(const u32x4*)(gb2 + (size_t)224 * ldb);
    }
#pragma unroll
    for (int kk = 0; kk < 64; kk += 32) {
      bf16x8 a[4];
#pragma unroll
      for (int mi = 0; mi < 4; ++mi) a[mi] = *(const bf16x8*)(fa + mi * 16 * 72 + kk);
#pragma unroll
      for (int nh = 0; nh < 2; ++nh) {
        bf16x8 b[4];
#pragma unroll
        for (int ni = 0; ni < 4; ++ni) b[ni] = *(const bf16x8*)(fb + (nh * 4 + ni) * 16 * 72 + kk);
#pragma unroll
        for (int mi = 0; mi < 4; ++mi)
#pragma unroll
          for (int ni = 0; ni < 4; ++ni)
            acc[mi][nh * 4 + ni] = __builtin_amdgcn_mfma_f32_16x16x32_bf16(a[mi], b[ni], acc[mi][nh * 4 + ni], 0, 0, 0);
      }
    }
  }
}
DEV void dual_tile256(const u16* A, const u16* Wt, int mt, int nt, u16* out, u16* sA, u16* sB) {
  f32x4 acc[4][8];
#pragma unroll
  for (int i = 0; i < 4; ++i)
#pragma unroll
    for (int j = 0; j < 8; ++j) acc[i][j] = (f32x4){0.f, 0.f, 0.f, 0.f};
  gemm_acc256(A + (size_t)mt * 128 * 1024, 1024, Wt + (size_t)nt * 256 * 1024, 1024, 1024, acc, sA, sB);
  const int tid0 = tid_(); const int lane = tid0 & 63, w = tid0 >> 6, wm = w >> 1, wn = w & 1;
#pragma unroll
  for (int mi = 0; mi < 4; ++mi)
#pragma unroll
    for (int np = 0; np < 4; ++np) {
      const int col = (nt * 2 + wn) * 64 + np * 16 + (lane & 15);
#pragma unroll
      for (int j = 0; j < 4; ++j) {
        const int row = mt * 128 + wm * 64 + mi * 16 + (lane >> 4) * 4 + j;
        out[(size_t)row * 2816 + col] = f2bf(siluf_(acc[mi][2 * np][j]) * acc[mi][2 * np + 1][j]);
      }
    }
}
DEV void zm_tile256(const u16* A, const u16* Wt, int mt, int nt, u16* Zm, u16* sA, u16* sB) {
  f32x4 acc[4][8];
#pragma unroll
  for (int i = 0; i < 4; ++i)
#pragma unroll
    for (int j = 0; j < 8; ++j) acc[i][j] = (f32x4){0.f, 0.f, 0.f, 0.f};
  gemm_acc256(A + (size_t)mt * 128 * 1024, 1024, Wt + (size_t)nt * 256 * 1024, 1024, 1024, acc, sA, sB);
  const int tid0 = tid_(); const int lane = tid0 & 63, w = tid0 >> 6, wm = w >> 1, wn = w & 1;
#pragma unroll
  for (int mi = 0; mi < 4; ++mi)
#pragma unroll
    for (int ni = 0; ni < 8; ++ni) {
      const int col = nt * 256 + wn * 128 + ni * 16 + (lane & 15);
#pragma unroll
      for (int j = 0; j < 4; ++j) {
        const int row = mt * 128 + wm * 64 + mi * 16 + (lane >> 4) * 4 + j;
        Zm[(size_t)row * ZW + col] = f2bf(acc[mi][ni][j]);
      }
    }
}
DEV void g4_tile(const P& p, int mt, int nt, u16* sA, u16* sB) {
  const u16* BR = (const u16*)(p.ws + OFF_D + D_BR);
  const u16* XN = (const u16*)(p.ws + OFF_XN);
  const u16* Wb = (const u16*)(p.ws + OFF_W) + W_BR;
  const u16* Wg = (const u16*)(p.ws + OFF_W) + W_ING;
  u16* M = (u16*)(p.ws + OFF_D + D_M);
  f32x4 accM[4][2];
#pragma unroll
  for (int i = 0; i < 4; ++i)
#pragma unroll
    for (int j = 0; j < 2; ++j) accM[i][j] = (f32x4){0.f, 0.f, 0.f, 0.f};
#pragma unroll 1
  for (int n = 0; n < 4; ++n) {
    unsigned gate[4][2][2];
    {
      f32x4 accG[4][2];
#pragma unroll
      for (int i = 0; i < 4; ++i)
#pragma unroll
        for (int j = 0; j < 2; ++j) accG[i][j] = (f32x4){0.f, 0.f, 0.f, 0.f};
      gemm_acc<64>(XN + (size_t)mt * 128 * 1024, 1024, Wg + ((size_t)n * 1024 + nt * 64) * 1024, 1024, 1024, accG, sA, sB);
#pragma unroll
      for (int i = 0; i < 4; ++i)
#pragma unroll
        for (int j = 0; j < 2; ++j) {
          gate[i][j][0] = pack2(sigm(accG[i][j][0]), sigm(accG[i][j][1]));
          gate[i][j][1] = pack2(sigm(accG[i][j][2]), sigm(accG[i][j][3]));
        }
    }
    f32x4 accP[4][2];
#pragma unroll
    for (int i = 0; i < 4; ++i)
#pragma unroll
      for (int j = 0; j < 2; ++j) accP[i][j] = (f32x4){0.f, 0.f, 0.f, 0.f};
    gemm_acc<64>(BR + (size_t)mt * 128 * 1024 + n * 256, 1024, Wb + ((size_t)n * 1024 + nt * 64) * 256, 256, 256, accP, sA, sB);
#pragma unroll
    for (int i = 0; i < 4; ++i)
#pragma unroll
      for (int j = 0; j < 2; ++j) {
        accM[i][j][0] += bflo(gate[i][j][0]) * accP[i][j][0];
        accM[i][j][1] += bfhi(gate[i][j][0]) * accP[i][j][1];
        accM[i][j][2] += bflo(gate[i][j][1]) * accP[i][j][2];
        accM[i][j][3] += bfhi(gate[i][j][1]) * accP[i][j][3];
      }
  }
  const int tid0 = tid_(); const int lane = tid0 & 63, w = tid0 >> 6, wm = w >> 1, wn = w & 1;
#pragma unroll
  for (int mi = 0; mi < 4; ++mi)
#pragma unroll
    for (int ni = 0; ni < 2; ++ni) {
      const int col = nt * 64 + wn * 32 + ni * 16 + (lane & 15);
#pragma unroll
      for (int j = 0; j < 4; ++j) {
        const int row = mt * 128 + wm * 64 + mi * 16 + (lane >> 4) * 4 + j;
        M[(size_t)row * 1024 + col] = f2bf(accM[mi][ni][j]);
      }
    }
}

DEV void dn_conv16(const u16* __restrict__ Zm, const float* __restrict__ buf, const float* __restrict__ cw, int rowbase, int t, int c,
                   float (&o)[16]) {
#pragma unroll
  for (int e = 0; e < 16; ++e) o[e] = 0.f;
#pragma unroll
  for (int tap = 0; tap < 4; ++tap) {
    const int tau = t - 3 + tap;
    float x[16];
    if (tau >= 0) {
      const uint4* z = (const uint4*)(Zm + (size_t)(rowbase + tau) * ZW + c);
      unpack16(z[0], z[1], x);
    } else if (buf) {
      const float4* bb = (const float4*)(buf + (3 + tau) * 768 + c);
#pragma unroll
      for (int q = 0; q < 4; ++q) { float4 f = bb[q]; x[q * 4] = f.x; x[q * 4 + 1] = f.y; x[q * 4 + 2] = f.z; x[q * 4 + 3] = f.w; }
    } else {
#pragma unroll
      for (int e = 0; e < 16; ++e) x[e] = 0.f;
    }
    const float4* w4 = (const float4*)(cw + tap * 768 + c);
#pragma unroll
    for (int q = 0; q < 4; ++q) {
      float4 f = w4[q];
      o[q * 4] += f.x * x[q * 4]; o[q * 4 + 1] += f.y * x[q * 4 + 1]; o[q * 4 + 2] += f.z * x[q * 4 + 2]; o[q * 4 + 3] += f.w * x[q * 4 + 3];
    }
  }
#pragma unroll
  for (int e = 0; e < 16; ++e) o[e] = siluf_(o[e]);
}

DEV void delta_pre(const P& p, int l, int idx, float* smem) {
  float* sq = smem;
  float* sk = smem + 64 * 68;
  float* sL = smem + 2 * 64 * 68;
  float* sbeta = sL + 4096;
  float* sg = sbeta + 64;
  float* sgc = sg + 64;
  int s, h, j, pad, T;
  if (idx < 1056) { s = idx / 132; int r = idx - s * 132; h = r / 33; j = r - h * 33; pad = 48; T = TP; }
  else { int r = idx - 1056; s = 8 + (r >> 2); h = r & 3; j = 0; pad = 56; T = 8; }
  const int tid = tid_();
  const u16* Zm = (const u16*)(p.ws + OFF_D + D_ZM);
  const float* BA = (const float*)(p.ws + OFF_BA);
  const float* cw = p.in[15] + l * 4 * 768;
  const float* buf = (s >= 8) ? p.in[3] + (size_t)(l * 128 + (s - 8)) * 3 * 768 : nullptr;
  const int rowbase = rowbase_of(s);
  u16* wsb = (u16*)p.out + (size_t)idx * 20480;
  float* gamma = (float*)(p.ws + OFF_GAMMA);
  {
    const int i = tid >> 2, dq = (tid & 3) * 16;
    const int t = j * 64 + i - pad;
    float qv[16], kv[16];
    float sq_ = 0.f, sk_ = 0.f;
    if (t >= 0) {
      dn_conv16(Zm, buf, cw, rowbase, t, h * 64 + dq, qv);
      dn_conv16(Zm, buf, cw, rowbase, t, 256 + h * 64 + dq, kv);
#pragma unroll
      for (int e = 0; e < 16; ++e) { sq_ += qv[e] * qv[e]; sk_ += kv[e] * kv[e]; }
    } else {
#pragma unroll
      for (int e = 0; e < 16; ++e) { qv[e] = 0.f; kv[e] = 0.f; }
    }
    sq_ += __shfl_xor(sq_, 1, 64); sq_ += __shfl_xor(sq_, 2, 64);
    sk_ += __shfl_xor(sk_, 1, 64); sk_ += __shfl_xor(sk_, 2, 64);
    const float qs = rsqrtf(sq_ + 1e-6f) * 0.125f, ks = rsqrtf(sk_ + 1e-6f);
#pragma unroll
    for (int e = 0; e < 16; ++e) { sq[i * 68 + dq + e] = qv[e] * qs; sk[i * 68 + dq + e] = kv[e] * ks; }
  }
  if (tid < 64) {
    const int t = j * 64 + tid - pad;
    float be = 0.f, g = 0.f;
    if (t >= 0) {
      const float* ba = BA + (size_t)(rowbase + t) * 8;
      be = sigm(ba[h]);
      float a = ba[4 + h] + p.in[17][l * 4 + h];
      g = -expf(p.in[16][l * 4 + h]) * softplusf_(a);
    }
    sbeta[tid] = be;
    sg[tid] = g;
  }
  __syncthreads();
  if (tid < 64) {
    float c = 0.f;
    for (int i2 = 0; i2 <= tid; ++i2) c += sg[i2];
    sgc[tid] = c;
  }
  __syncthreads();
  {
    const int ti = tid >> 4, tj = tid & 15;
    float aL[4][4], aI[4][4];
#pragma unroll
    for (int a = 0; a < 4; ++a)
#pragma unroll
      for (int b = 0; b < 4; ++b) { aL[a][b] = 0.f; aI[a][b] = 0.f; }
    for (int d = 0; d < 64; d += 4) {
      float4 qa[4], ka[4], kb[4];
#pragma unroll
      for (int a = 0; a < 4; ++a) { qa[a] = *(const float4*)&sq[(ti + 16 * a) * 68 + d]; ka[a] = *(const float4*)&sk[(ti + 16 * a) * 68 + d]; }
#pragma unroll
      for (int b = 0; b < 4; ++b) kb[b] = *(const float4*)&sk[(tj + 16 * b) * 68 + d];
#pragma unroll
      for (int a = 0; a < 4; ++a)
#pragma unroll
        for (int b = 0; b < 4; ++b) {
          aL[a][b] += ka[a].x * kb[b].x + ka[a].y * kb[b].y + ka[a].z * kb[b].z + ka[a].w * kb[b].w;
          aI[a][b] += qa[a].x * kb[b].x + qa[a].y * kb[b].y + qa[a].z * kb[b].z + qa[a].w * kb[b].w;
        }
    }
#pragma unroll
    for (int a = 0; a < 4; ++a)
#pragma unroll
      for (int b = 0; b < 4; ++b) {
        const int i = ti + 16 * a, jj = tj + 16 * b;
        const float dec = (jj <= i) ? __expf(sgc[i] - sgc[jj]) : 0.f;
        sL[i * 64 + jj] = (jj < i) ? aL[a][b] * sbeta[i] * dec : 0.f;
        wsb[3 * 4096 + i * 64 + jj] = f2bf(aI[a][b] * dec);
      }
  }
  for (int e = tid; e < 4096; e += 256) {
    const int i = e >> 6, d = e & 63;
    wsb[2 * 4096 + e] = f2bf(sq[i * 68 + d] * __expf(sgc[i]));
  }
  for (int e = tid; e < 4096; e += 256) {
    const int d = e >> 6, i = e & 63;
    wsb[4 * 4096 + e] = f2bf(sk[i * 68 + d] * __expf(sgc[63] - sgc[i]));
  }
  if (tid == 0) gamma[idx] = __expf(sgc[63]);
  __syncthreads();
  {
    const int i = tid >> 2, dq = (tid & 3) * 16;
    const int t = j * 64 + i - pad;
    float vv[16];
    if (t >= 0) dn_conv16(Zm, buf, cw, rowbase, t, 512 + h * 64 + dq, vv);
    else {
#pragma unroll
      for (int e = 0; e < 16; ++e) vv[e] = 0.f;
    }
    const float be = sbeta[i], eg = be * __expf(sgc[i]);
#pragma unroll
    for (int e = 0; e < 16; ++e) { sq[i * 68 + dq + e] = vv[e] * be; sk[i * 68 + dq + e] *= eg; }
  }
  __syncthreads();
  {
    float* arr = (tid < 128) ? sq : sk;
    const int col = (tid >> 1) & 63, hf = tid & 1;
    for (int i = 1; i < 64; ++i) {
      float acc = 0.f;
      for (int j0 = hf * 4; j0 < i; j0 += 8) {
        const float4 l4 = *(const float4*)&sL[i * 64 + j0];
        acc -= l4.x * arr[j0 * 68 + col] + l4.y * arr[(j0 + 1) * 68 + col] + l4.z * arr[(j0 + 2) * 68 + col] + l4.w * arr[(j0 + 3) * 68 + col];
      }
      acc += __shfl_xor(acc, 1, 64);
      if (hf == 0) arr[i * 68 + col] += acc;
    }
  }
  __syncthreads();
  for (int e = tid; e < 4096; e += 256) {
    const int i = e >> 6, d = e & 63;
    wsb[e] = f2bf(sq[i * 68 + d]);
    wsb[4096 + e] = f2bf(sk[i * 68 + d]);
  }
  if (h == 0 && j == (s < 8 ? 32 : 0)) {
    float* o = st_out(p, O_PDCONV, O_SDCONV, l, s, 3 * 768);
    for (int e = tid; e < 3 * 768; e += 256) {
      const int r = e / 768, c = e - r * 768;
      o[e] = bf2f(Zm[(size_t)(rowbase + T - 3 + r) * ZW + c]);
    }
  }
}

DEV void mm64(const float* __restrict__ A, const float* __restrict__ B, float (&acc)[4][4], int ti, int tj) {
#pragma unroll 4
  for (int kk = 0; kk < 64; kk += 4) {
    float4 a[4], b[4];
#pragma unroll
    for (int x = 0; x < 4; ++x) a[x] = *(const float4*)&A[(ti + 16 * x) * 68 + kk];
#pragma unroll
    for (int y = 0; y < 4; ++y) b[y] = *(const float4*)&B[(kk + y) * 64 + tj * 4];
#pragma unroll
    for (int x = 0; x < 4; ++x) {
      acc[x][0] += a[x].x * b[0].x + a[x].y * b[1].x + a[x].z * b[2].x + a[x].w * b[3].x;
      acc[x][1] += a[x].x * b[0].y + a[x].y * b[1].y + a[x].z * b[2].y + a[x].w * b[3].y;
      acc[x][2] += a[x].x * b[0].z + a[x].y * b[1].z + a[x].z * b[2].z + a[x].w * b[3].z;
      acc[x][3] += a[x].x * b[0].w + a[x].y * b[1].w + a[x].z * b[2].w + a[x].w * b[3].w;
    }
  }
}
DEV void storeA16(float* sA, uint4 r0, uint4 r1) {
  const int tid = tid_();
  float x[16];
  unpack16(r0, r1, x);
  float* d = sA + (tid >> 2) * 68 + (tid & 3) * 16;
#pragma unroll
  for (int q = 0; q < 4; ++q) *(float4*)(d + q * 4) = make_float4(x[q * 4], x[q * 4 + 1], x[q * 4 + 2], x[q * 4 + 3]);
}

DEV void mm64h(const u16* __restrict__ A, const float* __restrict__ B, float (&acc)[4][4], int ti, int tj) {
#pragma unroll 4
  for (int kk = 0; kk < 64; kk += 4) {
    float4 a[4], b[4];
#pragma unroll
    for (int x = 0; x < 4; ++x) {
      const uint2 av = *(const uint2*)&A[(ti + 16 * x) * 72 + kk];
      a[x] = make_float4(bflo(av.x), bfhi(av.x), bflo(av.y), bfhi(av.y));
    }
#pragma unroll
    for (int y = 0; y < 4; ++y) b[y] = *(const float4*)&B[(kk + y) * 64 + tj * 4];
#pragma unroll
    for (int x = 0; x < 4; ++x) {
      acc[x][0] += a[x].x * b[0].x + a[x].y * b[1].x + a[x].z * b[2].x + a[x].w * b[3].x;
      acc[x][1] += a[x].x * b[0].y + a[x].y * b[1].y + a[x].z * b[2].y + a[x].w * b[3].y;
      acc[x][2] += a[x].x * b[0].z + a[x].y * b[1].z + a[x].z * b[2].z + a[x].w * b[3].z;
      acc[x][3] += a[x].x * b[0].w + a[x].y * b[1].w + a[x].z * b[2].w + a[x].w * b[3].w;
    }
  }
}
DEV void store16h(u16* sA, uint4 r0, uint4 r1) {
  const int tid = tid_();
  uint4* d = (uint4*)(sA + (tid >> 2) * 72 + (tid & 3) * 16);
  d[0] = r0; d[1] = r1;
}

DEV void delta_seq(const P& p, int l, int s, int h, float* smem) {
  float* sS = smem;
  float* sV = smem + 4096;
  u16* sA0 = (u16*)(smem + 8192);
  u16* sA1 = sA0 + 64 * 72;
  u16* sA2 = sA1 + 64 * 72;
  const int tid = tid_(), ti = tid >> 4, tj = tid & 15;
  const int n = (s < 8) ? 33 : 1, pad = (s < 8) ? 48 : 56;
  const int item0 = (s < 8) ? (s * 4 + h) * 33 : 1056 + (s - 8) * 4 + h;
  const int rowbase = rowbase_of(s);
  const float* s0 = (s >= 8) ? p.in[2] + (size_t)((l * 128 + (s - 8)) * 4 + h) * 4096 : nullptr;
  for (int e = tid; e < 4096; e += 256) sS[e] = s0 ? s0[e] : 0.f;
  const u16* wsb = (const u16*)p.out + (size_t)item0 * 20480;
  const float* gamma = (const float*)(p.ws + OFF_GAMMA) + item0;
  const u16* Zm = (const u16*)(p.ws + OFF_D + D_ZM);
  u16* BR = (u16*)(p.ws + OFF_D + D_BR);
  const float4 ng = *(const float4*)(p.in[18] + l * 64 + tj * 4);
  uint4 rw0, rw1, rq0, rq1, ri0, ri1, rk0, rk1;
  {
    const uint4* src = (const uint4*)(wsb + tid * 16);
    rw0 = src[512]; rw1 = src[513];
    rq0 = src[1024]; rq1 = src[1025];
    ri0 = src[1536]; ri1 = src[1537];
    rk0 = src[2048]; rk1 = src[2049];
  }
  for (int j = 0; j < n; ++j) {
    const u16* it = wsb + (size_t)j * 20480;
    uint2 uu_pf[4], zz_pf[4];
#pragma unroll
    for (int a = 0; a < 4; ++a) {
      const int i = ti + 16 * a;
      uu_pf[a] = *(const uint2*)(it + i * 64 + tj * 4);
      const int t = j * 64 + i - pad;
      zz_pf[a] = (t >= 0) ? *(const uint2*)(Zm + (size_t)(rowbase + t) * ZW + 768 + h * 64 + tj * 4) : make_uint2(0u, 0u);
    }
    const float gm = gamma[j];
    __syncthreads();
    store16h(sA0, rw0, rw1); store16h(sA1, rq0, rq1); store16h(sA2, ri0, ri1);
    __syncthreads();
    if (j + 1 < n) {
      const uint4* src = (const uint4*)(it + 20480 + tid * 16);
      rw0 = src[512]; rw1 = src[513]; rq0 = src[1024]; rq1 = src[1025]; ri0 = src[1536]; ri1 = src[1537];
    }
    float acc[4][4];
#pragma unroll
    for (int a = 0; a < 4; ++a)
#pragma unroll
      for (int c = 0; c < 4; ++c) acc[a][c] = 0.f;
    mm64h(sA0, sS, acc, ti, tj);
#pragma unroll
    for (int a = 0; a < 4; ++a) {
      const int i = ti + 16 * a;
      const uint2 uu = uu_pf[a];
      *(float4*)&sV[i * 64 + tj * 4] = make_float4(bflo(uu.x) - acc[a][0], bfhi(uu.x) - acc[a][1], bflo(uu.y) - acc[a][2], bfhi(uu.y) - acc[a][3]);
    }
    __syncthreads();
    store16h(sA0, rk0, rk1);
    if (j + 1 < n) { const uint4* src = (const uint4*)(it + 20480 + tid * 16); rk0 = src[2048]; rk1 = src[2049]; }
    float o[4][4];
#pragma unroll
    for (int a = 0; a < 4; ++a)
#pragma unroll
      for (int c = 0; c < 4; ++c) o[a][c] = 0.f;
    mm64h(sA1, sS, o, ti, tj);
    mm64h(sA2, sV, o, ti, tj);
#pragma unroll
    for (int a = 0; a < 4; ++a) {
      const int i = ti + 16 * a;
      const int t = j * 64 + i - pad;
      float ss = o[a][0] * o[a][0] + o[a][1] * o[a][1] + o[a][2] * o[a][2] + o[a][3] * o[a][3];
      ss += __shfl_xor(ss, 1, 64); ss += __shfl_xor(ss, 2, 64); ss += __shfl_xor(ss, 4, 64); ss += __shfl_xor(ss, 8, 64);
      if (t >= 0) {
        const float inv = rsqrtf(ss * (1.f / 64.f) + 1e-6f);
        const size_t row = (size_t)(rowbase + t);
        const uint2 zz = zz_pf[a];
        float y0 = o[a][0] * inv * ng.x * siluf_(bflo(zz.x));
        float y1 = o[a][1] * inv * ng.y * siluf_(bfhi(zz.x));
        float y2 = o[a][2] * inv * ng.z * siluf_(bflo(zz.y));
        float y3 = o[a][3] * inv * ng.w * siluf_(bfhi(zz.y));
        uint2 ov; ov.x = pack2(y0, y1); ov.y = pack2(y2, y3);
        *(uint2*)(BR + row * 1024 + h * 64 + tj * 4) = ov;
      }
    }
    __syncthreads();
#pragma unroll
    for (int a = 0; a < 4; ++a)
#pragma unroll
      for (int c = 0; c < 4; ++c) acc[a][c] = 0.f;
    mm64h(sA0, sV, acc, ti, tj);
#pragma unroll
    for (int a = 0; a < 4; ++a) {
      float4* sp = (float4*)&sS[(ti + 16 * a) * 64 + tj * 4];
      float4 old = *sp;
      *sp = make_float4(gm * old.x + acc[a][0], gm * old.y + acc[a][1], gm * old.z + acc[a][2], gm * old.w + acc[a][3]);
    }
  }
  __syncthreads();
  float* so = st_out(p, O_PDELTA, O_SDELTA, l, s, 4 * 4096) + h * 4096;
  for (int e = tid; e < 4096; e += 256) so[e] = sS[e];
}

DEV void s5_block(const P& p, int l, int s, int gq, float* smem) {
  const int tid = tid_(), lane = tid & 63;
  const int w = __builtin_amdgcn_readfirstlane(tid >> 6);
  const int g = gq * 4 + w;
  float* sC = smem + w * 3248;
  float* sH = sC + 2080;
  float* sU = sH + 1040;
  const int T = (s < 8) ? TP : 8;
  const int rowbase = rowbase_of(s);
  const u16* Zm = (const u16*)(p.ws + OFF_D + D_ZM);
  u16* Y5 = (u16*)(p.ws + OFF_D + D_Y5);
  const int lg_ = l * 16 + g;
  const float lr = p.in[19][lg_ * 64 + lane], li = p.in[20][lg_ * 64 + lane];
  const float dt = expf(p.in[21][lg_]);
  const float mag = expf(lr * dt);
  const float lbr = mag * cosf(li * dt), lbi = mag * sinf(li * dt);
  const float den = lr * lr + li * li;
  const float cfr = ((lbr - 1.f) * lr + lbi * li) / den, cfi = (lbi * lr - (lbr - 1.f) * li) / den;
  float xr_c[16], xi_c[16];
  {
    const float4* br4 = (const float4*)(p.in[22] + ((size_t)lg_ * 64 + lane) * 16);
    const float4* bi4 = (const float4*)(p.in[23] + ((size_t)lg_ * 64 + lane) * 16);
#pragma unroll
    for (int q = 0; q < 4; ++q) {
      float4 a = br4[q], b = bi4[q];
      xr_c[q * 4] = cfr * a.x - cfi * b.x; xi_c[q * 4] = cfr * b.x + cfi * a.x;
      xr_c[q * 4 + 1] = cfr * a.y - cfi * b.y; xi_c[q * 4 + 1] = cfr * b.y + cfi * a.y;
      xr_c[q * 4 + 2] = cfr * a.z - cfi * b.z; xi_c[q * 4 + 2] = cfr * b.z + cfi * a.z;
      xr_c[q * 4 + 3] = cfr * a.w - cfi * b.w; xi_c[q * 4 + 3] = cfr * b.w + cfi * a.w;
    }
  }
  for (int e = lane; e < 1024; e += 64) {
    const int c = e >> 6, pp = e & 63;
    sC[(c * 65 + pp) * 2] = p.in[24][(size_t)lg_ * 1024 + e];
    sC[(c * 65 + pp) * 2 + 1] = p.in[25][(size_t)lg_ * 1024 + e];
  }
  float hr = 0.f, hi = 0.f;
  if (s >= 8) {
    hr = p.in[4][((size_t)(l * 128 + (s - 8)) * 16 + g) * 64 + lane];
    hi = p.in[5][((size_t)(l * 128 + (s - 8)) * 16 + g) * 64 + lane];
  }
  const int ytt = lane >> 3, cp = (lane & 7) * 2;
  const float d0 = p.in[26][l * 256 + g * 16 + cp], d1 = p.in[26][l * 256 + g * 16 + cp + 1];
  const u16* ubase = Zm + (size_t)rowbase * ZW + 1024 + g * 16 + (size_t)(lane >> 1) * ZW + (lane & 1) * 8;
  uint4 pu = make_uint4(0u, 0u, 0u, 0u);
  if (lane < 16) pu = *(const uint4*)(ubase);
  if (lane < 16) {
    float* d = sU + (lane >> 1) * 16 + (lane & 1) * 8;
    *(float4*)(d) = make_float4(bflo(pu.x), bfhi(pu.x), bflo(pu.y), bfhi(pu.y));
    *(float4*)(d + 4) = make_float4(bflo(pu.z), bfhi(pu.z), bflo(pu.w), bfhi(pu.w));
  }
  for (int t0 = 0; t0 < T; t0 += 8) {
    __syncthreads();
    if (lane < 16 && t0 + 8 < T) pu = *(const uint4*)(ubase + (size_t)(t0 + 8) * ZW);
#pragma unroll 2
    for (int tt = 0; tt < 8; ++tt) {
      const float4 u0 = *(const float4*)(sU + tt * 16), u1 = *(const float4*)(sU + tt * 16 + 4), u2 = *(const float4*)(sU + tt * 16 + 8),
                   u3 = *(const float4*)(sU + tt * 16 + 12);
      const float u[16] = {u0.x, u0.y, u0.z, u0.w, u1.x, u1.y, u1.z, u1.w, u2.x, u2.y, u2.z, u2.w, u3.x, u3.y, u3.z, u3.w};
      float xr = 0.f, xi = 0.f;
#pragma unroll
      for (int c = 0; c < 16; ++c) { xr += xr_c[c] * u[c]; xi += xi_c[c] * u[c]; }
      const float nr = lbr * hr - lbi * hi + xr;
      const float ni = lbr * hi + lbi * hr + xi;
      hr = nr; hi = ni;
      *(float2*)&sH[(tt * 65 + lane) * 2] = make_float2(hr, hi);
    }
    __syncthreads();
    float y0 = 0.f, y1 = 0.f;
#pragma unroll 8
    for (int pp = 0; pp < 64; ++pp) {
      const float2 hv = *(const float2*)&sH[(ytt * 65 + pp) * 2];
      const float2 c0 = *(const float2*)&sC[(cp * 65 + pp) * 2];
      const float2 c1 = *(const float2*)&sC[((cp + 1) * 65 + pp) * 2];
      y0 += hv.x * c0.x - hv.y * c0.y;
      y1 += hv.x * c1.x - hv.y * c1.y;
    }
    const size_t row = (size_t)(rowbase + t0 + ytt);
    const float2 uy = *(const float2*)(sU + ytt * 16 + cp);
    y0 = geluf_(y0 + d0 * uy.x);
    y1 = geluf_(y1 + d1 * uy.y);
    *(unsigned*)(Y5 + row * 256 + g * 16 + cp) = pack2(y0, y1);
    if (lane < 16 && t0 + 8 < T) {
      float* d = sU + (lane >> 1) * 16 + (lane & 1) * 8;
      *(float4*)(d) = make_float4(bflo(pu.x), bfhi(pu.x), bflo(pu.y), bfhi(pu.y));
      *(float4*)(d + 4) = make_float4(bflo(pu.z), bfhi(pu.z), bflo(pu.w), bfhi(pu.w));
    }
  }
  st_out(p, O_PS5RE, O_SS5RE, l, s, 1024)[g * 64 + lane] = hr;
  st_out(p, O_PS5IM, O_SS5IM, l, s, 1024)[g * 64 + lane] = hi;
}


DEV void s5_prompt(const P& p, int l, int s, int g, float* smem) {
  const int tid = tid_(), lane = tid & 63;
  const int w = __builtin_amdgcn_readfirstlane(tid >> 6);
  float* sC = smem;
  float* sE = smem + 2080;
  float* sH = smem + 2080 + 512 + w * 1168;
  float* sU = sH + 1040;
  const int rowbase = rowbase_of(s);
  const int tbeg = w * 512, tend = (w == 3) ? TP : tbeg + 512;
  const u16* Zm = (const u16*)(p.ws + OFF_D + D_ZM);
  u16* Y5 = (u16*)(p.ws + OFF_D + D_Y5);
  const int lg_ = l * 16 + g;
  const float lr = p.in[19][lg_ * 64 + lane], li = p.in[20][lg_ * 64 + lane];
  const float dt = expf(p.in[21][lg_]);
  const float mag = expf(lr * dt);
  const float lbr = mag * cosf(li * dt), lbi = mag * sinf(li * dt);
  const float den = lr * lr + li * li;
  const float cfr = ((lbr - 1.f) * lr + lbi * li) / den, cfi = (lbi * lr - (lbr - 1.f) * li) / den;
  float xr_c[16], xi_c[16];
  {
    const float4* br4 = (const float4*)(p.in[22] + ((size_t)lg_ * 64 + lane) * 16);
    const float4* bi4 = (const float4*)(p.in[23] + ((size_t)lg_ * 64 + lane) * 16);
#pragma unroll
    for (int q = 0; q < 4; ++q) {
      float4 a = br4[q], b = bi4[q];
      xr_c[q * 4] = cfr * a.x - cfi * b.x; xi_c[q * 4] = cfr * b.x + cfi * a.x;
      xr_c[q * 4 + 1] = cfr * a.y - cfi * b.y; xi_c[q * 4 + 1] = cfr * b.y + cfi * a.y;
      xr_c[q * 4 + 2] = cfr * a.z - cfi * b.z; xi_c[q * 4 + 2] = cfr * b.z + cfi * a.z;
      xr_c[q * 4 + 3] = cfr * a.w - cfi * b.w; xi_c[q * 4 + 3] = cfr * b.w + cfi * a.w;
    }
  }
  for (int e = tid; e < 1024; e += 256) {
    const int c = e >> 6, pp = e & 63;
    sC[(c * 65 + pp) * 2] = p.in[24][(size_t)lg_ * 1024 + e];
    sC[(c * 65 + pp) * 2 + 1] = p.in[25][(size_t)lg_ * 1024 + e];
  }
  const u16* ubase = Zm + (size_t)rowbase * ZW + 1024 + g * 16 + (size_t)(lane >> 1) * ZW + (lane & 1) * 8;
  float hr = 0.f, hi = 0.f;
  if (w < 3) {
    uint4 pu = make_uint4(0u, 0u, 0u, 0u);
    if (lane < 16) pu = *(const uint4*)(ubase + (size_t)tbeg * ZW);
    for (int t0 = tbeg; t0 < tend; t0 += 8) {
      if (lane < 16) {
        float* d = sU + (lane >> 1) * 16 + (lane & 1) * 8;
        *(float4*)(d) = make_float4(bflo(pu.x), bfhi(pu.x), bflo(pu.y), bfhi(pu.y));
        *(float4*)(d + 4) = make_float4(bflo(pu.z), bfhi(pu.z), bflo(pu.w), bfhi(pu.w));
      }
      if (lane < 16 && t0 + 8 < tend) pu = *(const uint4*)(ubase + (size_t)(t0 + 8) * ZW);
      __builtin_amdgcn_wave_barrier();
#pragma unroll 2
      for (int tt = 0; tt < 8; ++tt) {
        const float4 u0 = *(const float4*)(sU + tt * 16), u1 = *(const float4*)(sU + tt * 16 + 4), u2 = *(const float4*)(sU + tt * 16 + 8),
                     u3 = *(const float4*)(sU + tt * 16 + 12);
        const float u[16] = {u0.x, u0.y, u0.z, u0.w, u1.x, u1.y, u1.z, u1.w, u2.x, u2.y, u2.z, u2.w, u3.x, u3.y, u3.z, u3.w};
        float xr = 0.f, xi = 0.f;
#pragma unroll
        for (int c = 0; c < 16; ++c) { xr += xr_c[c] * u[c]; xi += xi_c[c] * u[c]; }
        const float nr = lbr * hr - lbi * hi + xr;
        const float ni = lbr * hi + lbi * hr + xi;
        hr = nr; hi = ni;
      }
      __builtin_amdgcn_wave_barrier();
    }
    *(float2*)&sE[(w * 64 + lane) * 2] = make_float2(hr, hi);
  }
  __syncthreads();
  {
    const float m512 = expf(lr * dt * 512.f);
    const float pr = m512 * cosf(li * dt * 512.f), pi = m512 * sinf(li * dt * 512.f);
    float Hr = 0.f, Hi = 0.f;
    for (int k = 0; k < w; ++k) {
      const float2 e = *(const float2*)&sE[(k * 64 + lane) * 2];
      const float nr = pr * Hr - pi * Hi + e.x, ni = pr * Hi + pi * Hr + e.y;
      Hr = nr; Hi = ni;
    }
    hr = Hr; hi = Hi;
  }
  const int ytt = lane >> 3, cp = (lane & 7) * 2;
  const float d0 = p.in[26][l * 256 + g * 16 + cp], d1 = p.in[26][l * 256 + g * 16 + cp + 1];
  {
    uint4 pu = make_uint4(0u, 0u, 0u, 0u);
    if (lane < 16) pu = *(const uint4*)(ubase + (size_t)tbeg * ZW);
    for (int t0 = tbeg; t0 < tend; t0 += 8) {
      if (lane < 16) {
        float* d = sU + (lane >> 1) * 16 + (lane & 1) * 8;
        *(float4*)(d) = make_float4(bflo(pu.x), bfhi(pu.x), bflo(pu.y), bfhi(pu.y));
        *(float4*)(d + 4) = make_float4(bflo(pu.z), bfhi(pu.z), bflo(pu.w), bfhi(pu.w));
      }
      if (lane < 16 && t0 + 8 < tend) pu = *(const uint4*)(ubase + (size_t)(t0 + 8) * ZW);
      __builtin_amdgcn_wave_barrier();
#pragma unroll 2
      for (int tt = 0; tt < 8; ++tt) {
        const float4 u0 = *(const float4*)(sU + tt * 16), u1 = *(const float4*)(sU + tt * 16 + 4), u2 = *(const float4*)(sU + tt * 16 + 8),
                     u3 = *(const float4*)(sU + tt * 16 + 12);
        const float u[16] = {u0.x, u0.y, u0.z, u0.w, u1.x, u1.y, u1.z, u1.w, u2.x, u2.y, u2.z, u2.w, u3.x, u3.y, u3.z, u3.w};
        float xr = 0.f, xi = 0.f;
#pragma unroll
        for (int c = 0; c < 16; ++c) { xr += xr_c[c] * u[c]; xi += xi_c[c] * u[c]; }
        const float nr = lbr * hr - lbi * hi + xr;
        const float ni = lbr * hi + lbi * hr + xi;
        hr = nr; hi = ni;
        *(float2*)&sH[(tt * 65 + lane) * 2] = make_float2(hr, hi);
      }
      __builtin_amdgcn_wave_barrier();
      float y0 = 0.f, y1 = 0.f;
#pragma unroll 8
      for (int pp = 0; pp < 64; ++pp) {
        const float2 hv = *(const float2*)&sH[(ytt * 65 + pp) * 2];
        const float2 c0 = *(const float2*)&sC[(cp * 65 + pp) * 2];
        const float2 c1 = *(const float2*)&sC[((cp + 1) * 65 + pp) * 2];
        y0 += hv.x * c0.x - hv.y * c0.y;
        y1 += hv.x * c1.x - hv.y * c1.y;
      }
      const size_t row = (size_t)(rowbase + t0 + ytt);
      const float2 uy = *(const float2*)(sU + ytt * 16 + cp);
      y0 = geluf_(y0 + d0 * uy.x);
      y1 = geluf_(y1 + d1 * uy.y);
      *(unsigned*)(Y5 + row * 256 + g * 16 + cp) = pack2(y0, y1);
      __builtin_amdgcn_wave_barrier();
    }
  }
  if (w == 3) {
    st_out(p, O_PS5RE, O_SS5RE, l, s, 1024)[g * 64 + lane] = hr;
    st_out(p, O_PS5IM, O_SS5IM, l, s, 1024)[g * 64 + lane] = hi;
  }
}

DEV float lru_xin(const P& p, const u16* Zm, int l, int s, int rowbase, int tau, int c) {
  if (tau >= 0) return bf2f(Zm[(size_t)(rowbase + tau) * ZW + 1280 + c]);
  if (s >= 8) return p.in[7][((size_t)(l * 128 + (s - 8)) * 3 + (3 + tau)) * 256 + c];
  return 0.f;
}
DEV void lru_pass1(const P& p, int l, int s, int t0, float* smem) {
  float* sX = smem;
  const int c = tid_();
  const int T = (s < 8) ? TP : 8;
  const int nT = min(32, T - t0);
  const int rowbase = rowbase_of(s);
  const u16* Zm = (const u16*)(p.ws + OFF_D + D_ZM);
  u16* LA = (u16*)(p.ws + OFF_D + D_LA);
  u16* LB = (u16*)(p.ws + OFF_D + D_LB);
  const float w0 = p.in[29][(l * 4 + 0) * 256 + c], w1 = p.in[29][(l * 4 + 1) * 256 + c], w2 = p.in[29][(l * 4 + 2) * 256 + c],
              w3 = p.in[29][(l * 4 + 3) * 256 + c];
  const float cb = p.in[30][l * 256 + c];
  float xm3 = lru_xin(p, Zm, l, s, rowbase, t0 - 3, c), xm2 = lru_xin(p, Zm, l, s, rowbase, t0 - 2, c),
        xm1 = lru_xin(p, Zm, l, s, rowbase, t0 - 1, c);
  u16 xin[32];
#pragma unroll
  for (int tt = 0; tt < 32; ++tt) xin[tt] = (tt < nT) ? Zm[(size_t)(rowbase + t0 + tt) * ZW + 1280 + c] : (u16)0;
#pragma unroll
  for (int tt = 0; tt < 32; ++tt) {
    const float x0 = bf2f(xin[tt]);
    sX[tt * 256 + c] = (tt < nT) ? (w0 * xm3 + w1 * xm2 + w2 * xm1 + w3 * x0 + cb) : 0.f;
    xm3 = xm2; xm2 = xm1; xm1 = x0;
  }
  __syncthreads();
  const int blk = __builtin_amdgcn_readfirstlane(c >> 6), d = c & 63;
  const float* wa = p.in[31] + (size_t)(l * 4 + blk) * 4096;
  const float* wx = p.in[33] + (size_t)(l * 4 + blk) * 4096;
  const float ba = p.in[32][l * 256 + c], bx = p.in[34][l * 256 + c];
  const float sp = softplusf_(-p.in[35][l * 256 + c]);
  for (int b8 = 0; b8 * 8 < nT; ++b8) {
    float ra[8], ia[8];
#pragma unroll
    for (int tt = 0; tt < 8; ++tt) { ra[tt] = 0.f; ia[tt] = 0.f; }
#pragma unroll 4
    for (int k = 0; k < 64; ++k) {
      const float wav = wa[k * 64 + d], wxv = wx[k * 64 + d];
#pragma unroll
      for (int tt = 0; tt < 8; ++tt) {
        const float xv = sX[(b8 * 8 + tt) * 256 + blk * 64 + k];
        ra[tt] += xv * wav; ia[tt] += xv * wxv;
      }
    }
#pragma unroll
    for (int tt = 0; tt < 8; ++tt) {
      const int t = b8 * 8 + tt;
      if (t < nT) {
        const float r = sigm(ra[tt] + ba), ig = sigm(ia[tt] + bx);
        const float la = -8.f * r * sp;
        const float bb = sqrtf(-expm1f(2.f * la)) * (ig * sX[t * 256 + c]);
        const size_t row = (size_t)(rowbase + t0 + t);
        LA[row * 256 + c] = f2bf(la);
        LB[row * 256 + c] = f2bf(bb);
      }
    }
  }
  if (t0 + nT == T) {
    float* o = st_out(p, O_PLRUC, O_SLRUC, l, s, 3 * 256);
#pragma unroll
    for (int r = 0; r < 3; ++r) o[r * 256 + c] = lru_xin(p, Zm, l, s, rowbase, T - 3 + r, c);
  }
}
DEV void lru_pass2(const P& p, int l, int s) {
  const int c = tid_();
  const int T = (s < 8) ? TP : 8;
  const int rowbase = rowbase_of(s);
  const u16* Zm = (const u16*)(p.ws + OFF_D + D_ZM);
  const u16* LA = (const u16*)(p.ws + OFF_D + D_LA);
  const u16* LB = (const u16*)(p.ws + OFF_D + D_LB);
  u16* BR = (u16*)(p.ws + OFF_D + D_BR);
  float h = (s >= 8) ? p.in[6][(size_t)(l * 128 + (s - 8)) * 256 + c] : 0.f;
  u16 na[8], nb[8], ng[8];
#pragma unroll
  for (int tt = 0; tt < 8; ++tt) {
    const size_t row = (size_t)(rowbase + tt);
    na[tt] = LA[row * 256 + c]; nb[tt] = LB[row * 256 + c]; ng[tt] = Zm[row * ZW + 1536 + c];
  }
  for (int t0 = 0; t0 < T; t0 += 8) {
    float la[8], lb[8], lg[8];
#pragma unroll
    for (int tt = 0; tt < 8; ++tt) { la[tt] = bf2f(na[tt]); lb[tt] = bf2f(nb[tt]); lg[tt] = bf2f(ng[tt]); }
    if (t0 + 8 < T) {
#pragma unroll
      for (int tt = 0; tt < 8; ++tt) {
        const size_t row = (size_t)(rowbase + t0 + 8 + tt);
        na[tt] = LA[row * 256 + c]; nb[tt] = LB[row * 256 + c]; ng[tt] = Zm[row * ZW + 1536 + c];
      }
    }
#pragma unroll
    for (int tt = 0; tt < 8; ++tt) {
      h = __expf(la[tt]) * h + lb[tt];
      BR[(size_t)(rowbase + t0 + tt) * 1024 + 512 + c] = f2bf(h * geluf_(lg[tt]));
    }
  }
  st_out(p, O_PLRU, O_SLRU, l, s, 256)[c] = h;
}


DEV void lru_prompt(const P& p, int l, int s, int cg, float* smem) {
  const int tid = tid_(), lane = tid & 63;
  const int w = __builtin_amdgcn_readfirstlane(tid >> 6);
  const int c = cg * 64 + lane;
  float* sE = smem;
  float* sL = smem + 256;
  const int rowbase = rowbase_of(s);
  const int tbeg = w * 512, tend = (w == 3) ? TP : tbeg + 512;
  const u16* Zm = (const u16*)(p.ws + OFF_D + D_ZM);
  const u16* LA = (const u16*)(p.ws + OFF_D + D_LA);
  const u16* LB = (const u16*)(p.ws + OFF_D + D_LB);
  u16* BR = (u16*)(p.ws + OFF_D + D_BR);
  {
    float h = 0.f, sl = 0.f;
    for (int t0 = tbeg; t0 < tend; t0 += 8) {
      u16 na[8], nb[8];
#pragma unroll
      for (int tt = 0; tt < 8; ++tt) { const size_t row = (size_t)(rowbase + t0 + tt); na[tt] = LA[row * 256 + c]; nb[tt] = LB[row * 256 + c]; }
#pragma unroll
      for (int tt = 0; tt < 8; ++tt) { const float la = bf2f(na[tt]); h = __expf(la) * h + bf2f(nb[tt]); sl += la; }
    }
    sE[w * 64 + lane] = h; sL[w * 64 + lane] = sl;
  }
  __syncthreads();
  float h = 0.f;
  for (int k = 0; k < w; ++k) h = __expf(sL[k * 64 + lane]) * h + sE[k * 64 + lane];
  u16 na[8], nb[8], ng[8];
#pragma unroll
  for (int tt = 0; tt < 8; ++tt) {
    const size_t row = (size_t)(rowbase + tbeg + tt);
    na[tt] = LA[row * 256 + c]; nb[tt] = LB[row * 256 + c]; ng[tt] = Zm[row * ZW + 1536 + c];
  }
  for (int t0 = tbeg; t0 < tend; t0 += 8) {
    float la[8], lb[8], lg[8];
#pragma unroll
    for (int tt = 0; tt < 8; ++tt) { la[tt] = bf2f(na[tt]); lb[tt] = bf2f(nb[tt]); lg[tt] = bf2f(ng[tt]); }
    if (t0 + 8 < tend) {
#pragma unroll
      for (int tt = 0; tt < 8; ++tt) {
        const size_t row = (size_t)(rowbase + t0 + 8 + tt);
        na[tt] = LA[row * 256 + c]; nb[tt] = LB[row * 256 + c]; ng[tt] = Zm[row * ZW + 1536 + c];
      }
    }
#pragma unroll
    for (int tt = 0; tt < 8; ++tt) {
      h = __expf(la[tt]) * h + lb[tt];
      BR[(size_t)(rowbase + t0 + tt) * 1024 + 512 + c] = f2bf(h * geluf_(lg[tt]));
    }
  }
  if (w == 3) st_out(p, O_PLRU, O_SLRU, l, s, 256)[c] = h;
}

DEV void conv_item(const P& p, int l, int s, int t0, float* smem) {
  float* sG = smem;
  const int c = tid_(), lane = c & 63, w = c >> 6;
  const int T = (s < 8) ? TP : 8;
  const int nT = min(32, T - t0);
  const int rowbase = rowbase_of(s);
  const u16* Zm = (const u16*)(p.ws + OFF_D + D_ZM);
  u16* BR = (u16*)(p.ws + OFF_D + D_BR);
#pragma unroll 8
  for (int rr = 0; rr < 30 + nT; ++rr) {
    const int tau = t0 - 30 + rr;
    float gl = 0.f;
    if (tau >= 0) {
      const size_t row = (size_t)(rowbase + tau);
      gl = bf2f(Zm[row * ZW + 1792 + c]) * sigm(bf2f(Zm[row * ZW + 2048 + c]));
    } else if (s >= 8) gl = p.in[8][((size_t)(l * 128 + (s - 8)) * 30 + (30 + tau)) * 256 + c];
    sG[rr * 256 + c] = gl;
  }
  if (t0 + nT == T) {
    float* o = st_out(p, O_PCONV, O_SCONV, l, s, 30 * 256);
    for (int r = 0; r < 30; ++r) o[r * 256 + c] = sG[(nT + r) * 256 + c];
  }
  float wv[31];
#pragma unroll
  for (int j = 0; j < 31; ++j) wv[j] = p.in[36][(size_t)(l * 31 + j) * 256 + c];
  const float cb = p.in[37][l * 256 + c];
  for (int tt = 0; tt < nT; ++tt) {
    float y = cb;
#pragma unroll
    for (int j = 0; j < 31; ++j) y += wv[j] * sG[(tt + j) * 256 + c];
    sG[tt * 256 + c] = y;
  }
  __syncthreads();
  const float4 lg4 = *(const float4*)(p.in[38] + l * 256 + lane * 4);
  const float4 lb4 = *(const float4*)(p.in[39] + l * 256 + lane * 4);
  for (int tt = w; tt < nT; tt += 4) {
    const float4 v = *(const float4*)&sG[tt * 256 + lane * 4];
    float s1 = v.x + v.y + v.z + v.w;
    s1 = wave_sum(s1);
    const float mean = s1 * (1.f / 256.f);
    const float a0 = v.x - mean, a1 = v.y - mean, a2 = v.z - mean, a3 = v.w - mean;
    float s2 = a0 * a0 + a1 * a1 + a2 * a2 + a3 * a3;
    s2 = wave_sum(s2);
    const float rstd = rsqrtf(s2 * (1.f / 256.f) + 1e-6f);
    uint2 ov;
    ov.x = pack2(siluf_(a0 * rstd * lg4.x + lb4.x), siluf_(a1 * rstd * lg4.y + lb4.y));
    ov.y = pack2(siluf_(a2 * rstd * lg4.z + lb4.z), siluf_(a3 * rstd * lg4.w + lb4.w));
    *(uint2*)(BR + (size_t)(rowbase + t0 + tt) * 1024 + 768 + lane * 4) = ov;
  }
}

__global__ void __launch_bounds__(256, 2) mega(P p) {
  __shared__ __attribute__((aligned(16))) float smem[16128];
  __shared__ int s_item;
  cg::grid_group grid = cg::this_grid();
  u16* sA = (u16*)smem;
  u16* sB = sA + 128 * 72;
  const u16* W = (const u16*)(p.ws + OFF_W);
  const u16* XN = (const u16*)(p.ws + OFF_XN);
  float* X = (float*)(p.ws + OFF_X);
  u16* H = (u16*)(p.ws + OFF_D + D_H);
  u16* Zm = (u16*)(p.ws + OFF_D + D_ZM);
  const u16* M = (const u16*)(p.ws + OFF_D + D_M);
  int* ctr = (int*)p.ws;
  const int G = gridDim.x, B = blockIdx.x;

  for (int l = 0; l < 2; ++l) {
    phase_norm(p, l, 0);
    phase_convw(p, l, smem);
    grid.sync();
    for (int t = B; t < MT * 22; t += G) dual_tile256(XN, W + W_GU1, t % MT, t / MT, H, sA, sB);
    grid.sync();
    for (int t = B; t < MT * 8; t += G) resid_tile(H, 2816, 2816, W + W_DN1, t % MT, t / MT, X, 0.5f, sA, sB);
    grid.sync();
    phase_norm(p, l, 1);
    grid.sync();
    for (int t = B; t < MT * 9; t += G) zm_tile256(XN, W + W_INM, t % MT, t / MT, Zm, sA, sB);
    grid.sync();
    for (;;) {
      __syncthreads();
      if (threadIdx.x == 0) s_item = atomicAdd(&ctr[l * 2], 1);
      __syncthreads();
      const int it = s_item;
      if (it >= 3504) break;
      int ll = l;
      asm volatile("" : "+s"(ll));
      if (it < 128) s5_prompt(p, ll, it >> 4, it & 15, smem);
      else if (it < 1696) delta_pre(p, ll, it - 128, smem);
      else if (it < 2216) { int i = it - 1696; conv_item(p, ll, i / 65, (i % 65) * 32, smem); }
      else if (it < 2344) conv_item(p, ll, 8 + (it - 2216), 0, smem);
      else if (it < 2864) { int i = it - 2344; lru_pass1(p, ll, i / 65, (i % 65) * 32, smem); }
      else if (it < 2992) lru_pass1(p, ll, 8 + (it - 2864), 0, smem);
      else { int i = it - 2992; s5_block(p, ll, 8 + (i >> 2), i & 3, smem); }
    }
    grid.sync();
    for (;;) {
      __syncthreads();
      if (threadIdx.x == 0) s_item = atomicAdd(&ctr[l * 2 + 1], 1);
      __syncthreads();
      const int it = s_item;
      if (it >= 1252) break;
      int ll = l;
      asm volatile("" : "+s"(ll));
      if (it < 32) delta_seq(p, ll, it >> 2, it & 3, smem);
      else if (it < 64) { int i = it - 32; lru_prompt(p, ll, i >> 2, i & 3, smem); }
      else if (it < 612) { int i = it - 64; dual_tile<1>((const u16*)(p.ws + OFF_D + D_Y5), 256, 256, W + W_GLU, i % MT, i / MT, (u16*)(p.ws + OFF_D + D_BR), 1024, 256, p.in[28] + ll * 512, sA, sB); }
      else if (it < 1124) { int i = it - 612; delta_seq(p, ll, 8 + (i >> 2), i & 3, smem); }
      else lru_pass2(p, ll, 8 + (it - 1124));
    }
    grid.sync();
    for (int t = B; t < MT * 16; t += G) g4_tile(p, t % MT, t / MT, sA, sB);
    grid.sync();
    for (int t = B; t < MT * 8; t += G) resid_tile(M, 1024, 1024, W + W_OUT, t % MT, t / MT, X, 1.0f, sA, sB);
    grid.sync();
    phase_norm(p, l, 2);
    grid.sync();
    for (int t = B; t < MT * 22; t += G) dual_tile256(XN, W + W_GU2, t % MT, t / MT, H, sA, sB);
    grid.sync();
    for (int t = B; t < MT * 8; t += G) resid_tile(H, 2816, 2816, W + W_DN2, t % MT, t / MT, X, 0.5f, sA, sB);
    grid.sync();
  }
  phase_norm(p, 0, 3);
}

extern "C" void kernel_launch(void* const* d_in, const int* in_sizes, int n_in, void* d_out, int out_size, void* d_ws,
                              size_t ws_size, hipStream_t stream) {
  P p{};
  for (int i = 0; i < 46; ++i) p.in[i] = (const float*)d_in[i];
  p.out = (float*)d_out;
  p.ws = (char*)d_ws;
  static int grid_blocks = 0;
  if (!grid_blocks) {
    int dev = 0, cus = 0, per = 0;
    hipGetDevice(&dev);
    hipDeviceGetAttribute(&cus, hipDeviceAttributeMultiprocessorCount, dev);
    hipOccupancyMaxActiveBlocksPerMultiprocessor(&per, mega, 256, 0);
    if (per > 2) per = 2;
    if (per < 1) per = 1;
    grid_blocks = cus * per;
  }
  if (ws_size < WS_NEED) fprintf(stderr, "workspace too small: %zu < %zu\n", ws_size, (size_t)WS_NEED);
  hipMemsetAsync(d_ws, 0, 256, stream);
  void* args[] = {&p};
  hipError_t e = hipLaunchCooperativeKernel((void*)mega, dim3(grid_blocks), dim3(256), args, 0, stream);
  if (e != hipSuccess) fprintf(stderr, "cooperative launch failed: %s (grid %d)\n", hipGetErrorString(e), grid_blocks);
}
```

```cpp
#include <hip/hip_runtime.h>
#include <hip/hip_bf16.h>
#include <hip/hip_cooperative_groups.h>
#include <cstdio>
namespace cg = cooperative_groups;

typedef unsigned short u16;
using bf16x8 = __attribute__((ext_vector_type(8))) short;
using f32x4 = __attribute__((ext_vector_type(4))) float;
using u32x4 = __attribute__((ext_vector_type(4))) unsigned int;
#define DEV __device__ __forceinline__

struct P { const float* in[46]; float* out; char* ws; };

constexpr int NTOK = 17536, TP = 2064, NPR = 16512, ZW = 2304, MT = 137;
constexpr size_t OFF_X = 65536;
constexpr size_t OFF_W = OFF_X + (size_t)NTOK * 1024 * 4;
constexpr size_t W_GU1 = 0, W_DN1 = 5767168, W_INM = 8650752, W_ING = 11010048, W_BR = 15204352, W_OUT = 16252928,
                 W_GLU = 17301504, W_GU2 = 17432576, W_DN2 = 23199744, W_END = 26083328;
constexpr size_t OFF_XN = OFF_W + W_END * 2;
constexpr size_t OFF_BA = OFF_XN + (size_t)NTOK * 1024 * 2;
constexpr size_t OFF_D = OFF_BA + (size_t)NTOK * 8 * 4;
constexpr size_t D_H = 0, D_ZM = 0, D_M = 0, D_BR = 80805888, D_LA = 116719616, D_LB = 125698048, D_Y5 = 134676480;
constexpr size_t WS_NEED = OFF_D + 143654912;
constexpr size_t OFF_GAMMA = 1024;
constexpr size_t O_YS = 16777216, O_PDELTA = 17825792, O_PDCONV = 18087936, O_PS5RE = 18124800, O_PS5IM = 18141184,
                 O_PLRU = 18157568, O_PLRUC = 18161664, O_PCONV = 18173952, O_SDELTA = 18296832, O_SDCONV = 22491136,
                 O_SS5RE = 23080960, O_SS5IM = 23343104, O_SLRU = 23605248, O_SLRUC = 23670784, O_SCONV = 23867392;

DEV u16 f2bf(float f) { unsigned u = __float_as_uint(f); u += 0x7fffu + ((u >> 16) & 1u); return (u16)(u >> 16); }
DEV float bf2f(u16 h) { return __uint_as_float(((unsigned)h) << 16); }
DEV float bflo(unsigned u) { return __uint_as_float(u << 16); }
DEV float bfhi(unsigned u) { return __uint_as_float(u & 0xffff0000u); }
DEV unsigned pack2(float a, float b) { return (unsigned)f2bf(a) | ((unsigned)f2bf(b) << 16); }
DEV float sigm(float x) { return 1.f / (1.f + __expf(-x)); }
DEV float siluf_(float x) { return x / (1.f + __expf(-x)); }
DEV float softplusf_(float x) { return fmaxf(x, 0.f) + log1pf(__expf(-fabsf(x))); }
DEV float geluf_(float x) { float u = 0.7978845608028654f * (x + 0.044715f * x * x * x); return 0.5f * x * (1.f + tanhf(u)); }
DEV float wave_sum(float v) {
#pragma unroll
  for (int o = 32; o > 0; o >>= 1) v += __shfl_xor(v, o, 64);
  return v;
}
DEV void unpack16(uint4 a, uint4 b, float (&x)[16]) {
  x[0] = bflo(a.x); x[1] = bfhi(a.x); x[2] = bflo(a.y); x[3] = bfhi(a.y); x[4] = bflo(a.z); x[5] = bfhi(a.z); x[6] = bflo(a.w); x[7] = bfhi(a.w);
  x[8] = bflo(b.x); x[9] = bfhi(b.x); x[10] = bflo(b.y); x[11] = bfhi(b.y); x[12] = bflo(b.z); x[13] = bfhi(b.z); x[14] = bflo(b.w); x[15] = bfhi(b.w);
}
DEV float* st_out(const P& p, size_t offP, size_t offS, int l, int s, int sz) {
  return s < 8 ? p.out + offP + (size_t)(l * 8 + s) * sz : p.out + offS + (size_t)(l * 128 + (s - 8)) * sz;
}
DEV int tid_() { int t = threadIdx.x; asm volatile("" : "+v"(t)); return t; }
DEV int rowbase_of(int s) { return s < 8 ? s * TP : NPR + (s - 8) * 8; }

DEV void phase_norm(const P& p, int l, int kind) {
  const int tid0 = tid_(); const int lane = tid0 & 63, w = tid0 >> 6;
  float* X = (float*)(p.ws + OFF_X);
  u16* XN = (u16*)(p.ws + OFF_XN);
  float* BA = (float*)(p.ws + OFF_BA);
  const float* gain = kind == 0 ? p.in[10] + l * 1024 : kind == 1 ? p.in[13] + l * 1024 : kind == 2 ? p.in[42] + l * 1024 : p.in[45];
  float4 g4[4];
#pragma unroll
  for (int i = 0; i < 4; ++i) g4[i] = *(const float4*)(gain + i * 256 + lane * 4);
  const bool first = (kind == 0 && l == 0);
  for (int r = blockIdx.x * 4 + w; r < NTOK; r += gridDim.x * 4) {
    const float* src;
    int b = 0, t = 0;
    if (r < NPR) { b = r / TP; t = r - b * TP; }
    if (first) {
      if (r < NPR) src = t < 16 ? p.in[9] + t * 1024 : p.in[0] + ((size_t)b * 2048 + (t - 16)) * 1024;
      else src = p.in[1] + (size_t)(r - NPR) * 1024;
    } else src = X + (size_t)r * 1024;
    float4 v[4];
    float ss = 0.f;
#pragma unroll
    for (int i = 0; i < 4; ++i) {
      v[i] = *(const float4*)(src + i * 256 + lane * 4);
      ss += v[i].x * v[i].x + v[i].y * v[i].y + v[i].z * v[i].z + v[i].w * v[i].w;
    }
    ss = wave_sum(ss);
    const float inv = rsqrtf(ss * (1.f / 1024.f) + 1e-6f);
    if (first) {
#pragma unroll
      for (int i = 0; i < 4; ++i) *(float4*)(X + (size_t)r * 1024 + i * 256 + lane * 4) = v[i];
    }
#pragma unroll
    for (int i = 0; i < 4; ++i) {
      v[i].x *= inv * g4[i].x; v[i].y *= inv * g4[i].y; v[i].z *= inv * g4[i].z; v[i].w *= inv * g4[i].w;
    }
    if (kind == 3) {
      float* dst;
      if (r < NPR) { if (t < 16) continue; dst = p.out + ((size_t)b * 2048 + (t - 16)) * 1024; }
      else dst = p.out + O_YS + (size_t)(r - NPR) * 1024;
#pragma unroll
      for (int i = 0; i < 4; ++i) *(float4*)(dst + i * 256 + lane * 4) = v[i];
    } else {
#pragma unroll
      for (int i = 0; i < 4; ++i) {
        uint2 o; o.x = pack2(v[i].x, v[i].y); o.y = pack2(v[i].z, v[i].w);
        *(uint2*)(XN + (size_t)r * 1024 + i * 256 + lane * 4) = o;
      }
      if (kind == 1) {
        const float* wi = p.in[14] + (size_t)l * 1024 * 6408 + 1024;
        float acc[8];
#pragma unroll
        for (int j = 0; j < 8; ++j) acc[j] = 0.f;
#pragma unroll
        for (int i = 0; i < 4; ++i) {
          const float yv[4] = {v[i].x, v[i].y, v[i].z, v[i].w};
#pragma unroll
          for (int e = 0; e < 4; ++e) {
            const float4* wr = (const float4*)(wi + (size_t)(i * 256 + lane * 4 + e) * 6408);
            float4 a = wr[0], c = wr[1];
            acc[0] += yv[e] * a.x; acc[1] += yv[e] * a.y; acc[2] += yv[e] * a.z; acc[3] += yv[e] * a.w;
            acc[4] += yv[e] * c.x; acc[5] += yv[e] * c.y; acc[6] += yv[e] * c.z; acc[7] += yv[e] * c.w;
          }
        }
#pragma unroll
        for (int j = 0; j < 8; ++j) acc[j] = wave_sum(acc[j]);
        if (lane == 0) {
          *(float4*)(BA + (size_t)r * 8) = make_float4(acc[0], acc[1], acc[2], acc[3]);
          *(float4*)(BA + (size_t)r * 8 + 4) = make_float4(acc[4], acc[5], acc[6], acc[7]);
        }
      }
    }
  }
}

DEV int wmap(int mode, int R, int c0, int half) {
  if (mode == 0) return c0 + R;
  if (mode == 1) { int tile = R >> 7, r = R & 127; int type = (r >> 4) & 1; return type * half + tile * 64 + (r >> 5) * 16 + (r & 15); }
  return R < 1024 ? R : R + 8;
}
DEV void convT(const float* __restrict__ src, int ld, int K, int NR, u16* __restrict__ dst, int mode, int c0, int half,
               int& tbase, float* smem) {
  const int tid = tid_(), G = gridDim.x;
  const int kt = K >> 6, ntile = kt * (NR >> 6);
  int start = ((int)blockIdx.x - tbase) % G;
  if (start < 0) start += G;
  for (int t = start; t < ntile; t += G) {
    const int rt = t / kt, k0 = (t - rt * kt) * 64, R0 = rt * 64;
    __syncthreads();
    const int rr = tid & 63;
    const int col = wmap(mode, R0 + rr, c0, half);
#pragma unroll
    for (int i = 0; i < 16; ++i) {
      int kk = i * 4 + (tid >> 6);
      smem[kk * 65 + rr] = src[(size_t)(k0 + kk) * ld + col];
    }
    __syncthreads();
    const int r2 = tid >> 2, seg = (tid & 3) * 16;
    unsigned o[8];
#pragma unroll
    for (int e = 0; e < 8; ++e) o[e] = pack2(smem[(seg + 2 * e) * 65 + r2], smem[(seg + 2 * e + 1) * 65 + r2]);
    uint4* d = (uint4*)(dst + (size_t)(R0 + r2) * K + k0 + seg);
    d[0] = make_uint4(o[0], o[1], o[2], o[3]);
    d[1] = make_uint4(o[4], o[5], o[6], o[7]);
  }
  tbase = (tbase + ntile) % G;
}
DEV void phase_convw(const P& p, int l, float* smem) {
  u16* W = (u16*)(p.ws + OFF_W);
  int tb = 0;
  convT(p.in[11] + (size_t)l * 1024 * 5632, 5632, 1024, 5632, W + W_GU1, 1, 0, 2816, tb, smem);
  convT(p.in[12] + (size_t)l * 2816 * 1024, 1024, 2816, 1024, W + W_DN1, 0, 0, 0, tb, smem);
  convT(p.in[14] + (size_t)l * 1024 * 6408, 6408, 1024, 2304, W + W_INM, 2, 0, 0, tb, smem);
  convT(p.in[14] + (size_t)l * 1024 * 6408, 6408, 1024, 4096, W + W_ING, 0, 2312, 0, tb, smem);
  for (int n = 0; n < 4; ++n)
    convT(p.in[40] + (size_t)(l * 4 + n) * 256 * 1024, 1024, 256, 1024, W + W_BR + (size_t)n * 1024 * 256, 0, 0, 0, tb, smem);
  convT(p.in[41] + (size_t)l * 1024 * 1024, 1024, 1024, 1024, W + W_OUT, 0, 0, 0, tb, smem);
  convT(p.in[27] + (size_t)l * 256 * 512, 512, 256, 512, W + W_GLU, 1, 0, 256, tb, smem);
  convT(p.in[43] + (size_t)l * 1024 * 5632, 5632, 1024, 5632, W + W_GU2, 1, 0, 2816, tb, smem);
  convT(p.in[44] + (size_t)l * 2816 * 1024, 1024, 2816, 1024, W + W_DN2, 0, 0, 0, tb, smem);
}

template <int BN>
DEV void gemm_acc(const u16* __restrict__ A, int lda, const u16* __restrict__ Bt, int ldb, int K, f32x4 (&acc)[4][BN / 32],
                  u16* sA, u16* sB) {
  constexpr int NI = BN / 32;
  const int tid = tid_(), lane = tid & 63, w = tid >> 6, wm = w >> 1, wn = w & 1;
  const int lrow = tid >> 3, lseg = (tid & 7) * 8;
  const u16* ga = A + (size_t)lrow * lda + lseg;
  const u16* gb = Bt + (size_t)lrow * ldb + lseg;
  u16* wa = sA + lrow * 72 + lseg;
  u16* wb = sB + lrow * 72 + lseg;
  const u16* fa = sA + (wm * 64 + (lane & 15)) * 72 + (lane >> 4) * 8;
  const u16* fb = sB + (wn * (BN / 2) + (lane & 15)) * 72 + (lane >> 4) * 8;
  u32x4 pa0, pa1, pa2, pa3, pb0, pb1, pb2, pb3, qa0, qa1, qa2, qa3, qb0, qb1, qb2, qb3;
#define GA_LOAD(X, koff) do { const u16* _ga = ga + (koff); const u16* _gb = gb + (koff); \
    X##a0 = *(const u32x4*)(_ga); X##a1 = *(const u32x4*)(_ga + (size_t)32 * lda); X##a2 = *(const u32x4*)(_ga + (size_t)64 * lda); X##a3 = *(const u32x4*)(_ga + (size_t)96 * lda); \
    X##b0 = *(const u32x4*)(_gb); X##b1 = *(const u32x4*)(_gb + (size_t)32 * ldb); \
    if (BN == 128) { X##b2 = *(const u32x4*)(_gb + (size_t)64 * ldb); X##b3 = *(const u32x4*)(_gb + (size_t)96 * ldb); } } while (0)
#define GA_WRITE(X) do { *(u32x4*)(wa) = X##a0; *(u32x4*)(wa + 32 * 72) = X##a1; *(u32x4*)(wa + 64 * 72) = X##a2; *(u32x4*)(wa + 96 * 72) = X##a3; \
    *(u32x4*)(wb) = X##b0; *(u32x4*)(wb + 32 * 72) = X##b1; \
    if (BN == 128) { *(u32x4*)(wb + 64 * 72) = X##b2; *(u32x4*)(wb + 96 * 72) = X##b3; } } while (0)
#define GA_COMPUTE() do { _Pragma("unroll") for (int kk = 0; kk < 64; kk += 32) { bf16x8 a[4], b[NI]; \
    _Pragma("unroll") for (int mi = 0; mi < 4; ++mi) a[mi] = *(const bf16x8*)(fa + mi * 16 * 72 + kk); \
    _Pragma("unroll") for (int ni = 0; ni < NI; ++ni) b[ni] = *(const bf16x8*)(fb + ni * 16 * 72 + kk); \
    _Pragma("unroll") for (int mi = 0; mi < 4; ++mi) _Pragma("unroll") for (int ni = 0; ni < NI; ++ni) \
      acc[mi][ni] = __builtin_amdgcn_mfma_f32_16x16x32_bf16(a[mi], b[ni], acc[mi][ni], 0, 0, 0); } } while (0)
  GA_LOAD(p, 0);
  if (K > 64) GA_LOAD(q, 64);
  for (int k0 = 0; k0 < K; k0 += 128) {
    __syncthreads();
    GA_WRITE(p);
    __syncthreads();
    if (k0 + 128 < K) GA_LOAD(p, k0 + 128);
    GA_COMPUTE();
    if (k0 + 64 >= K) break;
    __syncthreads();
    GA_WRITE(q);
    __syncthreads();
    if (k0 + 192 < K) GA_LOAD(q, k0 + 192);
    GA_COMPUTE();
  }
#undef GA_LOAD
#undef GA_WRITE
#undef GA_COMPUTE
}

template <int MODE>
DEV void dual_tile(const u16* A, int lda, int K, const u16* Wt, int mt, int nt, u16* out, int ldo, int ocol0, const float* bias,
                   u16* sA, u16* sB) {
  f32x4 acc[4][4];
#pragma unroll
  for (int i = 0; i < 4; ++i)
#pragma unroll
    for (int j = 0; j < 4; ++j) acc[i][j] = (f32x4){0.f, 0.f, 0.f, 0.f};
  gemm_acc<128>(A + (size_t)mt * 128 * lda, lda, Wt + (size_t)nt * 128 * K, K, K, acc, sA, sB);
  const int tid0 = tid_(); const int lane = tid0 & 63, w = tid0 >> 6, wm = w >> 1, wn = w & 1;
#pragma unroll
  for (int mi = 0; mi < 4; ++mi)
#pragma unroll
    for (int np = 0; np < 2; ++np) {
      const int col = nt * 64 + (wn * 2 + np) * 16 + (lane & 15);
      float b0 = 0.f, b1 = 0.f;
      if (MODE == 1) { b0 = bias[col]; b1 = bias[256 + col]; }
#pragma unroll
      for (int j = 0; j < 4; ++j) {
        const int row = mt * 128 + wm * 64 + mi * 16 + (lane >> 4) * 4 + j;
        float g = acc[mi][2 * np][j], u = acc[mi][2 * np + 1][j];
        float v = (MODE == 0) ? siluf_(g) * u : (g + b0) * sigm(u + b1);
        out[(size_t)row * ldo + ocol0 + col] = f2bf(v);
      }
    }
}
DEV void resid_tile(const u16* A, int lda, int K, const u16* Wt, int mt, int nt, float* X, float scale, u16* sA, u16* sB) {
  f32x4 acc[4][4];
#pragma unroll
  for (int i = 0; i < 4; ++i)
#pragma unroll
    for (int j = 0; j < 4; ++j) acc[i][j] = (f32x4){0.f, 0.f, 0.f, 0.f};
  gemm_acc<128>(A + (size_t)mt * 128 * lda, lda, Wt + (size_t)nt * 128 * K, K, K, acc, sA, sB);
  const int tid0 = tid_(); const int lane = tid0 & 63, w = tid0 >> 6, wm = w >> 1, wn = w & 1;
#pragma unroll
  for (int mi = 0; mi < 4; ++mi)
#pragma unroll
    for (int ni = 0; ni < 4; ++ni) {
      const int col = nt * 128 + wn * 64 + ni * 16 + (lane & 15);
#pragma unroll
      for (int j = 0; j < 4; ++j) {
        const int row = mt * 128 + wm * 64 + mi * 16 + (lane >> 4) * 4 + j;
        X[(size_t)row * 1024 + col] += scale * acc[mi][ni][j];
      }
    }
}
DEV void zm_tile(const u16* A, const u16* Wt, int mt, int nt, u16* Zm, u16* sA, u16* sB) {
  f32x4 acc[4][4];
#pragma unroll
  for (int i = 0; i < 4; ++i)
#pragma unroll
    for (int j = 0; j < 4; ++j) acc[i][j] = (f32x4){0.f, 0.f, 0.f, 0.f};
  gemm_acc<128>(A + (size_t)mt * 128 * 1024, 1024, Wt + (size_t)nt * 128 * 1024, 1024, 1024, acc, sA, sB);
  const int tid0 = tid_(); const int lane = tid0 & 63, w = tid0 >> 6, wm = w >> 1, wn = w & 1;
#pragma unroll
  for (int mi = 0; mi < 4; ++mi)
#pragma unroll
    for (int ni = 0; ni < 4; ++ni) {
      const int col = nt * 128 + wn * 64 + ni * 16 + (lane & 15);
#pragma unroll
      for (int j = 0; j < 4; ++j) {
        const int row = mt * 128 + wm * 64 + mi * 16 + (lane >> 4) * 4 + j;
        Zm[(size_t)row * ZW + col] = f2bf(acc[mi][ni][j]);
      }
    }
}

DEV void gemm_acc256(const u16* __restrict__ A, int lda, const u16* __restrict__ Bt, int ldb, int K, f32x4 (&acc)[4][8],
                     u16* sA, u16* sB) {
  const int tid = tid_(), lane = tid & 63, w = tid >> 6, wm = w >> 1, wn = w & 1;
  const int lrow = tid >> 3, lseg = (tid & 7) * 8;
  const u16* ga = A + (size_t)lrow * lda + lseg;
  const u16* gb = Bt + (size_t)lrow * ldb + lseg;
  u16* wa = sA + lrow * 72 + lseg;
  u16* wb = sB + lrow * 72 + lseg;
  const u16* fa = sA + (wm * 64 + (lane & 15)) * 72 + (lane >> 4) * 8;
  const u16* fb = sB + (wn * 128 + (lane & 15)) * 72 + (lane >> 4) * 8;
  u32x4 ra0, ra1, ra2, ra3, rb0, rb1, rb2, rb3, rb4, rb5, rb6, rb7;
  ra0 = *(const u32x4*)(ga);
  ra1 = *(const u32x4*)(ga + (size_t)32 * lda);
  ra2 = *(const u32x4*)(ga + (size_t)64 * lda);
  ra3 = *(const u32x4*)(ga + (size_t)96 * lda);
  rb0 = *(const u32x4*)(gb);
  rb1 = *(const u32x4*)(gb + (size_t)32 * ldb);
  rb2 = *(const u32x4*)(gb + (size_t)64 * ldb);
  rb3 = *(const u32x4*)(gb + (size_t)96 * ldb);
  rb4 = *(const u32x4*)(gb + (size_t)128 * ldb);
  rb5 = *(const u32x4*)(gb + (size_t)160 * ldb);
  rb6 = *(const u32x4*)(gb + (size_t)192 * ldb);
  rb7 = *(const u32x4*)(gb + (size_t)224 * ldb);
  for (int k0 = 0; k0 < K; k0 += 64) {
    __syncthreads();
    *(u32x4*)(wa) = ra0; *(u32x4*)(wa + 32 * 72) = ra1; *(u32x4*)(wa + 64 * 72) = ra2; *(u32x4*)(wa + 96 * 72) = ra3;
    *(u32x4*)(wb) = rb0; *(u32x4*)(wb + 32 * 72) = rb1; *(u32x4*)(wb + 64 * 72) = rb2; *(u32x4*)(wb + 96 * 72) = rb3;
    *(u32x4*)(wb + 128 * 72) = rb4; *(u32x4*)(wb + 160 * 72) = rb5; *(u32x4*)(wb + 192 * 72) = rb6; *(u32x4*)(wb + 224 * 72) = rb7;
    __syncthreads();
    if (k0 + 64 < K) {
      const u16* ga2 = ga + k0 + 64;
      const u16* gb2 = gb + k0 + 64;
      ra0 = *(const u32x4*)(ga2);
      ra1 = *(const u32x4*)(ga2 + (size_t)32 * lda);
      ra2 = *(const u32x4*)(ga2 + (size_t)64 * lda);
      ra3 = *(const u32x4*)(ga2 + (size_t)96 * lda);
      rb0 = *(const u32x4*)(gb2);
      rb1 = *(const u32x4*)(gb2 + (size_t)32 * ldb);
      rb2 = *(const u32x4*)(gb2 + (size_t)64 * ldb);
      rb3 = *(const u32x4*)(gb2 + (size_t)96 * ldb);
      rb4 = *(const u32x4*)(gb2 + (size_t)128 * ldb);
      rb5 = *(const u32x4*)(gb2 + (size_t)160 * ldb);
      rb6 = *(const u32x4*)(gb2 + (size_t)192 * ldb);
      rb7 = *(const u32x4*)(gb2 + (size_t)224 * ldb);
    }
#pragma unroll
    for (int kk = 0; kk < 64; kk += 32) {
      bf16x8 a[4];
#pragma unroll
      for (int mi = 0; mi < 4; ++mi) a[mi] = *(const bf16x8*)(fa + mi * 16 * 72 + kk);
#pragma unroll
      for (int nh = 0; nh < 2; ++nh) {
        bf16x8 b[4];
#pragma unroll
        for (int ni = 0; ni < 4; ++ni) b[ni] = *(const bf16x8*)(fb + (nh * 4 + ni) * 16 * 72 + kk);
#pragma unroll
        for (int mi = 0; mi < 4; ++mi)
#pragma unroll
          for (int ni = 0; ni < 4; ++ni)
            acc[mi][nh * 4 + ni] = __builtin_amdgcn_mfma_f32_16x16x32_bf16(a[mi], b[ni], acc[mi][nh * 4 + ni], 0, 0, 0);
      }
    }
  }
}
DEV void dual_tile256(const u16* A, const u16* Wt, int mt, int nt, u16* out, u16* sA, u16* sB) {
  f32x4 acc[4][8];
#pragma unroll
  for (int i = 0; i < 4; ++i)
#pragma unroll
    for (int j = 0; j < 8; ++j) acc[i][j] = (f32x4){0.f, 0.f, 0.f, 0.f};
  gemm_acc256(A + (size_t)mt * 128 * 1024, 1024, Wt + (size_t)nt * 256 * 1024, 1024, 1024, acc, sA, sB);
  const int tid0 = tid_(); const int lane = tid0 & 63, w = tid0 >> 6, wm = w >> 1, wn = w & 1;
#pragma unroll
  for (int mi = 0; mi < 4; ++mi)
#pragma unroll
    for (int np = 0; np < 4; ++np) {
      const int col = (nt * 2 + wn) * 64 + np * 16 + (lane & 15);
#pragma unroll
      for (int j = 0; j < 4; ++j) {
        const int row = mt * 128 + wm * 64 + mi * 16 + (lane >> 4) * 4 + j;
        out[(size_t)row * 2816 + col] = f2bf(siluf_(acc[mi][2 * np][j]) * acc[mi][2 * np + 1][j]);
      }
    }
}
DEV void zm_tile256(const u16* A, const u16* Wt, int mt, int nt, u16* Zm, u16* sA, u16* sB) {
  f32x4 acc[4][8];
#pragma unroll
  for (int i = 0; i < 4; ++i)
#pragma unroll
    for (int j = 0; j < 8; ++j) acc[i][j] = (f32x4){0.f, 0.f, 0.f, 0.f};
  gemm_acc256(A + (size_t)mt * 128 * 1024, 1024, Wt + (size_t)nt * 256 * 1024, 1024, 1024, acc, sA, sB);
  const int tid0 = tid_(); const int lane = tid0 & 63, w = tid0 >> 6, wm = w >> 1, wn = w & 1;
#pragma unroll
  for (int mi = 0; mi < 4; ++mi)
#pragma unroll
    for (int ni = 0; ni < 8; ++ni) {
      const int col = nt * 256 + wn * 128 + ni * 16 + (lane & 15);
#pragma unroll
      for (int j = 0; j < 4; ++j) {
        const int row = mt * 128 + wm * 64 + mi * 16 + (lane >> 4) * 4 + j;
        Zm[(size_t)row * ZW + col] = f2bf(acc[mi][ni][j]);
      }
    }
}
DEV void g4_tile(const P& p, int mt, int nt, u16* sA, u16* sB) {
  const u16* BR = (const u16*)(p.ws + OFF_D + D_BR);
  const u16* XN = (const u16*)(p.ws + OFF_XN);
  const u16* Wb = (const u16*)(p.ws + OFF_W) + W_BR;
  const u16* Wg = (const u16*)(p.ws + OFF_W) + W_ING;
  u16* M = (u16*)(p.ws + OFF_D + D_M);
  f32x4 accM[4][2];
#pragma unroll
  for (int i = 0; i < 4; ++i)
#pragma unroll
    for (int j = 0; j < 2; ++j) accM[i][j] = (f32x4){0.f, 0.f, 0.f, 0.f};
#pragma unroll 1
  for (int n = 0; n < 4; ++n) {
    unsigned gate[4][2][2];
    {
      f32x4 accG[4][2];
#pragma unroll
      for (int i = 0; i < 4; ++i)
#pragma unroll
        for (int j = 0; j < 2; ++j) accG[i][j] = (f32x4){0.f, 0.f, 0.f, 0.f};
      gemm_acc<64>(XN + (size_t)mt * 128 * 1024, 1024, Wg + ((size_t)n * 1024 + nt * 64) * 1024, 1024, 1024, accG, sA, sB);
#pragma unroll
      for (int i = 0; i < 4; ++i)
#pragma unroll
        for (int j = 0; j < 2; ++j) {
          gate[i][j][0] = pack2(sigm(accG[i][j][0]), sigm(accG[i][j][1]));
          gate[i][j][1] = pack2(sigm(accG[i][j][2]), sigm(accG[i][j][3]));
        }
    }
    f32x4 accP[4][2];
#pragma unroll
    for (int i = 0; i < 4; ++i)
#pragma unroll
      for (int j = 0; j < 2; ++j) accP[i][j] = (f32x4){0.f, 0.f, 0.f, 0.f};
    gemm_acc<64>(BR + (size_t)mt * 128 * 1024 + n * 256, 1024, Wb + ((size_t)n * 1024 + nt * 64) * 256, 256, 256, accP, sA, sB);
#pragma unroll
    for (int i = 0; i < 4; ++i)
#pragma unroll
      for (int j = 0; j < 2; ++j) {
        accM[i][j][0] += bflo(gate[i][j][0]) * accP[i][j][0];
        accM[i][j][1] += bfhi(gate[i][j][0]) * accP[i][j][1];
        accM[i][j][2] += bflo(gate[i][j][1]) * accP[i][j][2];
        accM[i][j][3] += bfhi(gate[i][j][1]) * accP[i][j][3];
      }
  }
  const int tid0 = tid_(); const int lane = tid0 & 63, w = tid0 >> 6, wm = w >> 1, wn = w & 1;
#pragma unroll
  for (int mi = 0; mi < 4; ++mi)
#pragma unroll
    for (int ni = 0; ni < 2; ++ni) {
      const int col = nt * 64 + wn * 32 + ni * 16 + (lane & 15);
#pragma unroll
      for (int j = 0; j < 4; ++j) {
        const int row = mt * 128 + wm * 64 + mi * 16 + (lane >> 4) * 4 + j;
        M[(size_t)row * 1024 + col] = f2bf(accM[mi][ni][j]);
      }
    }
}

DEV void dn_conv16(const u16* __restrict__ Zm, const float* __restrict__ buf, const float* __restrict__ cw, int rowbase, int t, int c,
                   float (&o)[16]) {
#pragma unroll
  for (int e = 0; e < 16; ++e) o[e] = 0.f;
#pragma unroll
  for (int tap = 0; tap < 4; ++tap) {
    const int tau = t - 3 + tap;
    float x[16];
    if (tau >= 0) {
      const uint4* z = (const uint4*)(Zm + (size_t)(rowbase + tau) * ZW + c);
      unpack16(z[0], z[1], x);
    } else if (buf) {
      const float4* bb = (const float4*)(buf + (3 + tau) * 768 + c);
#pragma unroll
      for (int q = 0; q < 4; ++q) { float4 f = bb[q]; x[q * 4] = f.x; x[q * 4 + 1] = f.y; x[q * 4 + 2] = f.z; x[q * 4 + 3] = f.w; }
    } else {
#pragma unroll
      for (int e = 0; e < 16; ++e) x[e] = 0.f;
    }
    const float4* w4 = (const float4*)(cw + tap * 768 + c);
#pragma unroll
    for (int q = 0; q < 4; ++q) {
      float4 f = w4[q];
      o[q * 4] += f.x * x[q * 4]; o[q * 4 + 1] += f.y * x[q * 4 + 1]; o[q * 4 + 2] += f.z * x[q * 4 + 2]; o[q * 4 + 3] += f.w * x[q * 4 + 3];
    }
  }
#pragma unroll
  for (int e = 0; e < 16; ++e) o[e] = siluf_(o[e]);
}

DEV void delta_pre(const P& p, int l, int idx, float* smem) {
  float* sq = smem;
  float* sk = smem + 64 * 68;
  float* sL = smem + 2 * 64 * 68;
  float* sbeta = sL + 4096;
  float* sg = sbeta + 64;
  float* sgc = sg + 64;
  int s, h, j, pad, T;
  if (idx < 1056) { s = idx / 132; int r = idx - s * 132; h = r / 33; j = r - h * 33; pad = 48; T = TP; }
  else { int r = idx - 1056; s = 8 + (r >> 2); h = r & 3; j = 0; pad = 56; T = 8; }
  const int tid = tid_();
  const u16* Zm = (const u16*)(p.ws + OFF_D + D_ZM);
  const float* BA = (const float*)(p.ws + OFF_BA);
  const float* cw = p.in[15] + l * 4 * 768;
  const float* buf = (s >= 8) ? p.in[3] + (size_t)(l * 128 + (s - 8)) * 3 * 768 : nullptr;
  const int rowbase = rowbase_of(s);
  u16* wsb = (u16*)p.out + (size_t)idx * 20480;
  float* gamma = (float*)(p.ws + OFF_GAMMA);
  {
    const int i = tid >> 2, dq = (tid & 3) * 16;
    const int t = j * 64 + i - pad;
    float qv[16], kv[16];
    float sq_ = 0.f, sk_ = 0.f;
    if (t >= 0) {
      dn_conv16(Zm, buf, cw, rowbase, t, h * 64 + dq, qv);
      dn_conv16(Zm, buf, cw, rowbase, t, 256 + h * 64 + dq, kv);
#pragma unroll
      for (int e = 0; e < 16; ++e) { sq_ += qv[e] * qv[e]; sk_ += kv[e] * kv[e]; }
    } else {
#pragma unroll
      for (int e = 0; e < 16; ++e) { qv[e] = 0.f; kv[e] = 0.f; }
    }
    sq_ += __shfl_xor(sq_, 1, 64); sq_ += __shfl_xor(sq_, 2, 64);
    sk_ += __shfl_xor(sk_, 1, 64); sk_ += __shfl_xor(sk_, 2, 64);
    const float qs = rsqrtf(sq_ + 1e-6f) * 0.125f, ks = rsqrtf(sk_ + 1e-6f);
#pragma unroll
    for (int e = 0; e < 16; ++e) { sq[i * 68 + dq + e] = qv[e] * qs; sk[i * 68 + dq + e] = kv[e] * ks; }
  }
  if (tid < 64) {
    const int t = j * 64 + tid - pad;
    float be = 0.f, g = 0.f;
    if (t >= 0) {
      const float* ba = BA + (size_t)(rowbase + t) * 8;
      be = sigm(ba[h]);
      float a = ba[4 + h] + p.in[17][l * 4 + h];
      g = -expf(p.in[16][l * 4 + h]) * softplusf_(a);
    }
    sbeta[tid] = be;
    sg[tid] = g;
  }
  __syncthreads();
  if (tid < 64) {
    float c = 0.f;
    for (int i2 = 0; i2 <= tid; ++i2) c += sg[i2];
    sgc[tid] = c;
  }
  __syncthreads();
  {
    const int ti = tid >> 4, tj = tid & 15;
    float aL[4][4], aI[4][4];
#pragma unroll
    for (int a = 0; a < 4; ++a)
#pragma unroll
      for (int b = 0; b < 4; ++b) { aL[a][b] = 0.f; aI[a][b] = 0.f; }
    for (int d = 0; d < 64; d += 4) {
      float4 qa[4], ka[4], kb[4];
#pragma unroll
      for (int a = 0; a < 4; ++a) { qa[a] = *(const float4*)&sq[(ti + 16 * a) * 68 + d]; ka[a] = *(const float4*)&sk[(ti + 16 * a) * 68 + d]; }
#pragma unroll
      for (int b = 0; b < 4; ++b) kb[b] = *(const float4*)&sk[(tj + 16 * b) * 68 + d];
#pragma unroll
      for (int a = 0; a < 4; ++a)
#pragma unroll
        for (int b = 0; b < 4; ++b) {
          aL[a][b] += ka[a].x * kb[b].x + ka[a].y * kb[b].y + ka[a].z * kb[b].z + ka[a].w * kb[b].w;
          aI[a][b] += qa[a].x * kb[b].x + qa[a].y * kb[b].y + qa[a].z * kb[b].z + qa[a].w * kb[b].w;
        }
    }
#pragma unroll
    for (int a = 0; a < 4; ++a)
#pragma unroll
      for (int b = 0; b < 4; ++b) {
        const int i = ti + 16 * a, jj = tj + 16 * b;
        const float dec = (jj <= i) ? __expf(sgc[i] - sgc[jj]) : 0.f;
        sL[i * 64 + jj] = (jj < i) ? aL[a][b] * sbeta[i] * dec : 0.f;
        wsb[3 * 4096 + i * 64 + jj] = f2bf(aI[a][b] * dec);
      }
  }
  for (int e = tid; e < 4096; e += 256) {
    const int i = e >> 6, d = e & 63;
    wsb[2 * 4096 + e] = f2bf(sq[i * 68 + d] * __expf(sgc[i]));
  }
  for (int e = tid; e < 4096; e += 256) {
    const int d = e >> 6, i = e & 63;
    wsb[4 * 4096 + e] = f2bf(sk[i * 68 + d] * __expf(sgc[63] - sgc[i]));
  }
  if (tid == 0) gamma[idx] = __expf(sgc[63]);
  __syncthreads();
  {
    const int i = tid >> 2, dq = (tid & 3) * 16;
    const int t = j * 64 + i - pad;
    float vv[16];
    if (t >= 0) dn_conv16(Zm, buf, cw, rowbase, t, 512 + h * 64 + dq, vv);
    else {
#pragma unroll
      for (int e = 0; e < 16; ++e) vv[e] = 0.f;
    }
    const float be = sbeta[i], eg = be * __expf(sgc[i]);
#pragma unroll
    for (int e = 0; e < 16; ++e) { sq[i * 68 + dq + e] = vv[e] * be; sk[i * 68 + dq + e] *= eg; }
  }
  __syncthreads();
  {
    float* arr = (tid < 128) ? sq : sk;
    const int col = (tid >> 1) & 63, hf = tid & 1;
    for (int i = 1; i < 64; ++i) {
      float acc = 0.f;
      for (int j0 = hf * 4; j0 < i; j0 += 8) {
        const float4 l4 = *(const float4*)&sL[i * 64 + j0];
        acc -= l4.x * arr[j0 * 68 + col] + l4.y * arr[(j0 + 1) * 68 + col] + l4.z * arr[(j0 + 2) * 68 + col] + l4.w * arr[(j0 + 3) * 68 + col];
      }
      acc += __shfl_xor(acc, 1, 64);
      if (hf == 0) arr[i * 68 + col] += acc;
    }
  }
  __syncthreads();
  for (int e = tid; e < 4096; e += 256) {
    const int i = e >> 6, d = e & 63;
    wsb[e] = f2bf(sq[i * 68 + d]);
    wsb[4096 + e] = f2bf(sk[i * 68 + d]);
  }
  if (h == 0 && j == (s < 8 ? 32 : 0)) {
    float* o = st_out(p, O_PDCONV, O_SDCONV, l, s, 3 * 768);
    for (int e = tid; e < 3 * 768; e += 256) {
      const int r = e / 768, c = e - r * 768;
      o[e] = bf2f(Zm[(size_t)(rowbase + T - 3 + r) * ZW + c]);
    }
  }
}

DEV void mm64(const float* __restrict__ A, const float* __restrict__ B, float (&acc)[4][4], int ti, int tj) {
#pragma unroll 4
  for (int kk = 0; kk < 64; kk += 4) {
    float4 a[4], b[4];
#pragma unroll
    for (int x = 0; x < 4; ++x) a[x] = *(const float4*)&A[(ti + 16 * x) * 68 + kk];
#pragma unroll
    for (int y = 0; y < 4; ++y) b[y] = *(const float4*)&B[(kk + y) * 64 + tj * 4];
#pragma unroll
    for (int x = 0; x < 4; ++x) {
      acc[x][0] += a[x].x * b[0].x + a[x].y * b[1].x + a[x].z * b[2].x + a[x].w * b[3].x;
      acc[x][1] += a[x].x * b[0].y + a[x].y * b[1].y + a[x].z * b[2].y + a[x].w * b[3].y;
      acc[x][2] += a[x].x * b[0].z + a[x].y * b[1].z + a[x].z * b[2].z + a[x].w * b[3].z;
      acc[x][3] += a[x].x * b[0].w + a[x].y * b[1].w + a[x].z * b[2].w + a[x].w * b[3].w;
    }
  }
}
DEV void storeA16(float* sA, uint4 r0, uint4 r1) {
  const int tid = tid_();
  float x[16];
  unpack16(r0, r1, x);
  float* d = sA + (tid >> 2) * 68 + (tid & 3) * 16;
#pragma unroll
  for (int q = 0; q < 4; ++q) *(float4*)(d + q * 4) = make_float4(x[q * 4], x[q * 4 + 1], x[q * 4 + 2], x[q * 4 + 3]);
}

DEV void mm64h(const u16* __restrict__ A, const float* __restrict__ B, float (&acc)[4][4], int ti, int tj) {
#pragma unroll 4
  for (int kk = 0; kk < 64; kk += 4) {
    float4 a[4], b[4];
#pragma unroll
    for (int x = 0; x < 4; ++x) {
      const uint2 av = *(const uint2*)&A[(ti + 16 * x) * 72 + kk];
      a[x] = make_float4(bflo(av.x), bfhi(av.x), bflo(av.y), bfhi(av.y));
    }
#pragma unroll
    for (int y = 0; y < 4; ++y) b[y] = *(const float4*)&B[(kk + y) * 64 + tj * 4];
#pragma unroll
    for (int x = 0; x < 4; ++x) {
      acc[x][0] += a[x].x * b[0].x + a[x].y * b[1].x + a[x].z * b[2].x + a[x].w * b[3].x;
      acc[x][1] += a[x].x * b[0].y + a[x].y * b[1].y + a[x].z * b[2].y + a[x].w * b[3].y;
      acc[x][2] += a[x].x * b[0].z + a[x].y * b[1].z + a[x].z * b[2].z + a[x].w * b[3].z;
      acc[x][3] += a[x].x * b[0].w + a[x].y * b[1].w + a[x].z * b[2].w + a[x].w * b[3].w;
    }
  }
}
DEV void store16h(u16* sA, uint4 r0, uint4 r1) {
  const int tid = tid_();
  uint4* d = (uint4*)(sA + (tid >> 2) * 72 + (tid & 3) * 16);
  d[0] = r0; d[1] = r1;
}

DEV void delta_seq(const P& p, int l, int s, int h, float* smem) {
  float* sS = smem;
  float* sV = smem + 4096;
  u16* sA0 = (u16*)(smem + 8192);
  u16* sA1 = sA0 + 64 * 72;
  u16* sA2 = sA1 + 64 * 72;
  const int tid = tid_(), ti = tid >> 4, tj = tid & 15;
  const int n = (s < 8) ? 33 : 1, pad = (s < 8) ? 48 : 56;
  const int item0 = (s < 8) ? (s * 4 + h) * 33 : 1056 + (s - 8) * 4 + h;
  const int rowbase = rowbase_of(s);
  const float* s0 = (s >= 8) ? p.in[2] + (size_t)((l * 128 + (s - 8)) * 4 + h) * 4096 : nullptr;
  for (int e = tid; e < 4096; e += 256) sS[e] = s0 ? s0[e] : 0.f;
  const u16* wsb = (const u16*)p.out + (size_t)item0 * 20480;
  const float* gamma = (const float*)(p.ws + OFF_GAMMA) + item0;
  const u16* Zm = (const u16*)(p.ws + OFF_D + D_ZM);
  u16* BR = (u16*)(p.ws + OFF_D + D_BR);
  const float4 ng = *(const float4*)(p.in[18] + l * 64 + tj * 4);
  uint4 rw0, rw1, rq0, rq1, ri0, ri1, rk0, rk1;
  {
    const uint4* src = (const uint4*)(wsb + tid * 16);
    rw0 = src[512]; rw1 = src[513];
    rq0 = src[1024]; rq1 = src[1025];
    ri0 = src[1536]; ri1 = src[1537];
    rk0 = src[2048]; rk1 = src[2049];
  }
  for (int j = 0; j < n; ++j) {
    const u16* it = wsb + (size_t)j * 20480;
    uint2 uu_pf[4], zz_pf[4];
#pragma unroll
    for (int a = 0; a < 4; ++a) {
      const int i = ti + 16 * a;
      uu_pf[a] = *(const uint2*)(it + i * 64 + tj * 4);
      const int t = j * 64 + i - pad;
      zz_pf[a] = (t >= 0) ? *(const uint2*)(Zm + (size_t)(rowbase + t) * ZW + 768 + h * 64 + tj * 4) : make_uint2(0u, 0u);
    }
    const float gm = gamma[j];
    __syncthreads();
    store16h(sA0, rw0, rw1); store16h(sA1, rq0, rq1); store16h(sA2, ri0, ri1);
    __syncthreads();
    if (j + 1 < n) {
      const uint4* src = (const uint4*)(it + 20480 + tid * 16);
      rw0 = src[512]; rw1 = src[513]; rq0 = src[1024]; rq1 = src[1025]; ri0 = src[1536]; ri1 = src[1537];
    }
    float acc[4][4];
#pragma unroll
    for (int a = 0; a < 4; ++a)
#pragma unroll
      for (int c = 0; c < 4; ++c) acc[a][c] = 0.f;
    mm64h(sA0, sS, acc, ti, tj);
#pragma unroll
    for (int a = 0; a < 4; ++a) {
      const int i = ti + 16 * a;
      const uint2 uu = uu_pf[a];
      *(float4*)&sV[i * 64 + tj * 4] = make_float4(bflo(uu.x) - acc[a][0], bfhi(uu.x) - acc[a][1], bflo(uu.y) - acc[a][2], bfhi(uu.y) - acc[a][3]);
    }
    __syncthreads();
    store16h(sA0, rk0, rk1);
    if (j + 1 < n) { const uint4* src = (const uint4*)(it + 20480 + tid * 16); rk0 = src[2048]; rk1 = src[2049]; }
    float o[4][4];
#pragma unroll
    for (int a = 0; a < 4; ++a)
#pragma unroll
      for (int c = 0; c < 4; ++c) o[a][c] = 0.f;
    mm64h(sA1, sS, o, ti, tj);
    mm64h(sA2, sV, o, ti, tj);
#pragma unroll
    for (int a = 0; a < 4; ++a) {
      const int i = ti + 16 * a;
      const int t = j * 64 + i - pad;
      float ss = o[a][0] * o[a][0] + o[a][1] * o[a][1] + o[a][2] * o[a][2] + o[a][3] * o[a][3];
      ss += __shfl_xor(ss, 1, 64); ss += __shfl_xor(ss, 2, 64); ss += __shfl_xor(ss, 4, 64); ss += __shfl_xor(ss, 8, 64);
      if (t >= 0) {
        const float inv = rsqrtf(ss * (1.f / 64.f) + 1e-6f);
        const size_t row = (size_t)(rowbase + t);
        const uint2 zz = zz_pf[a];
        float y0 = o[a][0] * inv * ng.x * siluf_(bflo(zz.x));
        float y1 = o[a][1] * inv * ng.y * siluf_(bfhi(zz.x));
        float y2 = o[a][2] * inv * ng.z * siluf_(bflo(zz.y));
        float y3 = o[a][3] * inv * ng.w * siluf_(bfhi(zz.y));
        uint2 ov; ov.x = pack2(y0, y1); ov.y = pack2(y2, y3);
        *(uint2*)(BR + row * 1024 + h * 64 + tj * 4) = ov;
      }
    }
    __syncthreads();
#pragma unroll
    for (int a = 0; a < 4; ++a)
#pragma unroll
      for (int c = 0; c < 4; ++c) acc[a][c] = 0.f;
    mm64h(sA0, sV, acc, ti, tj);
#pragma unroll
    for (int a = 0; a < 4; ++a) {
      float4* sp = (float4*)&sS[(ti + 16 * a) * 64 + tj * 4];
      float4 old = *sp;
      *sp = make_float4(gm * old.x + acc[a][0], gm * old.y + acc[a][1], gm * old.z + acc[a][2], gm * old.w + acc[a][3]);
    }
  }
  __syncthreads();
  float* so = st_out(p, O_PDELTA, O_SDELTA, l, s, 4 * 4096) + h * 4096;
  for (int e = tid; e < 4096; e += 256) so[e] = sS[e];
}

DEV void s5_block(const P& p, int l, int s, int gq, float* smem) {
  const int tid = tid_(), lane = tid & 63;
  const int w = __builtin_amdgcn_readfirstlane(tid >> 6);
  const int g = gq * 4 + w;
  float* sC = smem + w * 3248;
  float* sH = sC + 2080;
  float* sU = sH + 1040;
  const int T = (s < 8) ? TP : 8;
  const int rowbase = rowbase_of(s);
  const u16* Zm = (const u16*)(p.ws + OFF_D + D_ZM);
  u16* Y5 = (u16*)(p.ws + OFF_D + D_Y5);
  const int lg_ = l * 16 + g;
  const float lr = p.in[19][lg_ * 64 + lane], li = p.in[20][lg_ * 64 + lane];
  const float dt = expf(p.in[21][lg_]);
  const float mag = expf(lr * dt);
  const float lbr = mag * cosf(li * dt), lbi = mag * sinf(li * dt);
  const float den = lr * lr + li * li;
  const float cfr = ((lbr - 1.f) * lr + lbi * li) / den, cfi = (lbi * lr - (lbr - 1.f) * li) / den;
  float xr_c[16], xi_c[16];
  {
    const float4* br4 = (const float4*)(p.in[22] + ((size_t)lg_ * 64 + lane) * 16);
    const float4* bi4 = (const float4*)(p.in[23] + ((size_t)lg_ * 64 + lane) * 16);
#pragma unroll
    for (int q = 0; q < 4; ++q) {
      float4 a = br4[q], b = bi4[q];
      xr_c[q * 4] = cfr * a.x - cfi * b.x; xi_c[q * 4] = cfr * b.x + cfi * a.x;
      xr_c[q * 4 + 1] = cfr * a.y - cfi * b.y; xi_c[q * 4 + 1] = cfr * b.y + cfi * a.y;
      xr_c[q * 4 + 2] = cfr * a.z - cfi * b.z; xi_c[q * 4 + 2] = cfr * b.z + cfi * a.z;
      xr_c[q * 4 + 3] = cfr * a.w - cfi * b.w; xi_c[q * 4 + 3] = cfr * b.w + cfi * a.w;
    }
  }
  for (int e = lane; e < 1024; e += 64) {
    const int c = e >> 6, pp = e & 63;
    sC[(c * 65 + pp) * 2] = p.in[24][(size_t)lg_ * 1024 + e];
    sC[(c * 65 + pp) * 2 + 1] = p.in[25][(size_t)lg_ * 1024 + e];
  }
  float hr = 0.f, hi = 0.f;
  if (s >= 8) {
    hr = p.in[4][((size_t)(l * 128 + (s - 8)) * 16 + g) * 64 + lane];
    hi = p.in[5][((size_t)(l * 128 + (s - 8)) * 16 + g) * 64 + lane];
  }
  const int ytt = lane >> 3, cp = (lane & 7) * 2;
  const float d0 = p.in[26][l * 256 + g * 16 + cp], d1 = p.in[26][l * 256 + g * 16 + cp + 1];
  const u16* ubase = Zm + (size_t)rowbase * ZW + 1024 + g * 16 + (size_t)(lane >> 1) * ZW + (lane & 1) * 8;
  uint4 pu = make_uint4(0u, 0u, 0u, 0u);
  if (lane < 16) pu = *(const uint4*)(ubase);
  if (lane < 16) {
    float* d = sU + (lane >> 1) * 16 + (lane & 1) * 8;
    *(float4*)(d) = make_float4(bflo(pu.x), bfhi(pu.x), bflo(pu.y), bfhi(pu.y));
    *(float4*)(d + 4) = make_float4(bflo(pu.z), bfhi(pu.z), bflo(pu.w), bfhi(pu.w));
  }
  for (int t0 = 0; t0 < T; t0 += 8) {
    __syncthreads();
    if (lane < 16 && t0 + 8 < T) pu = *(const uint4*)(ubase + (size_t)(t0 + 8) * ZW);
#pragma unroll 2
    for (int tt = 0; tt < 8; ++tt) {
      const float4 u0 = *(const float4*)(sU + tt * 16), u1 = *(const float4*)(sU + tt * 16 + 4), u2 = *(const float4*)(sU + tt * 16 + 8),
                   u3 = *(const float4*)(sU + tt * 16 + 12);
      const float u[16] = {u0.x, u0.y, u0.z, u0.w, u1.x, u1.y, u1.z, u1.w, u2.x, u2.y, u2.z, u2.w, u3.x, u3.y, u3.z, u3.w};
      float xr = 0.f, xi = 0.f;
#pragma unroll
      for (int c = 0; c < 16; ++c) { xr += xr_c[c] * u[c]; xi += xi_c[c] * u[c]; }
      const float nr = lbr * hr - lbi * hi + xr;
      const float ni = lbr * hi + lbi * hr + xi;
      hr = nr; hi = ni;
      *(float2*)&sH[(tt * 65 + lane) * 2] = make_float2(hr, hi);
    }
    __syncthreads();
    float y0 = 0.f, y1 = 0.f;
#pragma unroll 8
    for (int pp = 0; pp < 64; ++pp) {
      const float2 hv = *(const float2*)&sH[(ytt * 65 + pp) * 2];
      const float2 c0 = *(const float2*)&sC[(cp * 65 + pp) * 2];
      const float2 c1 = *(const float2*)&sC[((cp + 1) * 65 + pp) * 2];
      y0 += hv.x * c0.x - hv.y * c0.y;
      y1 += hv.x * c1.x - hv.y * c1.y;
    }
    const size_t row = (size_t)(rowbase + t0 + ytt);
    const float2 uy = *(const float2*)(sU + ytt * 16 + cp);
    y0 = geluf_(y0 + d0 * uy.x);
    y1 = geluf_(y1 + d1 * uy.y);
    *(unsigned*)(Y5 + row * 256 + g * 16 + cp) = pack2(y0, y1);
    if (lane < 16 && t0 + 8 < T) {
      float* d = sU + (lane >> 1) * 16 + (lane & 1) * 8;
      *(float4*)(d) = make_float4(bflo(pu.x), bfhi(pu.x), bflo(pu.y), bfhi(pu.y));
      *(float4*)(d + 4) = make_float4(bflo(pu.z), bfhi(pu.z), bflo(pu.w), bfhi(pu.w));
    }
  }
  st_out(p, O_PS5RE, O_SS5RE, l, s, 1024)[g * 64 + lane] = hr;
  st_out(p, O_PS5IM, O_SS5IM, l, s, 1024)[g * 64 + lane] = hi;
}


DEV void s5_prompt(const P& p, int l, int s, int g, float* smem) {
  const int tid = tid_(), lane = tid & 63;
  const int w = __builtin_amdgcn_readfirstlane(tid >> 6);
  float* sC = smem;
  float* sE = smem + 2080;
  float* sH = smem + 2080 + 512 + w * 1168;
  float* sU = sH + 1040;
  const int rowbase = rowbase_of(s);
  const int tbeg = w * 512, tend = (w == 3) ? TP : tbeg + 512;
  const u16* Zm = (const u16*)(p.ws + OFF_D + D_ZM);
  u16* Y5 = (u16*)(p.ws + OFF_D + D_Y5);
  const int lg_ = l * 16 + g;
  const float lr = p.in[19][lg_ * 64 + lane], li = p.in[20][lg_ * 64 + lane];
  const float dt = expf(p.in[21][lg_]);
  const float mag = expf(lr * dt);
  const float lbr = mag * cosf(li * dt), lbi = mag * sinf(li * dt);
  const float den = lr * lr + li * li;
  const float cfr = ((lbr - 1.f) * lr + lbi * li) / den, cfi = (lbi * lr - (lbr - 1.f) * li) / den;
  float xr_c[16], xi_c[16];
  {
    const float4* br4 = (const float4*)(p.in[22] + ((size_t)lg_ * 64 + lane) * 16);
    const float4* bi4 = (const float4*)(p.in[23] + ((size_t)lg_ * 64 + lane) * 16);
#pragma unroll
    for (int q = 0; q < 4; ++q) {
      float4 a = br4[q], b = bi4[q];
      xr_c[q * 4] = cfr * a.x - cfi * b.x; xi_c[q * 4] = cfr * b.x + cfi * a.x;
      xr_c[q * 4 + 1] = cfr * a.y - cfi * b.y; xi_c[q * 4 + 1] = cfr * b.y + cfi * a.y;
      xr_c[q * 4 + 2] = cfr * a.z - cfi * b.z; xi_c[q * 4 + 2] = cfr * b.z + cfi * a.z;
      xr_c[q * 4 + 3] = cfr * a.w - cfi * b.w; xi_c[q * 4 + 3] = cfr * b.w + cfi * a.w;
    }
  }
  for (int e = tid; e < 1024; e += 256) {
    const int c = e >> 6, pp = e & 63;
    sC[(c * 65 + pp) * 2] = p.in[24][(size_t)lg_ * 1024 + e];
    sC[(c * 65 + pp) * 2 + 1] = p.in[25][(size_t)lg_ * 1024 + e];
  }
  const u16* ubase = Zm + (size_t)rowbase * ZW + 1024 + g * 16 + (size_t)(lane >> 1) * ZW + (lane & 1) * 8;
  float hr = 0.f, hi = 0.f;
  if (w < 3) {
    uint4 pu = make_uint4(0u, 0u, 0u, 0u);
    if (lane < 16) pu = *(const uint4*)(ubase + (size_t)tbeg * ZW);
    for (int t0 = tbeg; t0 < tend; t0 += 8) {
      if (lane < 16) {
        float* d = sU + (lane >> 1) * 16 + (lane & 1) * 8;
        *(float4*)(d) = make_float4(bflo(pu.x), bfhi(pu.x), bflo(pu.y), bfhi(pu.y));
        *(float4*)(d + 4) = make_float4(bflo(pu.z), bfhi(pu.z), bflo(pu.w), bfhi(pu.w));
      }
      if (lane < 16 && t0 + 8 < tend) pu = *(const uint4*)(ubase + (size_t)(t0 + 8) * ZW);
      __builtin_amdgcn_wave_barrier();
#pragma unroll 2
      for (int tt = 0; tt < 8; ++tt) {
        const float4 u0 = *(const float4*)(sU + tt * 16), u1 = *(const float4*)(sU + tt * 16 + 4), u2 = *(const float4*)(sU + tt * 16 + 8),
                     u3 = *(const float4*)(sU + tt * 16 + 12);
        const float u[16] = {u0.x, u0.y, u0.z, u0.w, u1.x, u1.y, u1.z, u1.w, u2.x, u2.y, u2.z, u2.w, u3.x, u3.y, u3.z, u3.w};
        float xr = 0.f, xi = 0.f;
#pragma unroll
        for (int c = 0; c < 16; ++c) { xr += xr_c[c] * u[c]; xi += xi_c[c] * u[c]; }
        const float nr = lbr * hr - lbi * hi + xr;
        const float ni = lbr * hi + lbi * hr + xi;
        hr = nr; hi = ni;
      }
      __builtin_amdgcn_wave_barrier();
    }
    *(float2*)&sE[(w * 64 + lane) * 2] = make_float2(hr, hi);
  }
  __syncthreads();
  {
    const float m512 = expf(lr * dt * 512.f);
    const float pr = m512 * cosf(li * dt * 512.f), pi = m512 * sinf(li * dt * 512.f);
    float Hr = 0.f, Hi = 0.f;
    for (int k = 0; k < w; ++k) {
      const float2 e = *(const float2*)&sE[(k * 64 + lane) * 2];
      const float nr = pr * Hr - pi * Hi + e.x, ni = pr * Hi + pi * Hr + e.y;
      Hr = nr; Hi = ni;
    }
    hr = Hr; hi = Hi;
  }
  const int ytt = lane >> 3, cp = (lane & 7) * 2;
  const float d0 = p.in[26][l * 256 + g * 16 + cp], d1 = p.in[26][l * 256 + g * 16 + cp + 1];
  {
    uint4 pu = make_uint4(0u, 0u, 0u, 0u);
    if (lane < 16) pu = *(const uint4*)(ubase + (size_t)tbeg * ZW);
    for (int t0 = tbeg; t0 < tend; t0 += 8) {
      if (lane < 16) {
        float* d = sU + (lane >> 1) * 16 + (lane & 1) * 8;
        *(float4*)(d) = make_float4(bflo(pu.x), bfhi(pu.x), bflo(pu.y), bfhi(pu.y));
        *(float4*)(d + 4) = make_float4(bflo(pu.z), bfhi(pu.z), bflo(pu.w), bfhi(pu.w));
      }
      if (lane < 16 && t0 + 8 < tend) pu = *(const uint4*)(ubase + (size_t)(t0 + 8) * ZW);
      __builtin_amdgcn_wave_barrier();
#pragma unroll 2
      for (int tt = 0; tt < 8; ++tt) {
        const float4 u0 = *(const float4*)(sU + tt * 16), u1 = *(const float4*)(sU + tt * 16 + 4), u2 = *(const float4*)(sU + tt * 16 + 8),
                     u3 = *(const float4*)(sU + tt * 16 + 12);
        const float u[16] = {u0.x, u0.y, u0.z, u0.w, u1.x, u1.y, u1.z, u1.w, u2.x, u2.y, u2.z, u2.w, u3.x, u3.y, u3.z, u3.w};
        float xr = 0.f, xi = 0.f;
#pragma unroll
        for (int c = 0; c < 16; ++c) { xr += xr_c[c] * u[c]; xi += xi_c[c] * u[c]; }
        const float nr = lbr * hr - lbi * hi + xr;
        const float ni = lbr * hi + lbi * hr + xi;
        hr = nr; hi = ni;
        *(float2*)&sH[(tt * 65 + lane) * 2] = make_float2(hr, hi);
      }
      __builtin_amdgcn_wave_barrier();
      float y0 = 0.f, y1 = 0.f;
#pragma unroll 8
      for (int pp = 0; pp < 64; ++pp) {
        const float2 hv = *(const float2*)&sH[(ytt * 65 + pp) * 2];
        const float2 c0 = *(const float2*)&sC[(cp * 65 + pp) * 2];
        const float2 c1 = *(const float2*)&sC[((cp + 1) * 65 + pp) * 2];
        y0 += hv.x * c0.x - hv.y * c0.y;
        y1 += hv.x * c1.x - hv.y * c1.y;
      }
      const size_t row = (size_t)(rowbase + t0 + ytt);
      const float2 uy = *(const float2*)(sU + ytt * 16 + cp);
      y0 = geluf_(y0 + d0 * uy.x);
      y1 = geluf_(y1 + d1 * uy.y);
      *(unsigned*)(Y5 + row * 256 + g * 16 + cp) = pack2(y0, y1);
      __builtin_amdgcn_wave_barrier();
    }
  }
  if (w == 3) {
    st_out(p, O_PS5RE, O_SS5RE, l, s, 1024)[g * 64 + lane] = hr;
    st_out(p, O_PS5IM, O_SS5IM, l, s, 1024)[g * 64 + lane] = hi;
  }
}

DEV float lru_xin(const P& p, const u16* Zm, int l, int s, int rowbase, int tau, int c) {
  if (tau >= 0) return bf2f(Zm[(size_t)(rowbase + tau) * ZW + 1280 + c]);
  if (s >= 8) return p.in[7][((size_t)(l * 128 + (s - 8)) * 3 + (3 + tau)) * 256 + c];
  return 0.f;
}
DEV void lru_pass1(const P& p, int l, int s, int t0, float* smem) {
  float* sX = smem;
  const int c = tid_();
  const int T = (s < 8) ? TP : 8;
  const int nT = min(32, T - t0);
  const int rowbase = rowbase_of(s);
  const u16* Zm = (const u16*)(p.ws + OFF_D + D_ZM);
  u16* LA = (u16*)(p.ws + OFF_D + D_LA);
  u16* LB = (u16*)(p.ws + OFF_D + D_LB);
  const float w0 = p.in[29][(l * 4 + 0) * 256 + c], w1 = p.in[29][(l * 4 + 1) * 256 + c], w2 = p.in[29][(l * 4 + 2) * 256 + c],
              w3 = p.in[29][(l * 4 + 3) * 256 + c];
  const float cb = p.in[30][l * 256 + c];
  float xm3 = lru_xin(p, Zm, l, s, rowbase, t0 - 3, c), xm2 = lru_xin(p, Zm, l, s, rowbase, t0 - 2, c),
        xm1 = lru_xin(p, Zm, l, s, rowbase, t0 - 1, c);
  u16 xin[32];
#pragma unroll
  for (int tt = 0; tt < 32; ++tt) xin[tt] = (tt < nT) ? Zm[(size_t)(rowbase + t0 + tt) * ZW + 1280 + c] : (u16)0;
#pragma unroll
  for (int tt = 0; tt < 32; ++tt) {
    const float x0 = bf2f(xin[tt]);
    sX[tt * 256 + c] = (tt < nT) ? (w0 * xm3 + w1 * xm2 + w2 * xm1 + w3 * x0 + cb) : 0.f;
    xm3 = xm2; xm2 = xm1; xm1 = x0;
  }
  __syncthreads();
  const int blk = __builtin_amdgcn_readfirstlane(c >> 6), d = c & 63;
  const float* wa = p.in[31] + (size_t)(l * 4 + blk) * 4096;
  const float* wx = p.in[33] + (size_t)(l * 4 + blk) * 4096;
  const float ba = p.in[32][l * 256 + c], bx = p.in[34][l * 256 + c];
  const float sp = softplusf_(-p.in[35][l * 256 + c]);
  for (int b8 = 0; b8 * 8 < nT; ++b8) {
    float ra[8], ia[8];
#pragma unroll
    for (int tt = 0; tt < 8; ++tt) { ra[tt] = 0.f; ia[tt] = 0.f; }
#pragma unroll 4
    for (int k = 0; k < 64; ++k) {
      const float wav = wa[k * 64 + d], wxv = wx[k * 64 + d];
#pragma unroll
      for (int tt = 0; tt < 8; ++tt) {
        const float xv = sX[(b8 * 8 + tt) * 256 + blk * 64 + k];
        ra[tt] += xv * wav; ia[tt] += xv * wxv;
      }
    }
#pragma unroll
    for (int tt = 0; tt < 8; ++tt) {
      const int t = b8 * 8 + tt;
      if (t < nT) {
        const float r = sigm(ra[tt] + ba), ig = sigm(ia[tt] + bx);
        const float la = -8.f * r * sp;
        const float bb = sqrtf(-expm1f(2.f * la)) * (ig * sX[t * 256 + c]);
        const size_t row = (size_t)(rowbase + t0 + t);
        LA[row * 256 + c] = f2bf(la);
        LB[row * 256 + c] = f2bf(bb);
      }
    }
  }
  if (t0 + nT == T) {
    float* o = st_out(p, O_PLRUC, O_SLRUC, l, s, 3 * 256);
#pragma unroll
    for (int r = 0; r < 3; ++r) o[r * 256 + c] = lru_xin(p, Zm, l, s, rowbase, T - 3 + r, c);
  }
}
DEV void lru_pass2(const P& p, int l, int s) {
  const int c = tid_();
  const int T = (s < 8) ? TP : 8;
  const int rowbase = rowbase_of(s);
  const u16* Zm = (const u16*)(p.ws + OFF_D + D_ZM);
  const u16* LA = (const u16*)(p.ws + OFF_D + D_LA);
  const u16* LB = (const u16*)(p.ws + OFF_D + D_LB);
  u16* BR = (u16*)(p.ws + OFF_D + D_BR);
  float h = (s >= 8) ? p.in[6][(size_t)(l * 128 + (s - 8)) * 256 + c] : 0.f;
  u16 na[8], nb[8], ng[8];
#pragma unroll
  for (int tt = 0; tt < 8; ++tt) {
    const size_t row = (size_t)(rowbase + tt);
    na[tt] = LA[row * 256 + c]; nb[tt] = LB[row * 256 + c]; ng[tt] = Zm[row * ZW + 1536 + c];
  }
  for (int t0 = 0; t0 < T; t0 += 8) {
    float la[8], lb[8], lg[8];
#pragma unroll
    for (int tt = 0; tt < 8; ++tt) { la[tt] = bf2f(na[tt]); lb[tt] = bf2f(nb[tt]); lg[tt] = bf2f(ng[tt]); }
    if (t0 + 8 < T) {
#pragma unroll
      for (int tt = 0; tt < 8; ++tt) {
        const size_t row = (size_t)(rowbase + t0 + 8 + tt);
        na[tt] = LA[row * 256 + c]; nb[tt] = LB[row * 256 + c]; ng[tt] = Zm[row * ZW + 1536 + c];
      }
    }
#pragma unroll
    for (int tt = 0; tt < 8; ++tt) {
      h = __expf(la[tt]) * h + lb[tt];
      BR[(size_t)(rowbase + t0 + tt) * 1024 + 512 + c] = f2bf(h * geluf_(lg[tt]));
    }
  }
  st_out(p, O_PLRU, O_SLRU, l, s, 256)[c] = h;
}


DEV void lru_prompt(const P& p, int l, int s, int cg, float* smem) {
  const int tid = tid_(), lane = tid & 63;
  const int w = __builtin_amdgcn_readfirstlane(tid >> 6);
  const int c = cg * 64 + lane;
  float* sE = smem;
  float* sL = smem + 256;
  const int rowbase = rowbase_of(s);
  const int tbeg = w * 512, tend = (w == 3) ? TP : tbeg + 512;
  const u16* Zm = (const u16*)(p.ws + OFF_D + D_ZM);
  const u16* LA = (const u16*)(p.ws + OFF_D + D_LA);
  const u16* LB = (const u16*)(p.ws + OFF_D + D_LB);
  u16* BR = (u16*)(p.ws + OFF_D + D_BR);
  {
    float h = 0.f, sl = 0.f;
    for (int t0 = tbeg; t0 < tend; t0 += 8) {
      u16 na[8], nb[8];
#pragma unroll
      for (int tt = 0; tt < 8; ++tt) { const size_t row = (size_t)(rowbase + t0 + tt); na[tt] = LA[row * 256 + c]; nb[tt] = LB[row * 256 + c]; }
#pragma unroll
      for (int tt = 0; tt < 8; ++tt) { const float la = bf2f(na[tt]); h = __expf(la) * h + bf2f(nb[tt]); sl += la; }
    }
    sE[w * 64 + lane] = h; sL[w * 64 + lane] = sl;
  }
  __syncthreads();
  float h = 0.f;
  for (int k = 0; k < w; ++k) h = __expf(sL[k * 64 + lane]) * h + sE[k * 64 + lane];
  u16 na[8], nb[8], ng[8];
#pragma unroll
  for (int tt = 0; tt < 8; ++tt) {
    const size_t row = (size_t)(rowbase + tbeg + tt);
    na[tt] = LA[row * 256 + c]; nb[tt] = LB[row * 256 + c]; ng[tt] = Zm[row * ZW + 1536 + c];
  }
  for (int t0 = tbeg; t0 < tend; t0 += 8) {
    float la[8], lb[8], lg[8];
#pragma unroll
    for (int tt = 0; tt < 8; ++tt) { la[tt] = bf2f(na[tt]); lb[tt] = bf2f(nb[tt]); lg[tt] = bf2f(ng[tt]); }
    if (t0 + 8 < tend) {
#pragma unroll
      for (int tt = 0; tt < 8; ++tt) {
        const size_t row = (size_t)(rowbase + t0 + 8 + tt);
        na[tt] = LA[row * 256 + c]; nb[tt] = LB[row * 256 + c]; ng[tt] = Zm[row * ZW + 1536 + c];
      }
    }
#pragma unroll
    for (int tt = 0; tt < 8; ++tt) {
      h = __expf(la[tt]) * h + lb[tt];
      BR[(size_t)(rowbase + t0 + tt) * 1024 + 512 + c] = f2bf(h * geluf_(lg[tt]));
    }
  }
  if (w == 3) st_out(p, O_PLRU, O_SLRU, l, s, 256)[c] = h;
}

DEV void conv_item(const P& p, int l, int s, int t0, float* smem) {
  float* sG = smem;
  const int c = tid_(), lane = c & 63, w = c >> 6;
  const int T = (s < 8) ? TP : 8;
  const int nT = min(32, T - t0);
  const int rowbase = rowbase_of(s);
  const u16* Zm = (const u16*)(p.ws + OFF_D + D_ZM);
  u16* BR = (u16*)(p.ws + OFF_D + D_BR);
#pragma unroll 8
  for (int rr = 0; rr < 30 + nT; ++rr) {
    const int tau = t0 - 30 + rr;
    float gl = 0.f;
    if (tau >= 0) {
      const size_t row = (size_t)(rowbase + tau);
      gl = bf2f(Zm[row * ZW + 1792 + c]) * sigm(bf2f(Zm[row * ZW + 2048 + c]));
    } else if (s >= 8) gl = p.in[8][((size_t)(l * 128 + (s - 8)) * 30 + (30 + tau)) * 256 + c];
    sG[rr * 256 + c] = gl;
  }
  if (t0 + nT == T) {
    float* o = st_out(p, O_PCONV, O_SCONV, l, s, 30 * 256);
    for (int r = 0; r < 30; ++r) o[r * 256 + c] = sG[(nT + r) * 256 + c];
  }
  float wv[31];
#pragma unroll
  for (int j = 0; j < 31; ++j) wv[j] = p.in[36][(size_t)(l * 31 + j) * 256 + c];
  const float cb = p.in[37][l * 256 + c];
  for (int tt = 0; tt < nT; ++tt) {
    float y = cb;
#pragma unroll
    for (int j = 0; j < 31; ++j) y += wv[j] * sG[(tt + j) * 256 + c];
    sG[tt * 256 + c] = y;
  }
  __syncthreads();
  const float4 lg4 = *(const float4*)(p.in[38] + l * 256 + lane * 4);
  const float4 lb4 = *(const float4*)(p.in[39] + l * 256 + lane * 4);
  for (int tt = w; tt < nT; tt += 4) {
    const float4 v = *(const float4*)&sG[tt * 256 + lane * 4];
    float s1 = v.x + v.y + v.z + v.w;
    s1 = wave_sum(s1);
    const float mean = s1 * (1.f / 256.f);
    const float a0 = v.x - mean, a1 = v.y - mean, a2 = v.z - mean, a3 = v.w - mean;
    float s2 = a0 * a0 + a1 * a1 + a2 * a2 + a3 * a3;
    s2 = wave_sum(s2);
    const float rstd = rsqrtf(s2 * (1.f / 256.f) + 1e-6f);
    uint2 ov;
    ov.x = pack2(siluf_(a0 * rstd * lg4.x + lb4.x), siluf_(a1 * rstd * lg4.y + lb4.y));
    ov.y = pack2(siluf_(a2 * rstd * lg4.z + lb4.z), siluf_(a3 * rstd * lg4.w + lb4.w));
    *(uint2*)(BR + (size_t)(rowbase + t0 + tt) * 1024 + 768 + lane * 4) = ov;
  }
}


DEV bool tile_of(int t, int G, int N, int NT, int& mt, int& nt) {
  const int r = t / G, b = t - r * G;
  const int q = r * G + (b & 7) * (G >> 3) + (b >> 3);
  if (q >= N) return false;
  const int P = NT >> 3, wl = NT & 7, full = P * MT * 8;
  if (q < full) { const int panel = q / (MT * 8), rem = q - panel * MT * 8; mt = rem >> 3; nt = panel * 8 + (rem & 7); }
  else { const int q2 = q - full; mt = q2 / wl; nt = P * 8 + (q2 - mt * wl); }
  return true;
}
#define TILE_LOOP(NT_, CALL) do { const int N_ = MT * (NT_); const int Nr_ = ((N_ + G - 1) / G) * G; \
    for (int t = B; t < Nr_; t += G) { int mt, nt; if (tile_of(t, G, N_, (NT_), mt, nt)) { CALL; } } } while (0)
__global__ void __launch_bounds__(256, 2) mega(P p) {
  __shared__ __attribute__((aligned(16))) float smem[16128];
  __shared__ int s_item;
  cg::grid_group grid = cg::this_grid();
  u16* sA = (u16*)smem;
  u16* sB = sA + 128 * 72;
  const u16* W = (const u16*)(p.ws + OFF_W);
  const u16* XN = (const u16*)(p.ws + OFF_XN);
  float* X = (float*)(p.ws + OFF_X);
  u16* H = (u16*)(p.ws + OFF_D + D_H);
  u16* Zm = (u16*)(p.ws + OFF_D + D_ZM);
  const u16* M = (const u16*)(p.ws + OFF_D + D_M);
  int* ctr = (int*)p.ws;
  const int G = gridDim.x, B = blockIdx.x;

  for (int l = 0; l < 2; ++l) {
    phase_norm(p, l, 0);
    phase_convw(p, l, smem);
    grid.sync();
    TILE_LOOP(22, dual_tile256(XN, W + W_GU1, mt, nt, H, sA, sB));
    grid.sync();
    TILE_LOOP(8, resid_tile(H, 2816, 2816, W + W_DN1, mt, nt, X, 0.5f, sA, sB));
    grid.sync();
    phase_norm(p, l, 1);
    grid.sync();
    TILE_LOOP(9, zm_tile256(XN, W + W_INM, mt, nt, Zm, sA, sB));
    grid.sync();
    for (;;) {
      __syncthreads();
      if (threadIdx.x == 0) s_item = atomicAdd(&ctr[l * 2], 1);
      __syncthreads();
      const int it = s_item;
      if (it >= 3504) break;
      int ll = l;
      asm volatile("" : "+s"(ll));
      if (it < 128) s5_prompt(p, ll, it >> 4, it & 15, smem);
      else if (it < 1696) delta_pre(p, ll, it - 128, smem);
      else if (it < 2216) { int i = it - 1696; conv_item(p, ll, i / 65, (i % 65) * 32, smem); }
      else if (it < 2344) conv_item(p, ll, 8 + (it - 2216), 0, smem);
      else if (it < 2864) { int i = it - 2344; lru_pass1(p, ll, i / 65, (i % 65) * 32, smem); }
      else if (it < 2992) lru_pass1(p, ll, 8 + (it - 2864), 0, smem);
      else { int i = it - 2992; s5_block(p, ll, 8 + (i >> 2), i & 3, smem); }
    }
    grid.sync();
    for (;;) {
      __syncthreads();
      if (threadIdx.x == 0) s_item = atomicAdd(&ctr[l * 2 + 1], 1);
      __syncthreads();
      const int it = s_item;
      if (it >= 1252) break;
      int ll = l;
      asm volatile("" : "+s"(ll));
      if (it < 32) delta_seq(p, ll, it >> 2, it & 3, smem);
      else if (it < 64) { int i = it - 32; lru_prompt(p, ll, i >> 2, i & 3, smem); }
      else if (it < 612) { int i = it - 64; dual_tile<1>((const u16*)(p.ws + OFF_D + D_Y5), 256, 256, W + W_GLU, i % MT, i / MT, (u16*)(p.ws + OFF_D + D_BR), 1024, 256, p.in[28] + ll * 512, sA, sB); }
      else if (it < 1124) { int i = it - 612; delta_seq(p, ll, 8 + (i >> 2), i & 3, smem); }
      else lru_pass2(p, ll, 8 + (it - 1124));
    }
    grid.sync();
    TILE_LOOP(16, g4_tile(p, mt, nt, sA, sB));
    grid.sync();
    TILE_LOOP(8, resid_tile(M, 1024, 1024, W + W_OUT, mt, nt, X, 1.0f, sA, sB));
    grid.sync();
    phase_norm(p, l, 2);
    grid.sync();
    TILE_LOOP(22, dual_tile256(XN, W + W_GU2, mt, nt, H, sA, sB));
    grid.sync();
    TILE_LOOP(8, resid_tile(H, 2816, 2816, W + W_DN2, mt, nt, X, 0.5f, sA, sB));
    grid.sync();
  }
  phase_norm(p, 0, 3);
}

extern "C" void kernel_launch(void* const* d_in, const int* in_sizes, int n_in, void* d_out, int out_size, void* d_ws,
                              size_t ws_size, hipStream_t stream) {
  P p{};
  for (int i = 0; i < 46; ++i) p.in[i] = (const float*)d_in[i];
  p.out = (float*)d_out;
  p.ws = (char*)d_ws;
  static int grid_blocks = 0;
  if (!grid_blocks) {
    int dev = 0, cus = 0, per = 0;
    hipGetDevice(&dev);
    hipDeviceGetAttribute(&cus, hipDeviceAttributeMultiprocessorCount, dev);
    hipOccupancyMaxActiveBlocksPerMultiprocessor(&per, mega, 256, 0);
    if (per > 2) per = 2;
    if (per < 1) per = 1;
    grid_blocks = cus * per;
  }
  if (ws_size < WS_NEED) fprintf(stderr, "workspace too small: %zu < %zu\n", ws_size, (size_t)WS_NEED);
  hipMemsetAsync(d_ws, 0, 256, stream);
  void* args[] = {&p};
  hipError_t e = hipLaunchCooperativeKernel((void*)mega, dim3(grid_blocks), dim3(256), args, 0, stream);
  if (e != hipSuccess) fprintf(stderr, "cooperative launch failed: %s (grid %d)\n", hipGetErrorString(e), grid_blocks);
}
```

```cpp
#include <hip/hip_runtime.h>
#include <hip/hip_bf16.h>
#include <hip/hip_cooperative_groups.h>
#include <cstdio>
namespace cg = cooperative_groups;

typedef unsigned short u16;
using bf16x8 = __attribute__((ext_vector_type(8))) short;
using f32x4 = __attribute__((ext_vector_type(4))) float;
using u32x4 = __attribute__((ext_vector_type(4))) unsigned int;
#define DEV __device__ __forceinline__

struct P { const float* in[46]; float* out; char* ws; };

constexpr int NTOK = 17536, TP = 2064, NPR = 16512, ZW = 2304, MT = 137;
constexpr size_t OFF_X = 65536;
constexpr size_t OFF_W = OFF_X + (size_t)NTOK * 1024 * 4;
constexpr size_t W_GU1 = 0, W_DN1 = 5767168, W_INM = 8650752, W_ING = 11010048, W_BR = 15204352, W_OUT = 16252928,
                 W_GLU = 17301504, W_GU2 = 17432576, W_DN2 = 23199744, W_END = 26083328;
constexpr size_t OFF_XN = OFF_W + W_END * 2;
constexpr size_t OFF_BA = OFF_XN + (size_t)NTOK * 1024 * 2;
constexpr size_t OFF_D = OFF_BA + (size_t)NTOK * 8 * 4;
constexpr size_t D_H = 0, D_ZM = 0, D_M = 0, D_BR = 80805888, D_LA = 116719616, D_LB = 125698048, D_Y5 = 134676480;
constexpr size_t WS_NEED = OFF_D + 143654912;
constexpr size_t OFF_GAMMA = 1024;
constexpr size_t O_YS = 16777216, O_PDELTA = 17825792, O_PDCONV = 18087936, O_PS5RE = 18124800, O_PS5IM = 18141184,
                 O_PLRU = 18157568, O_PLRUC = 18161664, O_PCONV = 18173952, O_SDELTA = 18296832, O_SDCONV = 22491136,
                 O_SS5RE = 23080960, O_SS5IM = 23343104, O_SLRU = 23605248, O_SLRUC = 23670784, O_SCONV = 23867392;

DEV u16 f2bf(float f) { unsigned u = __float_as_uint(f); u += 0x7fffu + ((u >> 16) & 1u); return (u16)(u >> 16); }
DEV float bf2f(u16 h) { return __uint_as_float(((unsigned)h) << 16); }
DEV float bflo(unsigned u) { return __uint_as_float(u << 16); }
DEV float bfhi(unsigned u) { return __uint_as_float(u & 0xffff0000u); }
DEV unsigned pack2(float a, float b) { return (unsigned)f2bf(a) | ((unsigned)f2bf(b) << 16); }
DEV float sigm(float x) { return 1.f / (1.f + __expf(-x)); }
DEV float siluf_(float x) { return x / (1.f + __expf(-x)); }
DEV float softplusf_(float x) { return fmaxf(x, 0.f) + log1pf(__expf(-fabsf(x))); }
DEV float geluf_(float x) { float u = 0.7978845608028654f * (x + 0.044715f * x * x * x); return 0.5f * x * (1.f + tanhf(u)); }
DEV float wave_sum(float v) {
#pragma unroll
  for (int o = 32; o > 0; o >>= 1) v += __shfl_xor(v, o, 64);
  return v;
}
DEV void unpack16(uint4 a, uint4 b, float (&x)[16]) {
  x[0] = bflo(a.x); x[1] = bfhi(a.x); x[2] = bflo(a.y); x[3] = bfhi(a.y); x[4] = bflo(a.z); x[5] = bfhi(a.z); x[6] = bflo(a.w); x[7] = bfhi(a.w);
  x[8] = bflo(b.x); x[9] = bfhi(b.x); x[10] = bflo(b.y); x[11] = bfhi(b.y); x[12] = bflo(b.z); x[13] = bfhi(b.z); x[14] = bflo(b.w); x[15] = bfhi(b.w);
}
DEV float* st_out(const P& p, size_t offP, size_t offS, int l, int s, int sz) {
  return s < 8 ? p.out + offP + (size_t)(l * 8 + s) * sz : p.out + offS + (size_t)(l * 128 + (s - 8)) * sz;
}
DEV int tid_() { int t = threadIdx.x; asm volatile("" : "+v"(t)); return t; }
DEV int rowbase_of(int s) { return s < 8 ? s * TP : NPR + (s - 8) * 8; }

DEV void phase_norm(const P& p, int l, int kind) {
  const int tid0 = tid_(); const int lane = tid0 & 63, w = tid0 >> 6;
  float* X = (float*)(p.ws + OFF_X);
  u16* XN = (u16*)(p.ws + OFF_XN);
  float* BA = (float*)(p.ws + OFF_BA);
  const float* gain = kind == 0 ? p.in[10] + l * 1024 : kind == 1 ? p.in[13] + l * 1024 : kind == 2 ? p.in[42] + l * 1024 : p.in[45];
  float4 g4[4];
#pragma unroll
  for (int i = 0; i < 4; ++i) g4[i] = *(const float4*)(gain + i * 256 + lane * 4);
  const bool first = (kind == 0 && l == 0);
  for (int r = blockIdx.x * 4 + w; r < NTOK; r += gridDim.x * 4) {
    const float* src;
    int b = 0, t = 0;
    if (r < NPR) { b = r / TP; t = r - b * TP; }
    if (first) {
      if (r < NPR) src = t < 16 ? p.in[9] + t * 1024 : p.in[0] + ((size_t)b * 2048 + (t - 16)) * 1024;
      else src = p.in[1] + (size_t)(r - NPR) * 1024;
    } else src = X + (size_t)r * 1024;
    float4 v[4];
    float ss = 0.f;
#pragma unroll
    for (int i = 0; i < 4; ++i) {
      v[i] = *(const float4*)(src + i * 256 + lane * 4);
      ss += v[i].x * v[i].x + v[i].y * v[i].y + v[i].z * v[i].z + v[i].w * v[i].w;
    }
    ss = wave_sum(ss);
    const float inv = rsqrtf(ss * (1.f / 1024.f) + 1e-6f);
    if (first) {
#pragma unroll
      for (int i = 0; i < 4; ++i) *(float4*)(X + (size_t)r * 1024 + i * 256 + lane * 4) = v[i];
    }
#pragma unroll
    for (int i = 0; i < 4; ++i) {
      v[i].x *= inv * g4[i].x; v[i].y *= inv * g4[i].y; v[i].z *= inv * g4[i].z; v[i].w *= inv * g4[i].w;
    }
    if (kind == 3) {
      float* dst;
      if (r < NPR) { if (t < 16) continue; dst = p.out + ((size_t)b * 2048 + (t - 16)) * 1024; }
      else dst = p.out + O_YS + (size_t)(r - NPR) * 1024;
#pragma unroll
      for (int i = 0; i < 4; ++i) *(float4*)(dst + i * 256 + lane * 4) = v[i];
    } else {
#pragma unroll
      for (int i = 0; i < 4; ++i) {
        uint2 o; o.x = pack2(v[i].x, v[i].y); o.y = pack2(v[i].z, v[i].w);
        *(uint2*)(XN + (size_t)r * 1024 + i * 256 + lane * 4) = o;
      }
      if (kind == 1) {
        const float* wi = p.in[14] + (size_t)l * 1024 * 6408 + 1024;
        float acc[8];
#pragma unroll
        for (int j = 0; j < 8; ++j) acc[j] = 0.f;
#pragma unroll
        for (int i = 0; i < 4; ++i) {
          const float yv[4] = {v[i].x, v[i].y, v[i].z, v[i].w};
#pragma unroll
          for (int e = 0; e < 4; ++e) {
            const float4* wr = (const float4*)(wi + (size_t)(i * 256 + lane * 4 + e) * 6408);
            float4 a = wr[0], c = wr[1];
            acc[0] += yv[e] * a.x; acc[1] += yv[e] * a.y; acc[2] += yv[e] * a.z; acc[3] += yv[e] * a.w;
            acc[4] += yv[e] * c.x; acc[5] += yv[e] * c.y; acc[6] += yv[e] * c.z; acc[7] += yv[e] * c.w;
          }
        }
#pragma unroll
        for (int j = 0; j < 8; ++j) acc[j] = wave_sum(acc[j]);
        if (lane == 0) {
          *(float4*)(BA + (size_t)r * 8) = make_float4(acc[0], acc[1], acc[2], acc[3]);
          *(float4*)(BA + (size_t)r * 8 + 4) = make_float4(acc[4], acc[5], acc[6], acc[7]);
        }
      }
    }
  }
}

DEV int wmap(int mode, int R, int c0, int half) {
  if (mode == 0) return c0 + R;
  if (mode == 1) { int tile = R >> 7, r = R & 127; int type = (r >> 4) & 1; return type * half + tile * 64 + (r >> 5) * 16 + (r & 15); }
  return R < 1024 ? R : R + 8;
}
DEV void convT(const float* __restrict__ src, int ld, int K, int NR, u16* __restrict__ dst, int mode, int c0, int half,
               int& tbase, float* smem) {
  const int tid = tid_(), G = gridDim.x;
  const int kt = K >> 6, ntile = kt * (NR >> 6);
  int start = ((int)blockIdx.x - tbase) % G;
  if (start < 0) start += G;
  for (int t = start; t < ntile; t += G) {
    const int rt = t / kt, k0 = (t - rt * kt) * 64, R0 = rt * 64;
    __syncthreads();
    const int rr = tid & 63;
    const int col = wmap(mode, R0 + rr, c0, half);
#pragma unroll
    for (int i = 0; i < 16; ++i) {
      int kk = i * 4 + (tid >> 6);
      smem[kk * 65 + rr] = src[(size_t)(k0 + kk) * ld + col];
    }
    __syncthreads();
    const int r2 = tid >> 2, seg = (tid & 3) * 16;
    unsigned o[8];
#pragma unroll
    for (int e = 0; e < 8; ++e) o[e] = pack2(smem[(seg + 2 * e) * 65 + r2], smem[(seg + 2 * e + 1) * 65 + r2]);
    uint4* d = (uint4*)(dst + (size_t)(R0 + r2) * K + k0 + seg);
    d[0] = make_uint4(o[0], o[1], o[2], o[3]);
    d[1] = make_uint4(o[4], o[5], o[6], o[7]);
  }
  tbase = (tbase + ntile) % G;
}
DEV void phase_convw(const P& p, int l, float* smem) {
  u16* W = (u16*)(p.ws + OFF_W);
  int tb = 0;
  convT(p.in[11] + (size_t)l * 1024 * 5632, 5632, 1024, 5632, W + W_GU1, 1, 0, 2816, tb, smem);
  convT(p.in[12] + (size_t)l * 2816 * 1024, 1024, 2816, 1024, W + W_DN1, 0, 0, 0, tb, smem);
  convT(p.in[14] + (size_t)l * 1024 * 6408, 6408, 1024, 2304, W + W_INM, 2, 0, 0, tb, smem);
  convT(p.in[14] + (size_t)l * 1024 * 6408, 6408, 1024, 4096, W + W_ING, 0, 2312, 0, tb, smem);
  for (int n = 0; n < 4; ++n)
    convT(p.in[40] + (size_t)(l * 4 + n) * 256 * 1024, 1024, 256, 1024, W + W_BR + (size_t)n * 1024 * 256, 0, 0, 0, tb, smem);
  convT(p.in[41] + (size_t)l * 1024 * 1024, 1024, 1024, 1024, W + W_OUT, 0, 0, 0, tb, smem);
  convT(p.in[27] + (size_t)l * 256 * 512, 512, 256, 512, W + W_GLU, 1, 0, 256, tb, smem);
  convT(p.in[43] + (size_t)l * 1024 * 5632, 5632, 1024, 5632, W + W_GU2, 1, 0, 2816, tb, smem);
  convT(p.in[44] + (size_t)l * 2816 * 1024, 1024, 2816, 1024, W + W_DN2, 0, 0, 0, tb, smem);
}

template <int BN>
DEV void gemm_acc(const u16* __restrict__ A, int lda, const u16* __restrict__ Bt, int ldb, int K, f32x4 (&acc)[4][BN / 32],
                  u16* sA, u16* sB) {
  constexpr int NI = BN / 32;
  const int tid = tid_(), lane = tid & 63, w = tid >> 6, wm = w >> 1, wn = w & 1;
  const int lrow = tid >> 3, lseg = (tid & 7) * 8;
  const u16* ga = A + (size_t)lrow * lda + lseg;
  const u16* gb = Bt + (size_t)lrow * ldb + lseg;
  u16* wa = sA + lrow * 72 + lseg;
  u16* wb = sB + lrow * 72 + lseg;
  const u16* fa = sA + (wm * 64 + (lane & 15)) * 72 + (lane >> 4) * 8;
  const u16* fb = sB + (wn * (BN / 2) + (lane & 15)) * 72 + (lane >> 4) * 8;
  u32x4 pa0, pa1, pa2, pa3, pb0, pb1, pb2, pb3, qa0, qa1, qa2, qa3, qb0, qb1, qb2, qb3;
#define GA_LOAD(X, koff) do { const u16* _ga = ga + (koff); const u16* _gb = gb + (koff); \
    X##a0 = *(const u32x4*)(_ga); X##a1 = *(const u32x4*)(_ga + (size_t)32 * lda); X##a2 = *(const u32x4*)(_ga + (size_t)64 * lda); X##a3 = *(const u32x4*)(_ga + (size_t)96 * lda); \
    X##b0 = *(const u32x4*)(_gb); X##b1 = *(const u32x4*)(_gb + (size_t)32 * ldb); \
    if (BN == 128) { X##b2 = *(const u32x4*)(_gb + (size_t)64 * ldb); X##b3 = *(const u32x4*)(_gb + (size_t)96 * ldb); } } while (0)
#define GA_WRITE(X) do { *(u32x4*)(wa) = X##a0; *(u32x4*)(wa + 32 * 72) = X##a1; *(u32x4*)(wa + 64 * 72) = X##a2; *(u32x4*)(wa + 96 * 72) = X##a3; \
    *(u32x4*)(wb) = X##b0; *(u32x4*)(wb + 32 * 72) = X##b1; \
    if (BN == 128) { *(u32x4*)(wb + 64 * 72) = X##b2; *(u32x4*)(wb + 96 * 72) = X##b3; } } while (0)
#define GA_COMPUTE() do { _Pragma("unroll") for (int kk = 0; kk < 64; kk += 32) { bf16x8 a[4], b[NI]; \
    _Pragma("unroll") for (int mi = 0; mi < 4; ++mi) a[mi] = *(const bf16x8*)(fa + mi * 16 * 72 + kk); \
    _Pragma("unroll") for (int ni = 0; ni < NI; ++ni) b[ni] = *(const bf16x8*)(fb + ni * 16 * 72 + kk); \
    _Pragma("unroll") for (int mi = 0; mi < 4; ++mi) _Pragma("unroll") for (int ni = 0; ni < NI; ++ni) \
      acc[mi][ni] = __builtin_amdgcn_mfma_f32_16x16x32_bf16(b[ni], a[mi], acc[mi][ni], 0, 0, 0); } } while (0)
  GA_LOAD(p, 0);
  if (K > 64) GA_LOAD(q, 64);
  for (int k0 = 0; k0 < K; k0 += 128) {
    __syncthreads();
    GA_WRITE(p);
    __syncthreads();
    if (k0 + 128 < K) GA_LOAD(p, k0 + 128);
    GA_COMPUTE();
    if (k0 + 64 >= K) break;
    __syncthreads();
    GA_WRITE(q);
    __syncthreads();
    if (k0 + 192 < K) GA_LOAD(q, k0 + 192);
    GA_COMPUTE();
  }
#undef GA_LOAD
#undef GA_WRITE
#undef GA_COMPUTE
}

template <int MODE>
DEV void dual_tile(const u16* A, int lda, int K, const u16* Wt, int mt, int nt, u16* out, int ldo, int ocol0, const float* bias,
                   u16* sA, u16* sB) {
  f32x4 acc[4][4];
#pragma unroll
  for (int i = 0; i < 4; ++i)
#pragma unroll
    for (int j = 0; j < 4; ++j) acc[i][j] = (f32x4){0.f, 0.f, 0.f, 0.f};
  gemm_acc<128>(A + (size_t)mt * 128 * lda, lda, Wt + (size_t)nt * 128 * K, K, K, acc, sA, sB);
  const int tid0 = tid_(); const int lane = tid0 & 63, w = tid0 >> 6, wm = w >> 1, wn = w & 1;
#pragma unroll
  for (int np = 0; np < 2; ++np) {
    const int col = nt * 64 + (wn * 2 + np) * 16 + (lane >> 4) * 4;
    float4 b0 = make_float4(0.f, 0.f, 0.f, 0.f), b1 = b0;
    if (MODE == 1) { b0 = *(const float4*)(bias + col); b1 = *(const float4*)(bias + 256 + col); }
#pragma unroll
    for (int mi = 0; mi < 4; ++mi) {
      const int row = mt * 128 + wm * 64 + mi * 16 + (lane & 15);
      const f32x4 g = acc[mi][2 * np], u = acc[mi][2 * np + 1];
      float v0, v1, v2, v3;
      if (MODE == 0) { v0 = siluf_(g[0]) * u[0]; v1 = siluf_(g[1]) * u[1]; v2 = siluf_(g[2]) * u[2]; v3 = siluf_(g[3]) * u[3]; }
      else { v0 = (g[0] + b0.x) * sigm(u[0] + b1.x); v1 = (g[1] + b0.y) * sigm(u[1] + b1.y); v2 = (g[2] + b0.z) * sigm(u[2] + b1.z); v3 = (g[3] + b0.w) * sigm(u[3] + b1.w); }
      uint2 o; o.x = pack2(v0, v1); o.y = pack2(v2, v3);
      *(uint2*)(out + (size_t)row * ldo + ocol0 + col) = o;
    }
  }
}
DEV void resid_tile(const u16* A, int lda, int K, const u16* Wt, int mt, int nt, float* X, float scale, u16* sA, u16* sB) {
  f32x4 acc[4][4];
#pragma unroll
  for (int i = 0; i < 4; ++i)
#pragma unroll
    for (int j = 0; j < 4; ++j) acc[i][j] = (f32x4){0.f, 0.f, 0.f, 0.f};
  gemm_acc<128>(A + (size_t)mt * 128 * lda, lda, Wt + (size_t)nt * 128 * K, K, K, acc, sA, sB);
  const int tid0 = tid_(); const int lane = tid0 & 63, w = tid0 >> 6, wm = w >> 1, wn = w & 1;
#pragma unroll
  for (int mi = 0; mi < 4; ++mi) {
    const int row = mt * 128 + wm * 64 + mi * 16 + (lane & 15);
    float* rp = X + (size_t)row * 1024 + nt * 128 + wn * 64 + (lane >> 4) * 4;
#pragma unroll
    for (int ni = 0; ni < 4; ++ni) { f32x4* q = (f32x4*)(rp + ni * 16); *q = *q + scale * acc[mi][ni]; }
  }
}
DEV void zm_tile(const u16* A, const u16* Wt, int mt, int nt, u16* Zm, u16* sA, u16* sB) {
  f32x4 acc[4][4];
#pragma unroll
  for (int i = 0; i < 4; ++i)
#pragma unroll
    for (int j = 0; j < 4; ++j) acc[i][j] = (f32x4){0.f, 0.f, 0.f, 0.f};
  gemm_acc<128>(A + (size_t)mt * 128 * 1024, 1024, Wt + (size_t)nt * 128 * 1024, 1024, 1024, acc, sA, sB);
  const int tid0 = tid_(); const int lane = tid0 & 63, w = tid0 >> 6, wm = w >> 1, wn = w & 1;
#pragma unroll
  for (int mi = 0; mi < 4; ++mi)
#pragma unroll
    for (int ni = 0; ni < 4; ++ni) {
      const int row = mt * 128 + wm * 64 + mi * 16 + (lane & 15);
      const int col = nt * 128 + wn * 64 + ni * 16 + (lane >> 4) * 4;
      uint2 o; o.x = pack2(acc[mi][ni][0], acc[mi][ni][1]); o.y = pack2(acc[mi][ni][2], acc[mi][ni][3]);
      *(uint2*)(Zm + (size_t)row * ZW + col) = o;
    }
}

DEV void gemm_acc256(const u16* __restrict__ A, int lda, const u16* __restrict__ Bt, int ldb, int K, f32x4 (&acc)[4][8],
                     u16* sA, u16* sB) {
  const int tid = tid_(), lane = tid & 63, w = tid >> 6, wm = w >> 1, wn = w & 1;
  const int lrow = tid >> 3, lseg = (tid & 7) * 8;
  const u16* ga = A + (size_t)lrow * lda + lseg;
  const u16* gb = Bt + (size_t)lrow * ldb + lseg;
  u16* wa = sA + lrow * 72 + lseg;
  u16* wb = sB + lrow * 72 + lseg;
  const u16* fa = sA + (wm * 64 + (lane & 15)) * 72 + (lane >> 4) * 8;
  const u16* fb = sB + (wn * 128 + (lane & 15)) * 72 + (lane >> 4) * 8;
  u32x4 ra0, ra1, ra2, ra3, rb0, rb1, rb2, rb3, rb4, rb5, rb6, rb7;
  ra0 = *(const u32x4*)(ga);
  ra1 = *(const u32x4*)(ga + (size_t)32 * lda);
  ra2 = *(const u32x4*)(ga + (size_t)64 * lda);
  ra3 = *(const u32x4*)(ga + (size_t)96 * lda);
  rb0 = *(const u32x4*)(gb);
  rb1 = *(const u32x4*)(gb + (size_t)32 * ldb);
  rb2 = *(const u32x4*)(gb + (size_t)64 * ldb);
  rb3 = *(const u32x4*)(gb + (size_t)96 * ldb);
  rb4 = *(const u32x4*)(gb + (size_t)128 * ldb);
  rb5 = *(const u32x4*)(gb + (size_t)160 * ldb);
  rb6 = *(const u32x4*)(gb + (size_t)192 * ldb);
  rb7 = *(const u32x4*)(gb + (size_t)224 * ldb);
  for (int k0 = 0; k0 < K; k0 += 64) {
    __syncthreads();
    *(u32x4*)(wa) = ra0; *(u32x4*)(wa + 32 * 72) = ra1; *(u32x4*)(wa + 64 * 72) = ra2; *(u32x4*)(wa + 96 * 72) = ra3;
    *(u32x4*)(wb) = rb0; *(u32x4*)(wb + 32 * 72) = rb1; *(u32x4*)(wb + 64 * 72) = rb2; *(u32x4*)(wb + 96 * 72) = rb3;
    *(u32x4*)(wb + 128 * 72) = rb4; *(u32x4*)(wb + 160 * 72) = rb5; *(u32x4*)(wb + 192 * 72) = rb6; *(u32x4*)(wb + 224 * 72) = rb7;
    __syncthreads();
    if (k0 + 64 < K) {
      const u16* ga2 = ga + k0 + 64;
      const u16* gb2 = gb + k0 + 64;
      ra0 = *(const u32x4*)(ga2);
      ra1 = *(const u32x4*)(ga2 + (size_t)32 * lda);
      ra2 = *(const u32x4*)(ga2 + (size_t)64 * lda);
      ra3 = *(const u32x4*)(ga2 + (size_t)96 * lda);
      rb0 = *(const u32x4*)(gb2);
      rb1 = *(const u32x4*)(gb2 + (size_t)32 * ldb);
      rb2 = *(const u32x4*)(gb2 + (size_t)64 * ldb);
      rb3 = *(const u32x4*)(gb2 + (size_t)96 * ldb);
      rb4 = *(const u32x4*)(gb2 + (size_t)128 * ldb);
      rb5 = *(const u32x4*)(gb2 + (size_t)160 * ldb);
      rb6 = *(const u32x4*)(gb2 + (size_t)192 * ldb);
      rb7 = *(const u32x4*)(gb2 + (size_t)224 * ldb);
    }
#pragma unroll
    for (int kk = 0; kk < 64; kk += 32) {
      bf16x8 a[4];
#pragma unroll
      for (int mi = 0; mi < 4; ++mi) a[mi] = *(const bf16x8*)(fa + mi * 16 * 72 + kk);
#pragma unroll
      for (int nh = 0; nh < 2; ++nh) {
        bf16x8 b[4];
#pragma unroll
        for (int ni = 0; ni < 4; ++ni) b[ni] = *(const bf16x8*)(fb + (nh * 4 + ni) * 16 * 72 + kk);
#pragma unroll
        for (int mi = 0; mi < 4; ++mi)
#pragma unroll
          for (int ni = 0; ni < 4; ++ni)
            acc[mi][nh * 4 + ni] = __builtin_amdgcn_mfma_f32_16x16x32_bf16(b[ni], a[mi], acc[mi][nh * 4 + ni], 0, 0, 0);
      }
    }
  }
}
DEV void dual_tile256(const u16* A, const u16* Wt, int mt, int nt, u16* out, u16* sA, u16* sB) {
  f32x4 acc[4][8];
#pragma unroll
  for (int i = 0; i < 4; ++i)
#pragma unroll
    for (int j = 0; j < 8; ++j) acc[i][j] = (f32x4){0.f, 0.f, 0.f, 0.f};
  gemm_acc256(A + (size_t)mt * 128 * 1024, 1024, Wt + (size_t)nt * 256 * 1024, 1024, 1024, acc, sA, sB);
  const int tid0 = tid_(); const int lane = tid0 & 63, w = tid0 >> 6, wm = w >> 1, wn = w & 1;
#pragma unroll
  for (int mi = 0; mi < 4; ++mi) {
    const int row = mt * 128 + wm * 64 + mi * 16 + (lane & 15);
#pragma unroll
    for (int np = 0; np < 4; ++np) {
      const int col = (nt * 2 + wn) * 64 + np * 16 + (lane >> 4) * 4;
      const f32x4 g = acc[mi][2 * np], u = acc[mi][2 * np + 1];
      uint2 o; o.x = pack2(siluf_(g[0]) * u[0], siluf_(g[1]) * u[1]); o.y = pack2(siluf_(g[2]) * u[2], siluf_(g[3]) * u[3]);
      *(uint2*)(out + (size_t)row * 2816 + col) = o;
    }
  }
}
DEV void zm_tile256(const u16* A, const u16* Wt, int mt, int nt, u16* Zm, u16* sA, u16* sB) {
  f32x4 acc[4][8];
#pragma unroll
  for (int i = 0; i < 4; ++i)
#pragma unroll
    for (int j = 0; j < 8; ++j) acc[i][j] = (f32x4){0.f, 0.f, 0.f, 0.f};
  gemm_acc256(A + (size_t)mt * 128 * 1024, 1024, Wt + (size_t)nt * 256 * 1024, 1024, 1024, acc, sA, sB);
  const int tid0 = tid_(); const int lane = tid0 & 63, w = tid0 >> 6, wm = w >> 1, wn = w & 1;
#pragma unroll
  for (int mi = 0; mi < 4; ++mi) {
    const int row = mt * 128 + wm * 64 + mi * 16 + (lane & 15);
#pragma unroll
    for (int ni = 0; ni < 8; ++ni) {
      const int col = nt * 256 + wn * 128 + ni * 16 + (lane >> 4) * 4;
      uint2 o; o.x = pack2(acc[mi][ni][0], acc[mi][ni][1]); o.y = pack2(acc[mi][ni][2], acc[mi][ni][3]);
      *(uint2*)(Zm + (size_t)row * ZW + col) = o;
    }
  }
}
DEV void g4_tile(const P& p, int mt, int nt, u16* sA, u16* sB) {
  const u16* BR = (const u16*)(p.ws + OFF_D + D_BR);
  const u16* XN = (const u16*)(p.ws + OFF_XN);
  const u16* Wb = (const u16*)(p.ws + OFF_W) + W_BR;
  const u16* Wg = (const u16*)(p.ws + OFF_W) + W_ING;
  u16* M = (u16*)(p.ws + OFF_D + D_M);
  f32x4 accM[4][2];
#pragma unroll
  for (int i = 0; i < 4; ++i)
#pragma unroll
    for (int j = 0; j < 2; ++j) accM[i][j] = (f32x4){0.f, 0.f, 0.f, 0.f};
#pragma unroll 1
  for (int n = 0; n < 4; ++n) {
    unsigned gate[4][2][2];
    {
      f32x4 accG[4][2];
#pragma unroll
      for (int i = 0; i < 4; ++i)
#pragma unroll
        for (int j = 0; j < 2; ++j) accG[i][j] = (f32x4){0.f, 0.f, 0.f, 0.f};
      gemm_acc<64>(XN + (size_t)mt * 128 * 1024, 1024, Wg + ((size_t)n * 1024 + nt * 64) * 1024, 1024, 1024, accG, sA, sB);
#pragma unroll
      for (int i = 0; i < 4; ++i)
#pragma unroll
        for (int j = 0; j < 2; ++j) {
          gate[i][j][0] = pack2(sigm(accG[i][j][0]), sigm(accG[i][j][1]));
          gate[i][j][1] = pack2(sigm(accG[i][j][2]), sigm(accG[i][j][3]));
        }
    }
    f32x4 accP[4][2];
#pragma unroll
    for (int i = 0; i < 4; ++i)
#pragma unroll
      for (int j = 0; j < 2; ++j) accP[i][j] = (f32x4){0.f, 0.f, 0.f, 0.f};
    gemm_acc<64>(BR + (size_t)mt * 128 * 1024 + n * 256, 1024, Wb + ((size_t)n * 1024 + nt * 64) * 256, 256, 256, accP, sA, sB);
#pragma unroll
    for (int i = 0; i < 4; ++i)
#pragma unroll
      for (int j = 0; j < 2; ++j) {
        accM[i][j][0] += bflo(gate[i][j][0]) * accP[i][j][0];
        accM[i][j][1] += bfhi(gate[i][j][0]) * accP[i][j][1];
        accM[i][j][2] += bflo(gate[i][j][1]) * accP[i][j][2];
        accM[i][j][3] += bfhi(gate[i][j][1]) * accP[i][j][3];
      }
  }
  const int tid0 = tid_(); const int lane = tid0 & 63, w = tid0 >> 6, wm = w >> 1, wn = w & 1;
#pragma unroll
  for (int mi = 0; mi < 4; ++mi) {
    const int row = mt * 128 + wm * 64 + mi * 16 + (lane & 15);
#pragma unroll
    for (int ni = 0; ni < 2; ++ni) {
      const int col = nt * 64 + wn * 32 + ni * 16 + (lane >> 4) * 4;
      uint2 o; o.x = pack2(accM[mi][ni][0], accM[mi][ni][1]); o.y = pack2(accM[mi][ni][2], accM[mi][ni][3]);
      *(uint2*)(M + (size_t)row * 1024 + col) = o;
    }
  }
}

DEV void dn_conv16(const u16* __restrict__ Zm, const float* __restrict__ buf, const float* __restrict__ cw, int rowbase, int t, int c,
                   float (&o)[16]) {
#pragma unroll
  for (int e = 0; e < 16; ++e) o[e] = 0.f;
#pragma unroll
  for (int tap = 0; tap < 4; ++tap) {
    const int tau = t - 3 + tap;
    float x[16];
    if (tau >= 0) {
      const uint4* z = (const uint4*)(Zm + (size_t)(rowbase + tau) * ZW + c);
      unpack16(z[0], z[1], x);
    } else if (buf) {
      const float4* bb = (const float4*)(buf + (3 + tau) * 768 + c);
#pragma unroll
      for (int q = 0; q < 4; ++q) { float4 f = bb[q]; x[q * 4] = f.x; x[q * 4 + 1] = f.y; x[q * 4 + 2] = f.z; x[q * 4 + 3] = f.w; }
    } else {
#pragma unroll
      for (int e = 0; e < 16; ++e) x[e] = 0.f;
    }
    const float4* w4 = (const float4*)(cw + tap * 768 + c);
#pragma unroll
    for (int q = 0; q < 4; ++q) {
      float4 f = w4[q];
      o[q * 4] += f.x * x[q * 4]; o[q * 4 + 1] += f.y * x[q * 4 + 1]; o[q * 4 + 2] += f.z * x[q * 4 + 2]; o[q * 4 + 3] += f.w * x[q * 4 + 3];
    }
  }
#pragma unroll
  for (int e = 0; e < 16; ++e) o[e] = siluf_(o[e]);
}

DEV void delta_pre(const P& p, int l, int idx, float* smem) {
  float* sq = smem;
  float* sk = smem + 64 * 68;
  float* sL = smem + 2 * 64 * 68;
  float* sbeta = sL + 4096;
  float* sg = sbeta + 64;
  float* sgc = sg + 64;
  int s, h, j, pad, T;
  if (idx < 1056) { s = idx / 132; int r = idx - s * 132; h = r / 33; j = r - h * 33; pad = 48; T = TP; }
  else { int r = idx - 1056; s = 8 + (r >> 2); h = r & 3; j = 0; pad = 56; T = 8; }
  const int tid = tid_();
  const u16* Zm = (const u16*)(p.ws + OFF_D + D_ZM);
  const float* BA = (const float*)(p.ws + OFF_BA);
  const float* cw = p.in[15] + l * 4 * 768;
  const float* buf = (s >= 8) ? p.in[3] + (size_t)(l * 128 + (s - 8)) * 3 * 768 : nullptr;
  const int rowbase = rowbase_of(s);
  u16* wsb = (u16*)p.out + (size_t)idx * 20480;
  float* gamma = (float*)(p.ws + OFF_GAMMA);
  {
    const int i = tid >> 2, dq = (tid & 3) * 16;
    const int t = j * 64 + i - pad;
    float qv[16], kv[16];
    float sq_ = 0.f, sk_ = 0.f;
    if (t >= 0) {
      dn_conv16(Zm, buf, cw, rowbase, t, h * 64 + dq, qv);
      dn_conv16(Zm, buf, cw, rowbase, t, 256 + h * 64 + dq, kv);
#pragma unroll
      for (int e = 0; e < 16; ++e) { sq_ += qv[e] * qv[e]; sk_ += kv[e] * kv[e]; }
    } else {
#pragma unroll
      for (int e = 0; e < 16; ++e) { qv[e] = 0.f; kv[e] = 0.f; }
    }
    sq_ += __shfl_xor(sq_, 1, 64); sq_ += __shfl_xor(sq_, 2, 64);
    sk_ += __shfl_xor(sk_, 1, 64); sk_ += __shfl_xor(sk_, 2, 64);
    const float qs = rsqrtf(sq_ + 1e-6f) * 0.125f, ks = rsqrtf(sk_ + 1e-6f);
#pragma unroll
    for (int e = 0; e < 16; ++e) { sq[i * 68 + dq + e] = qv[e] * qs; sk[i * 68 + dq + e] = kv[e] * ks; }
  }
  if (tid < 64) {
    const int t = j * 64 + tid - pad;
    float be = 0.f, g = 0.f;
    if (t >= 0) {
      const float* ba = BA + (size_t)(rowbase + t) * 8;
      be = sigm(ba[h]);
      float a = ba[4 + h] + p.in[17][l * 4 + h];
      g = -expf(p.in[16][l * 4 + h]) * softplusf_(a);
    }
    sbeta[tid] = be;
    sg[tid] = g;
  }
  __syncthreads();
  if (tid < 64) {
    float c = 0.f;
    for (int i2 = 0; i2 <= tid; ++i2) c += sg[i2];
    sgc[tid] = c;
  }
  __syncthreads();
  {
    const int ti = tid >> 4, tj = tid & 15;
    float aL[4][4], aI[4][4];
#pragma unroll
    for (int a = 0; a < 4; ++a)
#pragma unroll
      for (int b = 0; b < 4; ++b) { aL[a][b] = 0.f; aI[a][b] = 0.f; }
    for (int d = 0; d < 64; d += 4) {
      float4 qa[4], ka[4], kb[4];
#pragma unroll
      for (int a = 0; a < 4; ++a) { qa[a] = *(const float4*)&sq[(ti + 16 * a) * 68 + d]; ka[a] = *(const float4*)&sk[(ti + 16 * a) * 68 + d]; }
#pragma unroll
      for (int b = 0; b < 4; ++b) kb[b] = *(const float4*)&sk[(tj + 16 * b) * 68 + d];
#pragma unroll
      for (int a = 0; a < 4; ++a)
#pragma unroll
        for (int b = 0; b < 4; ++b) {
          aL[a][b] += ka[a].x * kb[b].x + ka[a].y * kb[b].y + ka[a].z * kb[b].z + ka[a].w * kb[b].w;
          aI[a][b] += qa[a].x * kb[b].x + qa[a].y * kb[b].y + qa[a].z * kb[b].z + qa[a].w * kb[b].w;
        }
    }
#pragma unroll
    for (int a = 0; a < 4; ++a)
#pragma unroll
      for (int b = 0; b < 4; ++b) {
        const int i = ti + 16 * a, jj = tj + 16 * b;
        const float dec = (jj <= i) ? __expf(sgc[i] - sgc[jj]) : 0.f;
        sL[i * 64 + jj] = (jj < i) ? aL[a][b] * sbeta[i] * dec : 0.f;
        wsb[3 * 4096 + i * 64 + jj] = f2bf(aI[a][b] * dec);
      }
  }
  for (int e = tid; e < 4096; e += 256) {
    const int i = e >> 6, d = e & 63;
    wsb[2 * 4096 + e] = f2bf(sq[i * 68 + d] * __expf(sgc[i]));
  }
  for (int e = tid; e < 4096; e += 256) {
    const int d = e >> 6, i = e & 63;
    wsb[4 * 4096 + e] = f2bf(sk[i * 68 + d] * __expf(sgc[63] - sgc[i]));
  }
  if (tid == 0) gamma[idx] = __expf(sgc[63]);
  __syncthreads();
  {
    const int i = tid >> 2, dq = (tid & 3) * 16;
    const int t = j * 64 + i - pad;
    float vv[16];
    if (t >= 0) dn_conv16(Zm, buf, cw, rowbase, t, 512 + h * 64 + dq, vv);
    else {
#pragma unroll
      for (int e = 0; e < 16; ++e) vv[e] = 0.f;
    }
    const float be = sbeta[i], eg = be * __expf(sgc[i]);
#pragma unroll
    for (int e = 0; e < 16; ++e) { sq[i * 68 + dq + e] = vv[e] * be; sk[i * 68 + dq + e] *= eg; }
  }
  __syncthreads();
  {
    float* arr = (tid < 128) ? sq : sk;
    const int col = (tid >> 1) & 63, hf = tid & 1;
    for (int i = 1; i < 64; ++i) {
      float acc = 0.f;
      for (int j0 = hf * 4; j0 < i; j0 += 8) {
        const float4 l4 = *(const float4*)&sL[i * 64 + j0];
        acc -= l4.x * arr[j0 * 68 + col] + l4.y * arr[(j0 + 1) * 68 + col] + l4.z * arr[(j0 + 2) * 68 + col] + l4.w * arr[(j0 + 3) * 68 + col];
      }
      acc += __shfl_xor(acc, 1, 64);
      if (hf == 0) arr[i * 68 + col] += acc;
    }
  }
  __syncthreads();
  for (int e = tid; e < 4096; e += 256) {
    const int i = e >> 6, d = e & 63;
    wsb[e] = f2bf(sq[i * 68 + d]);
    wsb[4096 + e] = f2bf(sk[i * 68 + d]);
  }
  if (h == 0 && j == (s < 8 ? 32 : 0)) {
    float* o = st_out(p, O_PDCONV, O_SDCONV, l, s, 3 * 768);
    for (int e = tid; e < 3 * 768; e += 256) {
      const int r = e / 768, c = e - r * 768;
      o[e] = bf2f(Zm[(size_t)(rowbase + T - 3 + r) * ZW + c]);
    }
  }
}

DEV void mm64(const float* __restrict__ A, const float* __restrict__ B, float (&acc)[4][4], int ti, int tj) {
#pragma unroll 4
  for (int kk = 0; kk < 64; kk += 4) {
    float4 a[4], b[4];
#pragma unroll
    for (int x = 0; x < 4; ++x) a[x] = *(const float4*)&A[(ti + 16 * x) * 68 + kk];
#pragma unroll
    for (int y = 0; y < 4; ++y) b[y] = *(const float4*)&B[(kk + y) * 64 + tj * 4];
#pragma unroll
    for (int x = 0; x < 4; ++x) {
      acc[x][0] += a[x].x * b[0].x + a[x].y * b[1].x + a[x].z * b[2].x + a[x].w * b[3].x;
      acc[x][1] += a[x].x * b[0].y + a[x].y * b[1].y + a[x].z * b[2].y + a[x].w * b[3].y;
      acc[x][2] += a[x].x * b[0].z + a[x].y * b[1].z + a[x].z * b[2].z + a[x].w * b[3].z;
      acc[x][3] += a[x].x * b[0].w + a[x].y * b[1].w + a[x].z * b[2].w + a[x].w * b[3].w;
    }
  }
}
DEV void storeA16(float* sA, uint4 r0, uint4 r1) {
  const int tid = tid_();
  float x[16];
  unpack16(r0, r1, x);
  float* d = sA + (tid >> 2) * 68 + (tid & 3) * 16;
#pragma unroll
  for (int q = 0; q < 4; ++q) *(float4*)(d + q * 4) = make_float4(x[q * 4], x[q * 4 + 1], x[q * 4 + 2], x[q * 4 + 3]);
}

DEV void mm64h(const u16* __restrict__ A, const float* __restrict__ B, float (&acc)[4][4], int ti, int tj) {
#pragma unroll 4
  for (int kk = 0; kk < 64; kk += 4) {
    float4 a[4], b[4];
#pragma unroll
    for (int x = 0; x < 4; ++x) {
      const uint2 av = *(const uint2*)&A[(ti + 16 * x) * 72 + kk];
      a[x] = make_float4(bflo(av.x), bfhi(av.x), bflo(av.y), bfhi(av.y));
    }
#pragma unroll
    for (int y = 0; y < 4; ++y) b[y] = *(const float4*)&B[(kk + y) * 64 + tj * 4];
#pragma unroll
    for (int x = 0; x < 4; ++x) {
      acc[x][0] += a[x].x * b[0].x + a[x].y * b[1].x + a[x].z * b[2].x + a[x].w * b[3].x;
      acc[x][1] += a[x].x * b[0].y + a[x].y * b[1].y + a[x].z * b[2].y + a[x].w * b[3].y;
      acc[x][2] += a[x].x * b[0].z + a[x].y * b[1].z + a[x].z * b[2].z + a[x].w * b[3].z;
      acc[x][3] += a[x].x * b[0].w + a[x].y * b[1].w + a[x].z * b[2].w + a[x].w * b[3].w;
    }
  }
}
DEV void store16h(u16* sA, uint4 r0, uint4 r1) {
  const int tid = tid_();
  uint4* d = (uint4*)(sA + (tid >> 2) * 72 + (tid & 3) * 16);
  d[0] = r0; d[1] = r1;
}

DEV void delta_seq(const P& p, int l, int s, int h, float* smem) {
  float* sS = smem;
  float* sV = smem + 4096;
  u16* sA0 = (u16*)(smem + 8192);
  u16* sA1 = sA0 + 64 * 72;
  u16* sA2 = sA1 + 64 * 72;
  const int tid = tid_(), ti = tid >> 4, tj = tid & 15;
  const int n = (s < 8) ? 33 : 1, pad = (s < 8) ? 48 : 56;
  const int item0 = (s < 8) ? (s * 4 + h) * 33 : 1056 + (s - 8) * 4 + h;
  const int rowbase = rowbase_of(s);
  const float* s0 = (s >= 8) ? p.in[2] + (size_t)((l * 128 + (s - 8)) * 4 + h) * 4096 : nullptr;
  for (int e = tid; e < 4096; e += 256) sS[e] = s0 ? s0[e] : 0.f;
  const u16* wsb = (const u16*)p.out + (size_t)item0 * 20480;
  const float* gamma = (const float*)(p.ws + OFF_GAMMA) + item0;
  const u16* Zm = (const u16*)(p.ws + OFF_D + D_ZM);
  u16* BR = (u16*)(p.ws + OFF_D + D_BR);
  const float4 ng = *(const float4*)(p.in[18] + l * 64 + tj * 4);
  uint4 rw0, rw1, rq0, rq1, ri0, ri1, rk0, rk1;
  {
    const uint4* src = (const uint4*)(wsb + tid * 16);
    rw0 = src[512]; rw1 = src[513];
    rq0 = src[1024]; rq1 = src[1025];
    ri0 = src[1536]; ri1 = src[1537];
    rk0 = src[2048]; rk1 = src[2049];
  }
  for (int j = 0; j < n; ++j) {
    const u16* it = wsb + (size_t)j * 20480;
    uint2 uu_pf[4], zz_pf[4];
#pragma unroll
    for (int a = 0; a < 4; ++a) {
      const int i = ti + 16 * a;
      uu_pf[a] = *(const uint2*)(it + i * 64 + tj * 4);
      const int t = j * 64 + i - pad;
      zz_pf[a] = (t >= 0) ? *(const uint2*)(Zm + (size_t)(rowbase + t) * ZW + 768 + h * 64 + tj * 4) : make_uint2(0u, 0u);
    }
    const float gm = gamma[j];
    __syncthreads();
    store16h(sA0, rw0, rw1); store16h(sA1, rq0, rq1); store16h(sA2, ri0, ri1);
    __syncthreads();
    if (j + 1 < n) {
      const uint4* src = (const uint4*)(it + 20480 + tid * 16);
      rw0 = src[512]; rw1 = src[513]; rq0 = src[1024]; rq1 = src[1025]; ri0 = src[1536]; ri1 = src[1537];
    }
    float acc[4][4];
#pragma unroll
    for (int a = 0; a < 4; ++a)
#pragma unroll
      for (int c = 0; c < 4; ++c) acc[a][c] = 0.f;
    mm64h(sA0, sS, acc, ti, tj);
#pragma unroll
    for (int a = 0; a < 4; ++a) {
      const int i = ti + 16 * a;
      const uint2 uu = uu_pf[a];
      *(float4*)&sV[i * 64 + tj * 4] = make_float4(bflo(uu.x) - acc[a][0], bfhi(uu.x) - acc[a][1], bflo(uu.y) - acc[a][2], bfhi(uu.y) - acc[a][3]);
    }
    __syncthreads();
    store16h(sA0, rk0, rk1);
    if (j + 1 < n) { const uint4* src = (const uint4*)(it + 20480 + tid * 16); rk0 = src[2048]; rk1 = src[2049]; }
    float o[4][4];
#pragma unroll
    for (int a = 0; a < 4; ++a)
#pragma unroll
      for (int c = 0; c < 4; ++c) o[a][c] = 0.f;
    mm64h(sA1, sS, o, ti, tj);
    mm64h(sA2, sV, o, ti, tj);
#pragma unroll
    for (int a = 0; a < 4; ++a) {
      const int i = ti + 16 * a;
      const int t = j * 64 + i - pad;
      float ss = o[a][0] * o[a][0] + o[a][1] * o[a][1] + o[a][2] * o[a][2] + o[a][3] * o[a][3];
      ss += __shfl_xor(ss, 1, 64); ss += __shfl_xor(ss, 2, 64); ss += __shfl_xor(ss, 4, 64); ss += __shfl_xor(ss, 8, 64);
      if (t >= 0) {
        const float inv = rsqrtf(ss * (1.f / 64.f) + 1e-6f);
        const size_t row = (size_t)(rowbase + t);
        const uint2 zz = zz_pf[a];
        float y0 = o[a][0] * inv * ng.x * siluf_(bflo(zz.x));
        float y1 = o[a][1] * inv * ng.y * siluf_(bfhi(zz.x));
        float y2 = o[a][2] * inv * ng.z * siluf_(bflo(zz.y));
        float y3 = o[a][3] * inv * ng.w * siluf_(bfhi(zz.y));
        uint2 ov; ov.x = pack2(y0, y1); ov.y = pack2(y2, y3);
        *(uint2*)(BR + row * 1024 + h * 64 + tj * 4) = ov;
      }
    }
    __syncthreads();
#pragma unroll
    for (int a = 0; a < 4; ++a)
#pragma unroll
      for (int c = 0; c < 4; ++c) acc[a][c] = 0.f;
    mm64h(sA0, sV, acc, ti, tj);
#pragma unroll
    for (int a = 0; a < 4; ++a) {
      float4* sp = (float4*)&sS[(ti + 16 * a) * 64 + tj * 4];
      float4 old = *sp;
      *sp = make_float4(gm * old.x + acc[a][0], gm * old.y + acc[a][1], gm * old.z + acc[a][2], gm * old.w + acc[a][3]);
    }
  }
  __syncthreads();
  float* so = st_out(p, O_PDELTA, O_SDELTA, l, s, 4 * 4096) + h * 4096;
  for (int e = tid; e < 4096; e += 256) so[e] = sS[e];
}

DEV void s5_block(const P& p, int l, int s, int gq, float* smem) {
  const int tid = tid_(), lane = tid & 63;
  const int w = __builtin_amdgcn_readfirstlane(tid >> 6);
  const int g = gq * 4 + w;
  float* sC = smem + w * 3248;
  float* sH = sC + 2080;
  float* sU = sH + 1040;
  const int T = (s < 8) ? TP : 8;
  const int rowbase = rowbase_of(s);
  const u16* Zm = (const u16*)(p.ws + OFF_D + D_ZM);
  u16* Y5 = (u16*)(p.ws + OFF_D + D_Y5);
  const int lg_ = l * 16 + g;
  const float lr = p.in[19][lg_ * 64 + lane], li = p.in[20][lg_ * 64 + lane];
  const float dt = expf(p.in[21][lg_]);
  const float mag = expf(lr * dt);
  const float lbr = mag * cosf(li * dt), lbi = mag * sinf(li * dt);
  const float den = lr * lr + li * li;
  const float cfr = ((lbr - 1.f) * lr + lbi * li) / den, cfi = (lbi * lr - (lbr - 1.f) * li) / den;
  float xr_c[16], xi_c[16];
  {
    const float4* br4 = (const float4*)(p.in[22] + ((size_t)lg_ * 64 + lane) * 16);
    const float4* bi4 = (const float4*)(p.in[23] + ((size_t)lg_ * 64 + lane) * 16);
#pragma unroll
    for (int q = 0; q < 4; ++q) {
      float4 a = br4[q], b = bi4[q];
      xr_c[q * 4] = cfr * a.x - cfi * b.x; xi_c[q * 4] = cfr * b.x + cfi * a.x;
      xr_c[q * 4 + 1] = cfr * a.y - cfi * b.y; xi_c[q * 4 + 1] = cfr * b.y + cfi * a.y;
      xr_c[q * 4 + 2] = cfr * a.z - cfi * b.z; xi_c[q * 4 + 2] = cfr * b.z + cfi * a.z;
      xr_c[q * 4 + 3] = cfr * a.w - cfi * b.w; xi_c[q * 4 + 3] = cfr * b.w + cfi * a.w;
    }
  }
  for (int e = lane; e < 1024; e += 64) {
    const int c = e >> 6, pp = e & 63;
    sC[(c * 65 + pp) * 2] = p.in[24][(size_t)lg_ * 1024 + e];
    sC[(c * 65 + pp) * 2 + 1] = p.in[25][(size_t)lg_ * 1024 + e];
  }
  float hr = 0.f, hi = 0.f;
  if (s >= 8) {
    hr = p.in[4][((size_t)(l * 128 + (s - 8)) * 16 + g) * 64 + lane];
    hi = p.in[5][((size_t)(l * 128 + (s - 8)) * 16 + g) * 64 + lane];
  }
  const int ytt = lane >> 3, cp = (lane & 7) * 2;
  const float d0 = p.in[26][l * 256 + g * 16 + cp], d1 = p.in[26][l * 256 + g * 16 + cp + 1];
  const u16* ubase = Zm + (size_t)rowbase * ZW + 1024 + g * 16 + (size_t)(lane >> 1) * ZW + (lane & 1) * 8;
  uint4 pu = make_uint4(0u, 0u, 0u, 0u);
  if (lane < 16) pu = *(const uint4*)(ubase);
  if (lane < 16) {
    float* d = sU + (lane >> 1) * 16 + (lane & 1) * 8;
    *(float4*)(d) = make_float4(bflo(pu.x), bfhi(pu.x), bflo(pu.y), bfhi(pu.y));
    *(float4*)(d + 4) = make_float4(bflo(pu.z), bfhi(pu.z), bflo(pu.w), bfhi(pu.w));
  }
  for (int t0 = 0; t0 < T; t0 += 8) {
    __syncthreads();
    if (lane < 16 && t0 + 8 < T) pu = *(const uint4*)(ubase + (size_t)(t0 + 8) * ZW);
#pragma unroll 2
    for (int tt = 0; tt < 8; ++tt) {
      const float4 u0 = *(const float4*)(sU + tt * 16), u1 = *(const float4*)(sU + tt * 16 + 4), u2 = *(const float4*)(sU + tt * 16 + 8),
                   u3 = *(const float4*)(sU + tt * 16 + 12);
      const float u[16] = {u0.x, u0.y, u0.z, u0.w, u1.x, u1.y, u1.z, u1.w, u2.x, u2.y, u2.z, u2.w, u3.x, u3.y, u3.z, u3.w};
      float xr = 0.f, xi = 0.f;
#pragma unroll
      for (int c = 0; c < 16; ++c) { xr += xr_c[c] * u[c]; xi += xi_c[c] * u[c]; }
      const float nr = lbr * hr - lbi * hi + xr;
      const float ni = lbr * hi + lbi * hr + xi;
      hr = nr; hi = ni;
      *(float2*)&sH[(tt * 65 + lane) * 2] = make_float2(hr, hi);
    }
    __syncthreads();
    float y0 = 0.f, y1 = 0.f;
#pragma unroll 8
    for (int pp = 0; pp < 64; ++pp) {
      const float2 hv = *(const float2*)&sH[(ytt * 65 + pp) * 2];
      const float2 c0 = *(const float2*)&sC[(cp * 65 + pp) * 2];
      const float2 c1 = *(const float2*)&sC[((cp + 1) * 65 + pp) * 2];
      y0 += hv.x * c0.x - hv.y * c0.y;
      y1 += hv.x * c1.x - hv.y * c1.y;
    }
    const size_t row = (size_t)(rowbase + t0 + ytt);
    const float2 uy = *(const float2*)(sU + ytt * 16 + cp);
    y0 = geluf_(y0 + d0 * uy.x);
    y1 = geluf_(y1 + d1 * uy.y);
    *(unsigned*)(Y5 + row * 256 + g * 16 + cp) = pack2(y0, y1);
    if (lane < 16 && t0 + 8 < T) {
      float* d = sU + (lane >> 1) * 16 + (lane & 1) * 8;
      *(float4*)(d) = make_float4(bflo(pu.x), bfhi(pu.x), bflo(pu.y), bfhi(pu.y));
      *(float4*)(d + 4) = make_float4(bflo(pu.z), bfhi(pu.z), bflo(pu.w), bfhi(pu.w));
    }
  }
  st_out(p, O_PS5RE, O_SS5RE, l, s, 1024)[g * 64 + lane] = hr;
  st_out(p, O_PS5IM, O_SS5IM, l, s, 1024)[g * 64 + lane] = hi;
}


DEV void s5_prompt(const P& p, int l, int s, int g, float* smem) {
  const int tid = tid_(), lane = tid & 63;
  const int w = __builtin_amdgcn_readfirstlane(tid >> 6);
  float* sC = smem;
  float* sE = smem + 2080;
  float* sH = smem + 2080 + 512 + w * 1168;
  float* sU = sH + 1040;
  const int rowbase = rowbase_of(s);
  const int tbeg = w * 512, tend = (w == 3) ? TP : tbeg + 512;
  const u16* Zm = (const u16*)(p.ws + OFF_D + D_ZM);
  u16* Y5 = (u16*)(p.ws + OFF_D + D_Y5);
  const int lg_ = l * 16 + g;
  const float lr = p.in[19][lg_ * 64 + lane], li = p.in[20][lg_ * 64 + lane];
  const float dt = expf(p.in[21][lg_]);
  const float mag = expf(lr * dt);
  const float lbr = mag * cosf(li * dt), lbi = mag * sinf(li * dt);
  const float den = lr * lr + li * li;
  const float cfr = ((lbr - 1.f) * lr + lbi * li) / den, cfi = (lbi * lr - (lbr - 1.f) * li) / den;
  float xr_c[16], xi_c[16];
  {
    const float4* br4 = (const float4*)(p.in[22] + ((size_t)lg_ * 64 + lane) * 16);
    const float4* bi4 = (const float4*)(p.in[23] + ((size_t)lg_ * 64 + lane) * 16);
#pragma unroll
    for (int q = 0; q < 4; ++q) {
      float4 a = br4[q], b = bi4[q];
      xr_c[q * 4] = cfr * a.x - cfi * b.x; xi_c[q * 4] = cfr * b.x + cfi * a.x;
      xr_c[q * 4 + 1] = cfr * a.y - cfi * b.y; xi_c[q * 4 + 1] = cfr * b.y + cfi * a.y;
      xr_c[q * 4 + 2] = cfr * a.z - cfi * b.z; xi_c[q * 4 + 2] = cfr * b.z + cfi * a.z;
      xr_c[q * 4 + 3] = cfr * a.w - cfi * b.w; xi_c[q * 4 + 3] = cfr * b.w + cfi * a.w;
    }
  }
  for (int e = tid; e < 1024; e += 256) {
    const int c = e >> 6, pp = e & 63;
    sC[(c * 65 + pp) * 2] = p.in[24][(size_t)lg_ * 1024 + e];
    sC[(c * 65 + pp) * 2 + 1] = p.in[25][(size_t)lg_ * 1024 + e];
  }
  const u16* ubase = Zm + (size_t)rowbase * ZW + 1024 + g * 16 + (size_t)(lane >> 1) * ZW + (lane & 1) * 8;
  float hr = 0.f, hi = 0.f;
  if (w < 3) {
    uint4 pu = make_uint4(0u, 0u, 0u, 0u);
    if (lane < 16) pu = *(const uint4*)(ubase + (size_t)tbeg * ZW);
    for (int t0 = tbeg; t0 < tend; t0 += 8) {
      if (lane < 16) {
        float* d = sU + (lane >> 1) * 16 + (lane & 1) * 8;
        *(float4*)(d) = make_float4(bflo(pu.x), bfhi(pu.x), bflo(pu.y), bfhi(pu.y));
        *(float4*)(d + 4) = make_float4(bflo(pu.z), bfhi(pu.z), bflo(pu.w), bfhi(pu.w));
      }
      if (lane < 16 && t0 + 8 < tend) pu = *(const uint4*)(ubase + (size_t)(t0 + 8) * ZW);
      __builtin_amdgcn_wave_barrier();
#pragma unroll 2
      for (int tt = 0; tt < 8; ++tt) {
        const float4 u0 = *(const float4*)(sU + tt * 16), u1 = *(const float4*)(sU + tt * 16 + 4), u2 = *(const float4*)(sU + tt * 16 + 8),
                     u3 = *(const float4*)(sU + tt * 16 + 12);
        const float u[16] = {u0.x, u0.y, u0.z, u0.w, u1.x, u1.y, u1.z, u1.w, u2.x, u2.y, u2.z, u2.w, u3.x, u3.y, u3.z, u3.w};
        float xr = 0.f, xi = 0.f;
#pragma unroll
        for (int c = 0; c < 16; ++c) { xr += xr_c[c] * u[c]; xi += xi_c[c] * u[c]; }
        const float nr = lbr * hr - lbi * hi + xr;
        const float ni = lbr * hi + lbi * hr + xi;
        hr = nr; hi = ni;
      }
      __builtin_amdgcn_wave_barrier();
    }
    *(float2*)&sE[(w * 64 + lane) * 2] = make_float2(hr, hi);
  }
  __syncthreads();
  {
    const float m512 = expf(lr * dt * 512.f);
    const float pr = m512 * cosf(li * dt * 512.f), pi = m512 * sinf(li * dt * 512.f);
    float Hr = 0.f, Hi = 0.f;
    for (int k = 0; k < w; ++k) {
      const float2 e = *(const float2*)&sE[(k * 64 + lane) * 2];
      const float nr = pr * Hr - pi * Hi + e.x, ni = pr * Hi + pi * Hr + e.y;
      Hr = nr; Hi = ni;
    }
    hr = Hr; hi = Hi;
  }
  const int ytt = lane >> 3, cp = (lane & 7) * 2;
  const float d0 = p.in[26][l * 256 + g * 16 + cp], d1 = p.in[26][l * 256 + g * 16 + cp + 1];
  {
    uint4 pu = make_uint4(0u, 0u, 0u, 0u);
    if (lane < 16) pu = *(const uint4*)(ubase + (size_t)tbeg * ZW);
    for (int t0 = tbeg; t0 < tend; t0 += 8) {
      if (lane < 16) {
        float* d = sU + (lane >> 1) * 16 + (lane & 1) * 8;
        *(float4*)(d) = make_float4(bflo(pu.x), bfhi(pu.x), bflo(pu.y), bfhi(pu.y));
        *(float4*)(d + 4) = make_float4(bflo(pu.z), bfhi(pu.z), bflo(pu.w), bfhi(pu.w));
      }
      if (lane < 16 && t0 + 8 < tend) pu = *(const uint4*)(ubase + (size_t)(t0 + 8) * ZW);
      __builtin_amdgcn_wave_barrier();
#pragma unroll 2
      for (int tt = 0; tt < 8; ++tt) {
        const float4 u0 = *(const float4*)(sU + tt * 16), u1 = *(const float4*)(sU + tt * 16 + 4), u2 = *(const float4*)(sU + tt * 16 + 8),
                     u3 = *(const float4*)(sU + tt * 16 + 12);
        const float u[16] = {u0.x, u0.y, u0.z, u0.w, u1.x, u1.y, u1.z, u1.w, u2.x, u2.y, u2.z, u2.w, u3.x, u3.y, u3.z, u3.w};
        float xr = 0.f, xi = 0.f;
#pragma unroll
        for (int c = 0; c < 16; ++c) { xr += xr_c[c] * u[c]; xi += xi_c[c] * u[c]; }
        const float nr = lbr * hr - lbi * hi + xr;
        const float ni = lbr * hi + lbi * hr + xi;
        hr = nr; hi = ni;
        *(float2*)&sH[(tt * 65 + lane) * 2] = make_float2(hr, hi);
      }
      __builtin_amdgcn_wave_barrier();
      float y0 = 0.f, y1 = 0.f;
#pragma unroll 8
      for (int pp = 0; pp < 64; ++pp) {
        const float2 hv = *(const float2*)&sH[(ytt * 65 + pp) * 2];
        const float2 c0 = *(const float2*)&sC[(cp * 65 + pp) * 2];
        const float2 c1 = *(const float2*)&sC[((cp + 1) * 65 + pp) * 2];
        y0 += hv.x * c0.x - hv.y * c0.y;
        y1 += hv.x * c1.x - hv.y * c1.y;
      }
      const size_t row = (size_t)(rowbase + t0 + ytt);
      const float2 uy = *(const float2*)(sU + ytt * 16 + cp);
      y0 = geluf_(y0 + d0 * uy.x);
      y1 = geluf_(y1 + d1 * uy.y);
      *(unsigned*)(Y5 + row * 256 + g * 16 + cp) = pack2(y0, y1);
      __builtin_amdgcn_wave_barrier();
    }
  }
  if (w == 3) {
    st_out(p, O_PS5RE, O_SS5RE, l, s, 1024)[g * 64 + lane] = hr;
    st_out(p, O_PS5IM, O_SS5IM, l, s, 1024)[g * 64 + lane] = hi;
  }
}

DEV float lru_xin(const P& p, const u16* Zm, int l, int s, int rowbase, int tau, int c) {
  if (tau >= 0) return bf2f(Zm[(size_t)(rowbase + tau) * ZW + 1280 + c]);
  if (s >= 8) return p.in[7][((size_t)(l * 128 + (s - 8)) * 3 + (3 + tau)) * 256 + c];
  return 0.f;
}
DEV void lru_pass1(const P& p, int l, int s, int t0, float* smem) {
  float* sX = smem;
  const int c = tid_();
  const int T = (s < 8) ? TP : 8;
  const int nT = min(32, T - t0);
  const int rowbase = rowbase_of(s);
  const u16* Zm = (const u16*)(p.ws + OFF_D + D_ZM);
  u16* LA = (u16*)(p.ws + OFF_D + D_LA);
  u16* LB = (u16*)(p.ws + OFF_D + D_LB);
  const float w0 = p.in[29][(l * 4 + 0) * 256 + c], w1 = p.in[29][(l * 4 + 1) * 256 + c], w2 = p.in[29][(l * 4 + 2) * 256 + c],
              w3 = p.in[29][(l * 4 + 3) * 256 + c];
  const float cb = p.in[30][l * 256 + c];
  float xm3 = lru_xin(p, Zm, l, s, rowbase, t0 - 3, c), xm2 = lru_xin(p, Zm, l, s, rowbase, t0 - 2, c),
        xm1 = lru_xin(p, Zm, l, s, rowbase, t0 - 1, c);
  u16 xin[32];
#pragma unroll
  for (int tt = 0; tt < 32; ++tt) xin[tt] = (tt < nT) ? Zm[(size_t)(rowbase + t0 + tt) * ZW + 1280 + c] : (u16)0;
#pragma unroll
  for (int tt = 0; tt < 32; ++tt) {
    const float x0 = bf2f(xin[tt]);
    sX[tt * 256 + c] = (tt < nT) ? (w0 * xm3 + w1 * xm2 + w2 * xm1 + w3 * x0 + cb) : 0.f;
    xm3 = xm2; xm2 = xm1; xm1 = x0;
  }
  __syncthreads();
  const int blk = __builtin_amdgcn_readfirstlane(c >> 6), d = c & 63;
  const float* wa = p.in[31] + (size_t)(l * 4 + blk) * 4096;
  const float* wx = p.in[33] + (size_t)(l * 4 + blk) * 4096;
  const float ba = p.in[32][l * 256 + c], bx = p.in[34][l * 256 + c];
  const float sp = softplusf_(-p.in[35][l * 256 + c]);
  for (int b8 = 0; b8 * 8 < nT; ++b8) {
    float ra[8], ia[8];
#pragma unroll
    for (int tt = 0; tt < 8; ++tt) { ra[tt] = 0.f; ia[tt] = 0.f; }
#pragma unroll 4
    for (int k = 0; k < 64; ++k) {
      const float wav = wa[k * 64 + d], wxv = wx[k * 64 + d];
#pragma unroll
      for (int tt = 0; tt < 8; ++tt) {
        const float xv = sX[(b8 * 8 + tt) * 256 + blk * 64 + k];
        ra[tt] += xv * wav; ia[tt] += xv * wxv;
      }
    }
#pragma unroll
    for (int tt = 0; tt < 8; ++tt) {
      const int t = b8 * 8 + tt;
      if (t < nT) {
        const float r = sigm(ra[tt] + ba), ig = sigm(ia[tt] + bx);
        const float la = -8.f * r * sp;
        const float bb = sqrtf(-expm1f(2.f * la)) * (ig * sX[t * 256 + c]);
        const size_t row = (size_t)(rowbase + t0 + t);
        LA[row * 256 + c] = f2bf(la);
        LB[row * 256 + c] = f2bf(bb);
      }
    }
  }
  if (t0 + nT == T) {
    float* o = st_out(p, O_PLRUC, O_SLRUC, l, s, 3 * 256);
#pragma unroll
    for (int r = 0; r < 3; ++r) o[r * 256 + c] = lru_xin(p, Zm, l, s, rowbase, T - 3 + r, c);
  }
}
DEV void lru_pass2(const P& p, int l, int s) {
  const int c = tid_();
  const int T = (s < 8) ? TP : 8;
  const int rowbase = rowbase_of(s);
  const u16* Zm = (const u16*)(p.ws + OFF_D + D_ZM);
  const u16* LA = (const u16*)(p.ws + OFF_D + D_LA);
  const u16* LB = (const u16*)(p.ws + OFF_D + D_LB);
  u16* BR = (u16*)(p.ws + OFF_D + D_BR);
  float h = (s >= 8) ? p.in[6][(size_t)(l * 128 + (s - 8)) * 256 + c] : 0.f;
  u16 na[8], nb[8], ng[8];
#pragma unroll
  for (int tt = 0; tt < 8; ++tt) {
    const size_t row = (size_t)(rowbase + tt);
    na[tt] = LA[row * 256 + c]; nb[tt] = LB[row * 256 + c]; ng[tt] = Zm[row * ZW + 1536 + c];
  }
  for (int t0 = 0; t0 < T; t0 += 8) {
    float la[8], lb[8], lg[8];
#pragma unroll
    for (int tt = 0; tt < 8; ++tt) { la[tt] = bf2f(na[tt]); lb[tt] = bf2f(nb[tt]); lg[tt] = bf2f(ng[tt]); }
    if (t0 + 8 < T) {
#pragma unroll
      for (int tt = 0; tt < 8; ++tt) {
        const size_t row = (size_t)(rowbase + t0 + 8 + tt);
        na[tt] = LA[row * 256 + c]; nb[tt] = LB[row * 256 + c]; ng[tt] = Zm[row * ZW + 1536 + c];
      }
    }
#pragma unroll
    for (int tt = 0; tt < 8; ++tt) {
      h = __expf(la[tt]) * h + lb[tt];
      BR[(size_t)(rowbase + t0 + tt) * 1024 + 512 + c] = f2bf(h * geluf_(lg[tt]));
    }
  }
  st_out(p, O_PLRU, O_SLRU, l, s, 256)[c] = h;
}


DEV void lru_prompt(const P& p, int l, int s, int cg, float* smem) {
  const int tid = tid_(), lane = tid & 63;
  const int w = __builtin_amdgcn_readfirstlane(tid >> 6);
  const int c = cg * 64 + lane;
  float* sE = smem;
  float* sL = smem + 256;
  const int rowbase = rowbase_of(s);
  const int tbeg = w * 512, tend = (w == 3) ? TP : tbeg + 512;
  const u16* Zm = (const u16*)(p.ws + OFF_D + D_ZM);
  const u16* LA = (const u16*)(p.ws + OFF_D + D_LA);
  const u16* LB = (const u16*)(p.ws + OFF_D + D_LB);
  u16* BR = (u16*)(p.ws + OFF_D + D_BR);
  {
    float h = 0.f, sl = 0.f;
    for (int t0 = tbeg; t0 < tend; t0 += 8) {
      u16 na[8], nb[8];
#pragma unroll
      for (int tt = 0; tt < 8; ++tt) { const size_t row = (size_t)(rowbase + t0 + tt); na[tt] = LA[row * 256 + c]; nb[tt] = LB[row * 256 + c]; }
#pragma unroll
      for (int tt = 0; tt < 8; ++tt) { const float la = bf2f(na[tt]); h = __expf(la) * h + bf2f(nb[tt]); sl += la; }
    }
    sE[w * 64 + lane] = h; sL[w * 64 + lane] = sl;
  }
  __syncthreads();
  float h = 0.f;
  for (int k = 0; k < w; ++k) h = __expf(sL[k * 64 + lane]) * h + sE[k * 64 + lane];
  u16 na[8], nb[8], ng[8];
#pragma unroll
  for (int tt = 0; tt < 8; ++tt) {
    const size_t row = (size_t)(rowbase + tbeg + tt);
    na[tt] = LA[row * 256 + c]; nb[tt] = LB[row * 256 + c]; ng[tt] = Zm[row * ZW + 1536 + c];
  }
  for (int t0 = tbeg; t0 < tend; t0 += 8) {
    float la[8], lb[8], lg[8];
#pragma unroll
    for (int tt = 0; tt < 8; ++tt) { la[tt] = bf2f(na[tt]); lb[tt] = bf2f(nb[tt]); lg[tt] = bf2f(ng[tt]); }
    if (t0 + 8 < tend) {
#pragma unroll
      for (int tt = 0; tt < 8; ++tt) {
        const size_t row = (size_t)(rowbase + t0 + 8 + tt);
        na[tt] = LA[row * 256 + c]; nb[tt] = LB[row * 256 + c]; ng[tt] = Zm[row * ZW + 1536 + c];
      }
    }
#pragma unroll
    for (int tt = 0; tt < 8; ++tt) {
      h = __expf(la[tt]) * h + lb[tt];
      BR[(size_t)(rowbase + t0 + tt) * 1024 + 512 + c] = f2bf(h * geluf_(lg[tt]));
    }
  }
  if (w == 3) st_out(p, O_PLRU, O_SLRU, l, s, 256)[c] = h;
}

DEV void conv_item(const P& p, int l, int s, int t0, float* smem) {
  float* sG = smem;
  const int c = tid_(), lane = c & 63, w = c >> 6;
  const int T = (s < 8) ? TP : 8;
  const int nT = min(32, T - t0);
  const int rowbase = rowbase_of(s);
  const u16* Zm = (const u16*)(p.ws + OFF_D + D_ZM);
  u16* BR = (u16*)(p.ws + OFF_D + D_BR);
#pragma unroll 8
  for (int rr = 0; rr < 30 + nT; ++rr) {
    const int tau = t0 - 30 + rr;
    float gl = 0.f;
    if (tau >= 0) {
      const size_t row = (size_t)(rowbase + tau);
      gl = bf2f(Zm[row * ZW + 1792 + c]) * sigm(bf2f(Zm[row * ZW + 2048 + c]));
    } else if (s >= 8) gl = p.in[8][((size_t)(l * 128 + (s - 8)) * 30 + (30 + tau)) * 256 + c];
    sG[rr * 256 + c] = gl;
  }
  if (t0 + nT == T) {
    float* o = st_out(p, O_PCONV, O_SCONV, l, s, 30 * 256);
    for (int r = 0; r < 30; ++r) o[r * 256 + c] = sG[(nT + r) * 256 + c];
  }
  float wv[31];
#pragma unroll
  for (int j = 0; j < 31; ++j) wv[j] = p.in[36][(size_t)(l * 31 + j) * 256 + c];
  const float cb = p.in[37][l * 256 + c];
  for (int tt = 0; tt < nT; ++tt) {
    float y = cb;
#pragma unroll
    for (int j = 0; j < 31; ++j) y += wv[j] * sG[(tt + j) * 256 + c];
    sG[tt * 256 + c] = y;
  }
  __syncthreads();
  const float4 lg4 = *(const float4*)(p.in[38] + l * 256 + lane * 4);
  const float4 lb4 = *(const float4*)(p.in[39] + l * 256 + lane * 4);
  for (int tt = w; tt < nT; tt += 4) {
    const float4 v = *(const float4*)&sG[tt * 256 + lane * 4];
    float s1 = v.x + v.y + v.z + v.w;
    s1 = wave_sum(s1);
    const float mean = s1 * (1.f / 256.f);
    const float a0 = v.x - mean, a1 = v.y - mean, a2 = v.z - mean, a3 = v.w - mean;
    float s2 = a0 * a0 + a1 * a1 + a2 * a2 + a3 * a3;
    s2 = wave_sum(s2);
    const float rstd = rsqrtf(s2 * (1.f / 256.f) + 1e-6f);
    uint2 ov;
    ov.x = pack2(siluf_(a0 * rstd * lg4.x + lb4.x), siluf_(a1 * rstd * lg4.y + lb4.y));
    ov.y = pack2(siluf_(a2 * rstd * lg4.z + lb4.z), siluf_(a3 * rstd * lg4.w + lb4.w));
    *(uint2*)(BR + (size_t)(rowbase + t0 + tt) * 1024 + 768 + lane * 4) = ov;
  }
}


DEV bool tile_of(int t, int G, int N, int NT, int& mt, int& nt) {
  const int r = t / G, b = t - r * G;
  const int q = r * G + (b & 7) * (G >> 3) + (b >> 3);
  if (q >= N) return false;
  const int P = NT >> 3, wl = NT & 7, full = P * MT * 8;
  if (q < full) { const int panel = q / (MT * 8), rem = q - panel * MT * 8; mt = rem >> 3; nt = panel * 8 + (rem & 7); }
  else { const int q2 = q - full; mt = q2 / wl; nt = P * 8 + (q2 - mt * wl); }
  return true;
}
#define TILE_LOOP(NT_, CALL) do { const int N_ = MT * (NT_); const int Nr_ = ((N_ + G - 1) / G) * G; \
    for (int t = B; t < Nr_; t += G) { int mt, nt; if (tile_of(t, G, N_, (NT_), mt, nt)) { CALL; } } } while (0)
__global__ void __launch_bounds__(256, 2) mega(P p) {
  __shared__ __attribute__((aligned(16))) float smem[16128];
  __shared__ int s_item;
  cg::grid_group grid = cg::this_grid();
  u16* sA = (u16*)smem;
  u16* sB = sA + 128 * 72;
  const u16* W = (const u16*)(p.ws + OFF_W);
  const u16* XN = (const u16*)(p.ws + OFF_XN);
  float* X = (float*)(p.ws + OFF_X);
  u16* H = (u16*)(p.ws + OFF_D + D_H);
  u16* Zm = (u16*)(p.ws + OFF_D + D_ZM);
  const u16* M = (const u16*)(p.ws + OFF_D + D_M);
  int* ctr = (int*)p.ws;
  const int G = gridDim.x, B = blockIdx.x;

  for (int l = 0; l < 2; ++l) {
    phase_norm(p, l, 0);
    phase_convw(p, l, smem);
    grid.sync();
    TILE_LOOP(22, dual_tile256(XN, W + W_GU1, mt, nt, H, sA, sB));
    grid.sync();
    TILE_LOOP(8, resid_tile(H, 2816, 2816, W + W_DN1, mt, nt, X, 0.5f, sA, sB));
    grid.sync();
    phase_norm(p, l, 1);
    grid.sync();
    TILE_LOOP(9, zm_tile256(XN, W + W_INM, mt, nt, Zm, sA, sB));
    grid.sync();
    for (;;) {
      __syncthreads();
      if (threadIdx.x == 0) s_item = atomicAdd(&ctr[l * 2], 1);
      __syncthreads();
      const int it = s_item;
      if (it >= 3504) break;
      int ll = l;
      asm volatile("" : "+s"(ll));
      if (it < 128) s5_prompt(p, ll, it >> 4, it & 15, smem);
      else if (it < 1696) delta_pre(p, ll, it - 128, smem);
      else if (it < 2216) { int i = it - 1696; conv_item(p, ll, i / 65, (i % 65) * 32, smem); }
      else if (it < 2344) conv_item(p, ll, 8 + (it - 2216), 0, smem);
      else if (it < 2864) { int i = it - 2344; lru_pass1(p, ll, i / 65, (i % 65) * 32, smem); }
      else if (it < 2992) lru_pass1(p, ll, 8 + (it - 2864), 0, smem);
      else { int i = it - 2992; s5_block(p, ll, 8 + (i >> 2), i & 3, smem); }
    }
    grid.sync();
    for (;;) {
      __syncthreads();
      if (threadIdx.x == 0) s_item = atomicAdd(&ctr[l * 2 + 1], 1);
      __syncthreads();
      const int it = s_item;
      if (it >= 1252) break;
      int ll = l;
      asm volatile("" : "+s"(ll));
      if (it < 32) delta_seq(p, ll, it >> 2, it & 3, smem);
      else if (it < 64) { int i = it - 32; lru_prompt(p, ll, i >> 2, i & 3, smem); }
      else if (it < 612) { int i = it - 64; dual_tile<1>((const u16*)(p.ws + OFF_D + D_Y5), 256, 256, W + W_GLU, i % MT, i / MT, (u16*)(p.ws + OFF_D + D_BR), 1024, 256, p.in[28] + ll * 512, sA, sB); }
      else if (it < 1124) { int i = it - 612; delta_seq(p, ll, 8 + (i >> 2), i & 3, smem); }
      else lru_pass2(p, ll, 8 + (it - 1124));
    }
    grid.sync();
    TILE_LOOP(16, g4_tile(p, mt, nt, sA, sB));
    grid.sync();
    TILE_LOOP(8, resid_tile(M, 1024, 1024, W + W_OUT, mt, nt, X, 1.0f, sA, sB));
    grid.sync();
    phase_norm(p, l, 2);
    grid.sync();
    TILE_LOOP(22, dual_tile256(XN, W + W_GU2, mt, nt, H, sA, sB));
    grid.sync();
    TILE_LOOP(8, resid_tile(H, 2816, 2816, W + W_DN2, mt, nt, X, 0.5f, sA, sB));
    grid.sync();
  }
  phase_norm(p, 0, 3);
}

extern "C" void kernel_launch(void* const* d_in, const int* in_sizes, int n_in, void* d_out, int out_size, void* d_ws,
                              size_t ws_size, hipStream_t stream) {
  P p{};
  for (int i = 0; i < 46; ++i) p.in[i] = (const float*)d_in[i];
  p.out = (float*)d_out;
  p.ws = (char*)d_ws;
  static int grid_blocks = 0;
  if (!grid_blocks) {
    int dev = 0, cus = 0, per = 0;
    hipGetDevice(&dev);
    hipDeviceGetAttribute(&cus, hipDeviceAttributeMultiprocessorCount, dev);
    hipOccupancyMaxActiveBlocksPerMultiprocessor(&per, mega, 256, 0);
    if (per > 2) per = 2;
    if (per < 1) per = 1;
    grid_blocks = cus * per;
  }
  if (ws_size < WS_NEED) fprintf(stderr, "workspace too small: %zu < %zu\n", ws_size, (size_t)WS_NEED);
  hipMemsetAsync(d_ws, 0, 256, stream);
  void* args[] = {&p};
  hipError_t e = hipLaunchCooperativeKernel((void*)mega, dim3(grid_blocks), dim3(256), args, 0, stream);
  if (e != hipSuccess) fprintf(stderr, "cooperative launch failed: %s (grid %d)\n", hipGetErrorString(e), grid_blocks);
}
```

```cpp
#include <hip/hip_runtime.h>
#include <hip/hip_bf16.h>
#include <hip/hip_cooperative_groups.h>
#include <cstdio>
namespace cg = cooperative_groups;

typedef unsigned short u16;
using bf16x8 = __attribute__((ext_vector_type(8))) short;
using f32x4 = __attribute__((ext_vector_type(4))) float;
using u32x4 = __attribute__((ext_vector_type(4))) unsigned int;
#define DEV __device__ __forceinline__

struct P { const float* in[46]; float* out; char* ws; };

constexpr int NTOK = 17536, TP = 2064, NPR = 16512, ZW = 2304, MT = 137;
constexpr size_t OFF_X = 65536;
constexpr size_t OFF_W = OFF_X + (size_t)NTOK * 1024 * 4;
constexpr size_t W_GU1 = 0, W_DN1 = 5767168, W_INM = 8650752, W_ING = 11010048, W_BR = 15204352, W_OUT = 16252928,
                 W_GLU = 17301504, W_GU2 = 17432576, W_DN2 = 23199744, W_END = 26083328;
constexpr size_t OFF_XN = OFF_W + W_END * 2;
constexpr size_t OFF_BA = OFF_XN + (size_t)NTOK * 1024 * 2;
constexpr size_t OFF_D = OFF_BA + (size_t)NTOK * 8 * 4;
constexpr size_t D_H = 0, D_ZM = 0, D_M = 0, D_BR = 80805888, D_LA = 116719616, D_LB = 125698048, D_Y5 = 134676480;
constexpr size_t WS_NEED = OFF_D + 143654912;
constexpr size_t OFF_GAMMA = 1024;
constexpr size_t O_YS = 16777216, O_PDELTA = 17825792, O_PDCONV = 18087936, O_PS5RE = 18124800, O_PS5IM = 18141184,
                 O_PLRU = 18157568, O_PLRUC = 18161664, O_PCONV = 18173952, O_SDELTA = 18296832, O_SDCONV = 22491136,
                 O_SS5RE = 23080960, O_SS5IM = 23343104, O_SLRU = 23605248, O_SLRUC = 23670784, O_SCONV = 23867392;

DEV u16 f2bf(float f) { unsigned u = __float_as_uint(f); u += 0x7fffu + ((u >> 16) & 1u); return (u16)(u >> 16); }
DEV float bf2f(u16 h) { return __uint_as_float(((unsigned)h) << 16); }
DEV float bflo(unsigned u) { return __uint_as_float(u << 16); }
DEV float bfhi(unsigned u) { return __uint_as_float(u & 0xffff0000u); }
DEV unsigned pack2(float a, float b) { return (unsigned)f2bf(a) | ((unsigned)f2bf(b) << 16); }
DEV float sigm(float x) { return 1.f / (1.f + __expf(-x)); }
DEV float siluf_(float x) { return x / (1.f + __expf(-x)); }
DEV float softplusf_(float x) { return fmaxf(x, 0.f) + log1pf(__expf(-fabsf(x))); }
DEV float geluf_(float x) { float u = 0.7978845608028654f * (x + 0.044715f * x * x * x); return 0.5f * x * (1.f + tanhf(u)); }
DEV float wave_sum(float v) {
#pragma unroll
  for (int o = 32; o > 0; o >>= 1) v += __shfl_xor(v, o, 64);
  return v;
}
DEV void unpack16(uint4 a, uint4 b, float (&x)[16]) {
  x[0] = bflo(a.x); x[1] = bfhi(a.x); x[2] = bflo(a.y); x[3] = bfhi(a.y); x[4] = bflo(a.z); x[5] = bfhi(a.z); x[6] = bflo(a.w); x[7] = bfhi(a.w);
  x[8] = bflo(b.x); x[9] = bfhi(b.x); x[10] = bflo(b.y); x[11] = bfhi(b.y); x[12] = bflo(b.z); x[13] = bfhi(b.z); x[14] = bflo(b.w); x[15] = bfhi(b.w);
}
DEV float* st_out(const P& p, size_t offP, size_t offS, int l, int s, int sz) {
  return s < 8 ? p.out + offP + (size_t)(l * 8 + s) * sz : p.out + offS + (size_t)(l * 128 + (s - 8)) * sz;
}
DEV int tid_() { int t = threadIdx.x; asm volatile("" : "+v"(t)); return t; }
DEV int rowbase_of(int s) { return s < 8 ? s * TP : NPR + (s - 8) * 8; }

DEV void phase_norm(const P& p, int l, int kind) {
  const int tid0 = tid_(); const int lane = tid0 & 63, w = tid0 >> 6;
  float* X = (float*)(p.ws + OFF_X);
  u16* XN = (u16*)(p.ws + OFF_XN);
  float* BA = (float*)(p.ws + OFF_BA);
  const float* gain = kind == 0 ? p.in[10] + l * 1024 : kind == 1 ? p.in[13] + l * 1024 : kind == 2 ? p.in[42] + l * 1024 : p.in[45];
  float4 g4[4];
#pragma unroll
  for (int i = 0; i < 4; ++i) g4[i] = *(const float4*)(gain + i * 256 + lane * 4);
  const bool first = (kind == 0 && l == 0);
  for (int r = blockIdx.x * 4 + w; r < NTOK; r += gridDim.x * 4) {
    const float* src;
    int b = 0, t = 0;
    if (r < NPR) { b = r / TP; t = r - b * TP; }
    if (first) {
      if (r < NPR) src = t < 16 ? p.in[9] + t * 1024 : p.in[0] + ((size_t)b * 2048 + (t - 16)) * 1024;
      else src = p.in[1] + (size_t)(r - NPR) * 1024;
    } else src = X + (size_t)r * 1024;
    float4 v[4];
    float ss = 0.f;
#pragma unroll
    for (int i = 0; i < 4; ++i) {
      v[i] = *(const float4*)(src + i * 256 + lane * 4);
      ss += v[i].x * v[i].x + v[i].y * v[i].y + v[i].z * v[i].z + v[i].w * v[i].w;
    }
    ss = wave_sum(ss);
    const float inv = rsqrtf(ss * (1.f / 1024.f) + 1e-6f);
    if (first) {
#pragma unroll
      for (int i = 0; i < 4; ++i) *(float4*)(X + (size_t)r * 1024 + i * 256 + lane * 4) = v[i];
    }
#pragma unroll
    for (int i = 0; i < 4; ++i) {
      v[i].x *= inv * g4[i].x; v[i].y *= inv * g4[i].y; v[i].z *= inv * g4[i].z; v[i].w *= inv * g4[i].w;
    }
    if (kind == 3) {
      float* dst;
      if (r < NPR) { if (t < 16) continue; dst = p.out + ((size_t)b * 2048 + (t - 16)) * 1024; }
      else dst = p.out + O_YS + (size_t)(r - NPR) * 1024;
#pragma unroll
      for (int i = 0; i < 4; ++i) *(float4*)(dst + i * 256 + lane * 4) = v[i];
    } else {
#pragma unroll
      for (int i = 0; i < 4; ++i) {
        uint2 o; o.x = pack2(v[i].x, v[i].y); o.y = pack2(v[i].z, v[i].w);
        *(uint2*)(XN + (size_t)r * 1024 + i * 256 + lane * 4) = o;
      }
      if (kind == 1) {
        const float* wi = p.in[14] + (size_t)l * 1024 * 6408 + 1024;
        float acc[8];
#pragma unroll
        for (int j = 0; j < 8; ++j) acc[j] = 0.f;
#pragma unroll
        for (int i = 0; i < 4; ++i) {
          const float yv[4] = {v[i].x, v[i].y, v[i].z, v[i].w};
#pragma unroll
          for (int e = 0; e < 4; ++e) {
            const float4* wr = (const float4*)(wi + (size_t)(i * 256 + lane * 4 + e) * 6408);
            float4 a = wr[0], c = wr[1];
            acc[0] += yv[e] * a.x; acc[1] += yv[e] * a.y; acc[2] += yv[e] * a.z; acc[3] += yv[e] * a.w;
            acc[4] += yv[e] * c.x; acc[5] += yv[e] * c.y; acc[6] += yv[e] * c.z; acc[7] += yv[e] * c.w;
          }
        }
#pragma unroll
        for (int j = 0; j < 8; ++j) acc[j] = wave_sum(acc[j]);
        if (lane == 0) {
          *(float4*)(BA + (size_t)r * 8) = make_float4(acc[0], acc[1], acc[2], acc[3]);
          *(float4*)(BA + (size_t)r * 8 + 4) = make_float4(acc[4], acc[5], acc[6], acc[7]);
        }
      }
    }
  }
}

DEV int wmap(int mode, int R, int c0, int half) {
  if (mode == 0) return c0 + R;
  if (mode == 1) { int tile = R >> 7, r = R & 127; int type = (r >> 4) & 1; return type * half + tile * 64 + (r >> 5) * 16 + (r & 15); }
  return R < 1024 ? R : R + 8;
}
DEV void convT(const float* __restrict__ src, int ld, int K, int NR, u16* __restrict__ dst, int mode, int c0, int half,
               int& tbase, float* smem) {
  const int tid = tid_(), G = gridDim.x;
  const int kt = K >> 6, ntile = kt * (NR >> 6);
  int start = ((int)blockIdx.x - tbase) % G;
  if (start < 0) start += G;
  for (int t = start; t < ntile; t += G) {
    const int rt = t / kt, k0 = (t - rt * kt) * 64, R0 = rt * 64;
    __syncthreads();
    const int rr = tid & 63;
    const int col = wmap(mode, R0 + rr, c0, half);
#pragma unroll
    for (int i = 0; i < 16; ++i) {
      int kk = i * 4 + (tid >> 6);
      smem[kk * 65 + rr] = src[(size_t)(k0 + kk) * ld + col];
    }
    __syncthreads();
    const int r2 = tid >> 2, seg = (tid & 3) * 16;
    unsigned o[8];
#pragma unroll
    for (int e = 0; e < 8; ++e) o[e] = pack2(smem[(seg + 2 * e) * 65 + r2], smem[(seg + 2 * e + 1) * 65 + r2]);
    uint4* d = (uint4*)(dst + (size_t)(R0 + r2) * K + k0 + seg);
    d[0] = make_uint4(o[0], o[1], o[2], o[3]);
    d[1] = make_uint4(o[4], o[5], o[6], o[7]);
  }
  tbase = (tbase + ntile) % G;
}
DEV void phase_convw(const P& p, int l, float* smem) {
  u16* W = (u16*)(p.ws + OFF_W);
  int tb = 0;
  convT(p.in[11] + (size_t)l * 1024 * 5632, 5632, 1024, 5632, W + W_GU1, 1, 0, 2816, tb, smem);
  convT(p.in[12] + (size_t)l * 2816 * 1024, 1024, 2816, 1024, W + W_DN1, 0, 0, 0, tb, smem);
  convT(p.in[14] + (size_t)l * 1024 * 6408, 6408, 1024, 2304, W + W_INM, 2, 0, 0, tb, smem);
  convT(p.in[14] + (size_t)l * 1024 * 6408, 6408, 1024, 4096, W + W_ING, 0, 2312, 0, tb, smem);
  for (int n = 0; n < 4; ++n)
    convT(p.in[40] + (size_t)(l * 4 + n) * 256 * 1024, 1024, 256, 1024, W + W_BR + (size_t)n * 1024 * 256, 0, 0, 0, tb, smem);
  convT(p.in[41] + (size_t)l * 1024 * 1024, 1024, 1024, 1024, W + W_OUT, 0, 0, 0, tb, smem);
  convT(p.in[27] + (size_t)l * 256 * 512, 512, 256, 512, W + W_GLU, 1, 0, 256, tb, smem);
  convT(p.in[43] + (size_t)l * 1024 * 5632, 5632, 1024, 5632, W + W_GU2, 1, 0, 2816, tb, smem);
  convT(p.in[44] + (size_t)l * 2816 * 1024, 1024, 2816, 1024, W + W_DN2, 0, 0, 0, tb, smem);
}

template <int BN>
DEV void gemm_acc(const u16* __restrict__ A, int lda, const u16* __restrict__ Bt, int ldb, int K, f32x4 (&acc)[4][BN / 32],
                  u16* sA, u16* sB) {
  constexpr int NI = BN / 32;
  const int tid = tid_(), lane = tid & 63, w = tid >> 6, wm = w >> 1, wn = w & 1;
  const int lrow = tid >> 3, lseg = (tid & 7) * 8;
  const u16* ga = A + (size_t)lrow * lda + lseg;
  const u16* gb = Bt + (size_t)lrow * ldb + lseg;
  u16* wa = sA + lrow * 72 + lseg;
  u16* wb = sB + lrow * 72 + lseg;
  const u16* fa = sA + (wm * 64 + (lane & 15)) * 72 + (lane >> 4) * 8;
  const u16* fb = sB + (wn * (BN / 2) + (lane & 15)) * 72 + (lane >> 4) * 8;
  u32x4 pa0, pa1, pa2, pa3, pb0, pb1, pb2, pb3, qa0, qa1, qa2, qa3, qb0, qb1, qb2, qb3;
#define GA_LOAD(X, koff) do { const u16* _ga = ga + (koff); const u16* _gb = gb + (koff); \
    X##a0 = *(const u32x4*)(_ga); X##a1 = *(const u32x4*)(_ga + (size_t)32 * lda); X##a2 = *(const u32x4*)(_ga + (size_t)64 * lda); X##a3 = *(const u32x4*)(_ga + (size_t)96 * lda); \
    X##b0 = *(const u32x4*)(_gb); X##b1 = *(const u32x4*)(_gb + (size_t)32 * ldb); \
    if (BN == 128) { X##b2 = *(const u32x4*)(_gb + (size_t)64 * ldb); X##b3 = *(const u32x4*)(_gb + (size_t)96 * ldb); } } while (0)
#define GA_WRITE(X) do { *(u32x4*)(wa) = X##a0; *(u32x4*)(wa + 32 * 72) = X##a1; *(u32x4*)(wa + 64 * 72) = X##a2; *(u32x4*)(wa + 96 * 72) = X##a3; \
    *(u32x4*)(wb) = X##b0; *(u32x4*)(wb + 32 * 72) = X##b1; \
    if (BN == 128) { *(u32x4*)(wb + 64 * 72) = X##b2; *(u32x4*)(wb + 96 * 72) = X##b3; } } while (0)
#define GA_COMPUTE() do { _Pragma("unroll") for (int kk = 0; kk < 64; kk += 32) { bf16x8 a[4], b[NI]; \
    _Pragma("unroll") for (int mi = 0; mi < 4; ++mi) a[mi] = *(const bf16x8*)(fa + mi * 16 * 72 + kk); \
    _Pragma("unroll") for (int ni = 0; ni < NI; ++ni) b[ni] = *(const bf16x8*)(fb + ni * 16 * 72 + kk); \
    _Pragma("unroll") for (int mi = 0; mi < 4; ++mi) _Pragma("unroll") for (int ni = 0; ni < NI; ++ni) \
      acc[mi][ni] = __builtin_amdgcn_mfma_f32_16x16x32_bf16(b[ni], a[mi], acc[mi][ni], 0, 0, 0); } } while (0)
  GA_LOAD(p, 0);
  if (K > 64) GA_LOAD(q, 64);
  for (int k0 = 0; k0 < K; k0 += 128) {
    __syncthreads();
    GA_WRITE(p);
    __syncthreads();
    if (k0 + 128 < K) GA_LOAD(p, k0 + 128);
    GA_COMPUTE();
    if (k0 + 64 >= K) break;
    __syncthreads();
    GA_WRITE(q);
    __syncthreads();
    if (k0 + 192 < K) GA_LOAD(q, k0 + 192);
    GA_COMPUTE();
  }
#undef GA_LOAD
#undef GA_WRITE
#undef GA_COMPUTE
}

template <int MODE>
DEV void dual_tile(const u16* A, int lda, int K, const u16* Wt, int mt, int nt, u16* out, int ldo, int ocol0, const float* bias,
                   u16* sA, u16* sB) {
  f32x4 acc[4][4];
#pragma unroll
  for (int i = 0; i < 4; ++i)
#pragma unroll
    for (int j = 0; j < 4; ++j) acc[i][j] = (f32x4){0.f, 0.f, 0.f, 0.f};
  gemm_acc<128>(A + (size_t)mt * 128 * lda, lda, Wt + (size_t)nt * 128 * K, K, K, acc, sA, sB);
  const int tid0 = tid_(); const int lane = tid0 & 63, w = tid0 >> 6, wm = w >> 1, wn = w & 1;
#pragma unroll
  for (int np = 0; np < 2; ++np) {
    const int col = nt * 64 + (wn * 2 + np) * 16 + (lane >> 4) * 4;
    float4 b0 = make_float4(0.f, 0.f, 0.f, 0.f), b1 = b0;
    if (MODE == 1) { b0 = *(const float4*)(bias + col); b1 = *(const float4*)(bias + 256 + col); }
#pragma unroll
    for (int mi = 0; mi < 4; ++mi) {
      const int row = mt * 128 + wm * 64 + mi * 16 + (lane & 15);
      const f32x4 g = acc[mi][2 * np], u = acc[mi][2 * np + 1];
      float v0, v1, v2, v3;
      if (MODE == 0) { v0 = siluf_(g[0]) * u[0]; v1 = siluf_(g[1]) * u[1]; v2 = siluf_(g[2]) * u[2]; v3 = siluf_(g[3]) * u[3]; }
      else { v0 = (g[0] + b0.x) * sigm(u[0] + b1.x); v1 = (g[1] + b0.y) * sigm(u[1] + b1.y); v2 = (g[2] + b0.z) * sigm(u[2] + b1.z); v3 = (g[3] + b0.w) * sigm(u[3] + b1.w); }
      uint2 o; o.x = pack2(v0, v1); o.y = pack2(v2, v3);
      *(uint2*)(out + (size_t)row * ldo + ocol0 + col) = o;
    }
  }
}
DEV void resid_tile(const u16* A, int lda, int K, const u16* Wt, int mt, int nt, float* X, float scale, u16* sA, u16* sB) {
  f32x4 acc[4][4];
#pragma unroll
  for (int i = 0; i < 4; ++i)
#pragma unroll
    for (int j = 0; j < 4; ++j) acc[i][j] = (f32x4){0.f, 0.f, 0.f, 0.f};
  gemm_acc<128>(A + (size_t)mt * 128 * lda, lda, Wt + (size_t)nt * 128 * K, K, K, acc, sA, sB);
  const int tid0 = tid_(); const int lane = tid0 & 63, w = tid0 >> 6, wm = w >> 1, wn = w & 1;
#pragma unroll
  for (int mi = 0; mi < 4; ++mi) {
    const int row = mt * 128 + wm * 64 + mi * 16 + (lane & 15);
    float* rp = X + (size_t)row * 1024 + nt * 128 + wn * 64 + (lane >> 4) * 4;
#pragma unroll
    for (int ni = 0; ni < 4; ++ni) { f32x4* q = (f32x4*)(rp + ni * 16); *q = *q + scale * acc[mi][ni]; }
  }
}
DEV void zm_tile(const u16* A, const u16* Wt, int mt, int nt, u16* Zm, u16* sA, u16* sB) {
  f32x4 acc[4][4];
#pragma unroll
  for (int i = 0; i < 4; ++i)
#pragma unroll
    for (int j = 0; j < 4; ++j) acc[i][j] = (f32x4){0.f, 0.f, 0.f, 0.f};
  gemm_acc<128>(A + (size_t)mt * 128 * 1024, 1024, Wt + (size_t)nt * 128 * 1024, 1024, 1024, acc, sA, sB);
  const int tid0 = tid_(); const int lane = tid0 & 63, w = tid0 >> 6, wm = w >> 1, wn = w & 1;
#pragma unroll
  for (int mi = 0; mi < 4; ++mi)
#pragma unroll
    for (int ni = 0; ni < 4; ++ni) {
      const int row = mt * 128 + wm * 64 + mi * 16 + (lane & 15);
      const int col = nt * 128 + wn * 64 + ni * 16 + (lane >> 4) * 4;
      uint2 o; o.x = pack2(acc[mi][ni][0], acc[mi][ni][1]); o.y = pack2(acc[mi][ni][2], acc[mi][ni][3]);
      *(uint2*)(Zm + (size_t)row * ZW + col) = o;
    }
}

DEV void gemm_acc256(const u16* __restrict__ A, int lda, const u16* __restrict__ Bt, int ldb, int K, f32x4 (&acc)[4][8],
                     u16* sA, u16* sB) {
  const int tid = tid_(), lane = tid & 63, w = tid >> 6, wm = w >> 1, wn = w & 1;
  const int lrow = tid >> 3, lseg = (tid & 7) * 8;
  const u16* ga = A + (size_t)lrow * lda + lseg;
  const u16* gb = Bt + (size_t)lrow * ldb + lseg;
  u16* wa = sA + lrow * 72 + lseg;
  u16* wb = sB + lrow * 72 + lseg;
  const u16* fa = sA + (wm * 64 + (lane & 15)) * 72 + (lane >> 4) * 8;
  const u16* fb = sB + (wn * 128 + (lane & 15)) * 72 + (lane >> 4) * 8;
  u32x4 ra0, ra1, ra2, ra3, rb0, rb1, rb2, rb3, rb4, rb5, rb6, rb7;
  ra0 = *(const u32x4*)(ga);
  ra1 = *(const u32x4*)(ga + (size_t)32 * lda);
  ra2 = *(const u32x4*)(ga + (size_t)64 * lda);
  ra3 = *(const u32x4*)(ga + (size_t)96 * lda);
  rb0 = *(const u32x4*)(gb);
  rb1 = *(const u32x4*)(gb + (size_t)32 * ldb);
  rb2 = *(const u32x4*)(gb + (size_t)64 * ldb);
  rb3 = *(const u32x4*)(gb + (size_t)96 * ldb);
  rb4 = *(const u32x4*)(gb + (size_t)128 * ldb);
  rb5 = *(const u32x4*)(gb + (size_t)160 * ldb);
  rb6 = *(const u32x4*)(gb + (size_t)192 * ldb);
  rb7 = *(const u32x4*)(gb + (size_t)224 * ldb);
  for (int k0 = 0; k0 < K; k0 += 64) {
    __syncthreads();
    *(u32x4*)(wa) = ra0; *(u32x4*)(wa + 32 * 72) = ra1; *(u32x4*)(wa + 64 * 72) = ra2; *(u32x4*)(wa + 96 * 72) = ra3;
    *(u32x4*)(wb) = rb0; *(u32x4*)(wb + 32 * 72) = rb1; *(u32x4*)(wb + 64 * 72) = rb2; *(u32x4*)(wb + 96 * 72) = rb3;
    *(u32x4*)(wb + 128 * 72) = rb4; *(u32x4*)(wb + 160 * 72) = rb5; *(u32x4*)(wb + 192 * 72) = rb6; *(u32x4*)(wb + 224 * 72) = rb7;
    __syncthreads();
    if (k0 + 64 < K) {
      const u16* ga2 = ga + k0 + 64;
      const u16* gb2 = gb + k0 + 64;
      ra0 = *(const u32x4*)(ga2);
      ra1 = *(const u32x4*)(ga2 + (size_t)32 * lda);
      ra2 = *(const u32x4*)(ga2 + (size_t)64 * lda);
      ra3 = *(const u32x4*)(ga2 + (size_t)96 * lda);
      rb0 = *(const u32x4*)(gb2);
      rb1 = *(const u32x4*)(gb2 + (size_t)32 * ldb);
      rb2 = *(const u32x4*)(gb2 + (size_t)64 * ldb);
      rb3 = *(const u32x4*)(gb2 + (size_t)96 * ldb);
      rb4 = *(const u32x4*)(gb2 + (size_t)128 * ldb);
      rb5 = *(const u32x4*)(gb2 + (size_t)160 * ldb);
      rb6 = *(const u32x4*)(gb2 + (size_t)192 * ldb);
      rb7 = *(const u32x4*)(gb2 + (size_t)224 * ldb);
    }
#pragma unroll
    for (int kk = 0; kk < 64; kk += 32) {
      bf16x8 a[4];
#pragma unroll
      for (int mi = 0; mi < 4; ++mi) a[mi] = *(const bf16x8*)(fa + mi * 16 * 72 + kk);
#pragma unroll
      for (int nh = 0; nh < 2; ++nh) {
        bf16x8 b[4];
#pragma unroll
        for (int ni = 0; ni < 4; ++ni) b[ni] = *(const bf16x8*)(fb + (nh * 4 + ni) * 16 * 72 + kk);
#pragma unroll
        for (int mi = 0; mi < 4; ++mi)
#pragma unroll
          for (int ni = 0; ni < 4; ++ni)
            acc[mi][nh * 4 + ni] = __builtin_amdgcn_mfma_f32_16x16x32_bf16(b[ni], a[mi], acc[mi][nh * 4 + ni], 0, 0, 0);
      }
    }
  }
}
DEV void dual_tile256(const u16* A, const u16* Wt, int mt, int nt, u16* out, u16* sA, u16* sB) {
  f32x4 acc[4][8];
#pragma unroll
  for (int i = 0; i < 4; ++i)
#pragma unroll
    for (int j = 0; j < 8; ++j) acc[i][j] = (f32x4){0.f, 0.f, 0.f, 0.f};
  gemm_acc256(A + (size_t)mt * 128 * 1024, 1024, Wt + (size_t)nt * 256 * 1024, 1024, 1024, acc, sA, sB);
  const int tid0 = tid_(); const int lane = tid0 & 63, w = tid0 >> 6, wm = w >> 1, wn = w & 1;
#pragma unroll
  for (int mi = 0; mi < 4; ++mi) {
    const int row = mt * 128 + wm * 64 + mi * 16 + (lane & 15);
#pragma unroll
    for (int np = 0; np < 4; ++np) {
      const int col = (nt * 2 + wn) * 64 + np * 16 + (lane >> 4) * 4;
      const f32x4 g = acc[mi][2 * np], u = acc[mi][2 * np + 1];
      uint2 o; o.x = pack2(siluf_(g[0]) * u[0], siluf_(g[1]) * u[1]); o.y = pack2(siluf_(g[2]) * u[2], siluf_(g[3]) * u[3]);
      *(uint2*)(out + (size_t)row * 2816 + col) = o;
    }
  }
}
DEV void zm_tile256(const u16* A, const u16* Wt, int mt, int nt, u16* Zm, u16* sA, u16* sB) {
  f32x4 acc[4][8];
#pragma unroll
  for (int i = 0; i < 4; ++i)
#pragma unroll
    for (int j = 0; j < 8; ++j) acc[i][j] = (f32x4){0.f, 0.f, 0.f, 0.f};
  gemm_acc256(A + (size_t)mt * 128 * 1024, 1024, Wt + (size_t)nt * 256 * 1024, 1024, 1024, acc, sA, sB);
  const int tid0 = tid_(); const int lane = tid0 & 63, w = tid0 >> 6, wm = w >> 1, wn = w & 1;
#pragma unroll
  for (int mi = 0; mi < 4; ++mi) {
    const int row = mt * 128 + wm * 64 + mi * 16 + (lane & 15);
#pragma unroll
    for (int ni = 0; ni < 8; ++ni) {
      const int col = nt * 256 + wn * 128 + ni * 16 + (lane >> 4) * 4;
      uint2 o; o.x = pack2(acc[mi][ni][0], acc[mi][ni][1]); o.y = pack2(acc[mi][ni][2], acc[mi][ni][3]);
      *(uint2*)(Zm + (size_t)row * ZW + col) = o;
    }
  }
}
DEV void g4_tile(const P& p, int mt, int nt, u16* sA, u16* sB) {
  const u16* BR = (const u16*)(p.ws + OFF_D + D_BR);
  const u16* XN = (const u16*)(p.ws + OFF_XN);
  const u16* Wb = (const u16*)(p.ws + OFF_W) + W_BR;
  const u16* Wg = (const u16*)(p.ws + OFF_W) + W_ING;
  u16* M = (u16*)(p.ws + OFF_D + D_M);
  f32x4 accM[4][2];
#pragma unroll
  for (int i = 0; i < 4; ++i)
#pragma unroll
    for (int j = 0; j < 2; ++j) accM[i][j] = (f32x4){0.f, 0.f, 0.f, 0.f};
#pragma unroll 1
  for (int n = 0; n < 4; ++n) {
    unsigned gate[4][2][2];
    {
      f32x4 accG[4][2];
#pragma unroll
      for (int i = 0; i < 4; ++i)
#pragma unroll
        for (int j = 0; j < 2; ++j) accG[i][j] = (f32x4){0.f, 0.f, 0.f, 0.f};
      gemm_acc<64>(XN + (size_t)mt * 128 * 1024, 1024, Wg + ((size_t)n * 1024 + nt * 64) * 1024, 1024, 1024, accG, sA, sB);
#pragma unroll
      for (int i = 0; i < 4; ++i)
#pragma unroll
        for (int j = 0; j < 2; ++j) {
          gate[i][j][0] = pack2(sigm(accG[i][j][0]), sigm(accG[i][j][1]));
          gate[i][j][1] = pack2(sigm(accG[i][j][2]), sigm(accG[i][j][3]));
        }
    }
    f32x4 accP[4][2];
#pragma unroll
    for (int i = 0; i < 4; ++i)
#pragma unroll
      for (int j = 0; j < 2; ++j) accP[i][j] = (f32x4){0.f, 0.f, 0.f, 0.f};
    gemm_acc<64>(BR + (size_t)mt * 128 * 1024 + n * 256, 1024, Wb + ((size_t)n * 1024 + nt * 64) * 256, 256, 256, accP, sA, sB);
#pragma unroll
    for (int i = 0; i < 4; ++i)
#pragma unroll
      for (int j = 0; j < 2; ++j) {
        accM[i][j][0] += bflo(gate[i][j][0]) * accP[i][j][0];
        accM[i][j][1] += bfhi(gate[i][j][0]) * accP[i][j][1];
        accM[i][j][2] += bflo(gate[i][j][1]) * accP[i][j][2];
        accM[i][j][3] += bfhi(gate[i][j][1]) * accP[i][j][3];
      }
  }
  const int tid0 = tid_(); const int lane = tid0 & 63, w = tid0 >> 6, wm = w >> 1, wn = w & 1;
#pragma unroll
  for (int mi = 0; mi < 4; ++mi) {
    const int row = mt * 128 + wm * 64 + mi * 16 + (lane & 15);
#pragma unroll
    for (int ni = 0; ni < 2; ++ni) {
      const int col = nt * 64 + wn * 32 + ni * 16 + (lane >> 4) * 4;
      uint2 o; o.x = pack2(accM[mi][ni][0], accM[mi][ni][1]); o.y = pack2(accM[mi][ni][2], accM[mi][ni][3]);
      *(uint2*)(M + (size_t)row * 1024 + col) = o;
    }
  }
}

DEV void dn_conv16(const u16* __restrict__ Zm, const float* __restrict__ buf, const float* __restrict__ cw, int rowbase, int t, int c,
                   float (&o)[16]) {
#pragma unroll
  for (int e = 0; e < 16; ++e) o[e] = 0.f;
#pragma unroll
  for (int tap = 0; tap < 4; ++tap) {
    const int tau = t - 3 + tap;
    float x[16];
    if (tau >= 0) {
      const uint4* z = (const uint4*)(Zm + (size_t)(rowbase + tau) * ZW + c);
      unpack16(z[0], z[1], x);
    } else if (buf) {
      const float4* bb = (const float4*)(buf + (3 + tau) * 768 + c);
#pragma unroll
      for (int q = 0; q < 4; ++q) { float4 f = bb[q]; x[q * 4] = f.x; x[q * 4 + 1] = f.y; x[q * 4 + 2] = f.z; x[q * 4 + 3] = f.w; }
    } else {
#pragma unroll
      for (int e = 0; e < 16; ++e) x[e] = 0.f;
    }
    const float4* w4 = (const float4*)(cw + tap * 768 + c);
#pragma unroll
    for (int q = 0; q < 4; ++q) {
      float4 f = w4[q];
      o[q * 4] += f.x * x[q * 4]; o[q * 4 + 1] += f.y * x[q * 4 + 1]; o[q * 4 + 2] += f.z * x[q * 4 + 2]; o[q * 4 + 3] += f.w * x[q * 4 + 3];
    }
  }
#pragma unroll
  for (int e = 0; e < 16; ++e) o[e] = siluf_(o[e]);
}

DEV void delta_pre(const P& p, int l, int idx, float* smem) {
  float* sq = smem;
  float* sk = smem + 64 * 68;
  float* sL = smem + 2 * 64 * 68;
  float* sbeta = sL + 4096;
  float* sg = sbeta + 64;
  float* sgc = sg + 64;
  int s, h, j, pad, T;
  if (idx < 1056) { s = idx / 132; int r = idx - s * 132; h = r / 33; j = r - h * 33; pad = 48; T = TP; }
  else { int r = idx - 1056; s = 8 + (r >> 2); h = r & 3; j = 0; pad = 56; T = 8; }
  const int tid = tid_();
  const u16* Zm = (const u16*)(p.ws + OFF_D + D_ZM);
  const float* BA = (const float*)(p.ws + OFF_BA);
  const float* cw = p.in[15] + l * 4 * 768;
  const float* buf = (s >= 8) ? p.in[3] + (size_t)(l * 128 + (s - 8)) * 3 * 768 : nullptr;
  const int rowbase = rowbase_of(s);
  u16* wsb = (u16*)p.out + (size_t)idx * 20480;
  float* gamma = (float*)(p.ws + OFF_GAMMA);
  {
    const int i = tid >> 2, dq = (tid & 3) * 16;
    const int t = j * 64 + i - pad;
    float qv[16], kv[16];
    float sq_ = 0.f, sk_ = 0.f;
    if (t >= 0) {
      dn_conv16(Zm, buf, cw, rowbase, t, h * 64 + dq, qv);
      dn_conv16(Zm, buf, cw, rowbase, t, 256 + h * 64 + dq, kv);
#pragma unroll
      for (int e = 0; e < 16; ++e) { sq_ += qv[e] * qv[e]; sk_ += kv[e] * kv[e]; }
    } else {
#pragma unroll
      for (int e = 0; e < 16; ++e) { qv[e] = 0.f; kv[e] = 0.f; }
    }
    sq_ += __shfl_xor(sq_, 1, 64); sq_ += __shfl_xor(sq_, 2, 64);
    sk_ += __shfl_xor(sk_, 1, 64); sk_ += __shfl_xor(sk_, 2, 64);
    const float qs = rsqrtf(sq_ + 1e-6f) * 0.125f, ks = rsqrtf(sk_ + 1e-6f);
#pragma unroll
    for (int e = 0; e < 16; ++e) { sq[i * 68 + dq + e] = qv[e] * qs; sk[i * 68 + dq + e] = kv[e] * ks; }
  }
  if (tid < 64) {
    const int t = j * 64 + tid - pad;
    float be = 0.f, g = 0.f;
    if (t >= 0) {
      const float* ba = BA + (size_t)(rowbase + t) * 8;
      be = sigm(ba[h]);
      float a = ba[4 + h] + p.in[17][l * 4 + h];
      g = -expf(p.in[16][l * 4 + h]) * softplusf_(a);
    }
    sbeta[tid] = be;
    sg[tid] = g;
  }
  __syncthreads();
  if (tid < 64) {
    float c = 0.f;
    for (int i2 = 0; i2 <= tid; ++i2) c += sg[i2];
    sgc[tid] = c;
  }
  __syncthreads();
  {
    const int ti = tid >> 4, tj = tid & 15;
    float aL[4][4], aI[4][4];
#pragma unroll
    for (int a = 0; a < 4; ++a)
#pragma unroll
      for (int b = 0; b < 4; ++b) { aL[a][b] = 0.f; aI[a][b] = 0.f; }
    for (int d = 0; d < 64; d += 4) {
      float4 qa[4], ka[4], kb[4];
#pragma unroll
      for (int a = 0; a < 4; ++a) { qa[a] = *(const float4*)&sq[(ti + 16 * a) * 68 + d]; ka[a] = *(const float4*)&sk[(ti + 16 * a) * 68 + d]; }
#pragma unroll
      for (int b = 0; b < 4; ++b) kb[b] = *(const float4*)&sk[(tj + 16 * b) * 68 + d];
#pragma unroll
      for (int a = 0; a < 4; ++a)
#pragma unroll
        for (int b = 0; b < 4; ++b) {
          aL[a][b] += ka[a].x * kb[b].x + ka[a].y * kb[b].y + ka[a].z * kb[b].z + ka[a].w * kb[b].w;
          aI[a][b] += qa[a].x * kb[b].x + qa[a].y * kb[b].y + qa[a].z * kb[b].z + qa[a].w * kb[b].w;
        }
    }
#pragma unroll
    for (int a = 0; a < 4; ++a)
#pragma unroll
      for (int b = 0; b < 4; ++b) {
        const int i = ti + 16 * a, jj = tj + 16 * b;
        const float dec = (jj <= i) ? __expf(sgc[i] - sgc[jj]) : 0.f;
        sL[i * 64 + jj] = (jj < i) ? aL[a][b] * sbeta[i] * dec : 0.f;
        wsb[3 * 4096 + i * 64 + jj] = f2bf(aI[a][b] * dec);
      }
  }
  for (int e = tid; e < 4096; e += 256) {
    const int i = e >> 6, d = e & 63;
    wsb[2 * 4096 + e] = f2bf(sq[i * 68 + d] * __expf(sgc[i]));
  }
  for (int e = tid; e < 4096; e += 256) {
    const int d = e >> 6, i = e & 63;
    wsb[4 * 4096 + e] = f2bf(sk[i * 68 + d] * __expf(sgc[63] - sgc[i]));
  }
  if (tid == 0) gamma[idx] = __expf(sgc[63]);
  __syncthreads();
  {
    const int i = tid >> 2, dq = (tid & 3) * 16;
    const int t = j * 64 + i - pad;
    float vv[16];
    if (t >= 0) dn_conv16(Zm, buf, cw, rowbase, t, 512 + h * 64 + dq, vv);
    else {
#pragma unroll
      for (int e = 0; e < 16; ++e) vv[e] = 0.f;
    }
    const float be = sbeta[i], eg = be * __expf(sgc[i]);
#pragma unroll
    for (int e = 0; e < 16; ++e) { sq[i * 68 + dq + e] = vv[e] * be; sk[i * 68 + dq + e] *= eg; }
  }
  __syncthreads();
  {
    float* arr = (tid < 128) ? sq : sk;
    const int col = (tid >> 1) & 63, hf = tid & 1;
    for (int i = 1; i < 64; ++i) {
      float acc = 0.f;
      for (int j0 = hf * 4; j0 < i; j0 += 8) {
        const float4 l4 = *(const float4*)&sL[i * 64 + j0];
        acc -= l4.x * arr[j0 * 68 + col] + l4.y * arr[(j0 + 1) * 68 + col] + l4.z * arr[(j0 + 2) * 68 + col] + l4.w * arr[(j0 + 3) * 68 + col];
      }
      acc += __shfl_xor(acc, 1, 64);
      if (hf == 0) arr[i * 68 + col] += acc;
    }
  }
  __syncthreads();
  for (int e = tid; e < 4096; e += 256) {
    const int i = e >> 6, d = e & 63;
    wsb[e] = f2bf(sq[i * 68 + d]);
    wsb[4096 + e] = f2bf(sk[i * 68 + d]);
  }
  if (h == 0 && j == (s < 8 ? 32 : 0)) {
    float* o = st_out(p, O_PDCONV, O_SDCONV, l, s, 3 * 768);
    for (int e = tid; e < 3 * 768; e += 256) {
      const int r = e / 768, c = e - r * 768;
      o[e] = bf2f(Zm[(size_t)(rowbase + T - 3 + r) * ZW + c]);
    }
  }
}

DEV void mm64(const float* __restrict__ A, const float* __restrict__ B, float (&acc)[4][4], int ti, int tj) {
#pragma unroll 4
  for (int kk = 0; kk < 64; kk += 4) {
    float4 a[4], b[4];
#pragma unroll
    for (int x = 0; x < 4; ++x) a[x] = *(const float4*)&A[(ti + 16 * x) * 68 + kk];
#pragma unroll
    for (int y = 0; y < 4; ++y) b[y] = *(const float4*)&B[(kk + y) * 64 + tj * 4];
#pragma unroll
    for (int x = 0; x < 4; ++x) {
      acc[x][0] += a[x].x * b[0].x + a[x].y * b[1].x + a[x].z * b[2].x + a[x].w * b[3].x;
      acc[x][1] += a[x].x * b[0].y + a[x].y * b[1].y + a[x].z * b[2].y + a[x].w * b[3].y;
      acc[x][2] += a[x].x * b[0].z + a[x].y * b[1].z + a[x].z * b[2].z + a[x].w * b[3].z;
      acc[x][3] += a[x].x * b[0].w + a[x].y * b[1].w + a[x].z * b[2].w + a[x].w * b[3].w;
    }
  }
}
DEV void storeA16(float* sA, uint4 r0, uint4 r1) {
  const int tid = tid_();
  float x[16];
  unpack16(r0, r1, x);
  float* d = sA + (tid >> 2) * 68 + (tid & 3) * 16;
#pragma unroll
  for (int q = 0; q < 4; ++q) *(float4*)(d + q * 4) = make_float4(x[q * 4], x[q * 4 + 1], x[q * 4 + 2], x[q * 4 + 3]);
}

DEV void mm64h(const u16* __restrict__ A, const float* __restrict__ B, float (&acc)[4][4], int ti, int tj) {
#pragma unroll 4
  for (int kk = 0; kk < 64; kk += 4) {
    float4 a[4], b[4];
#pragma unroll
    for (int x = 0; x < 4; ++x) {
      const uint2 av = *(const uint2*)&A[(ti + 16 * x) * 72 + kk];
      a[x] = make_float4(bflo(av.x), bfhi(av.x), bflo(av.y), bfhi(av.y));
    }
#pragma unroll
    for (int y = 0; y < 4; ++y) b[y] = *(const float4*)&B[(kk + y) * 64 + tj * 4];
#pragma unroll
    for (int x = 0; x < 4; ++x) {
      acc[x][0] += a[x].x * b[0].x + a[x].y * b[1].x + a[x].z * b[2].x + a[x].w * b[3].x;
      acc[x][1] += a[x].x * b[0].y + a[x].y * b[1].y + a[x].z * b[2].y + a[x].w * b[3].y;
      acc[x][2] += a[x].x * b[0].z + a[x].y * b[1].z + a[x].z * b[2].z + a[x].w * b[3].z;
      acc[x][3] += a[x].x * b[0].w + a[x].y * b[1].w + a[x].z * b[2].w + a[x].w * b[3].w;
    }
  }
}
DEV void store16h(u16* sA, uint4 r0, uint4 r1) {
  const int tid = tid_();
  uint4* d = (uint4*)(sA + (tid >> 2) * 72 + (tid & 3) * 16);
  d[0] = r0; d[1] = r1;
}

DEV void delta_seq(const P& p, int l, int s, int h, float* smem) {
  float* sS = smem;
  float* sV = smem + 4096;
  u16* sA0 = (u16*)(smem + 8192);
  u16* sA1 = sA0 + 64 * 72;
  u16* sA2 = sA1 + 64 * 72;
  const int tid = tid_(), ti = tid >> 4, tj = tid & 15;
  const int n = (s < 8) ? 33 : 1, pad = (s < 8) ? 48 : 56;
  const int item0 = (s < 8) ? (s * 4 + h) * 33 : 1056 + (s - 8) * 4 + h;
  const int rowbase = rowbase_of(s);
  const float* s0 = (s >= 8) ? p.in[2] + (size_t)((l * 128 + (s - 8)) * 4 + h) * 4096 : nullptr;
  for (int e = tid; e < 4096; e += 256) sS[e] = s0 ? s0[e] : 0.f;
  const u16* wsb = (const u16*)p.out + (size_t)item0 * 20480;
  const float* gamma = (const float*)(p.ws + OFF_GAMMA) + item0;
  const u16* Zm = (const u16*)(p.ws + OFF_D + D_ZM);
  u16* BR = (u16*)(p.ws + OFF_D + D_BR);
  const float4 ng = *(const float4*)(p.in[18] + l * 64 + tj * 4);
  uint4 rw0, rw1, rq0, rq1, ri0, ri1, rk0, rk1;
  {
    const uint4* src = (const uint4*)(wsb + tid * 16);
    rw0 = src[512]; rw1 = src[513];
    rq0 = src[1024]; rq1 = src[1025];
    ri0 = src[1536]; ri1 = src[1537];
    rk0 = src[2048]; rk1 = src[2049];
  }
  for (int j = 0; j < n; ++j) {
    const u16* it = wsb + (size_t)j * 20480;
    uint2 uu_pf[4], zz_pf[4];
#pragma unroll
    for (int a = 0; a < 4; ++a) {
      const int i = ti + 16 * a;
      uu_pf[a] = *(const uint2*)(it + i * 64 + tj * 4);
      const int t = j * 64 + i - pad;
      zz_pf[a] = (t >= 0) ? *(const uint2*)(Zm + (size_t)(rowbase + t) * ZW + 768 + h * 64 + tj * 4) : make_uint2(0u, 0u);
    }
    const float gm = gamma[j];
    __syncthreads();
    store16h(sA0, rw0, rw1); store16h(sA1, rq0, rq1); store16h(sA2, ri0, ri1);
    __syncthreads();
    if (j + 1 < n) {
      const uint4* src = (const uint4*)(it + 20480 + tid * 16);
      rw0 = src[512]; rw1 = src[513]; rq0 = src[1024]; rq1 = src[1025]; ri0 = src[1536]; ri1 = src[1537];
    }
    float acc[4][4];
#pragma unroll
    for (int a = 0; a < 4; ++a)
#pragma unroll
      for (int c = 0; c < 4; ++c) acc[a][c] = 0.f;
    mm64h(sA0, sS, acc, ti, tj);
#pragma unroll
    for (int a = 0; a < 4; ++a) {
      const int i = ti + 16 * a;
      const uint2 uu = uu_pf[a];
      *(float4*)&sV[i * 64 + tj * 4] = make_float4(bflo(uu.x) - acc[a][0], bfhi(uu.x) - acc[a][1], bflo(uu.y) - acc[a][2], bfhi(uu.y) - acc[a][3]);
    }
    __syncthreads();
    store16h(sA0, rk0, rk1);
    if (j + 1 < n) { const uint4* src = (const uint4*)(it + 20480 + tid * 16); rk0 = src[2048]; rk1 = src[2049]; }
    float o[4][4];
#pragma unroll
    for (int a = 0; a < 4; ++a)
#pragma unroll
      for (int c = 0; c < 4; ++c) o[a][c] = 0.f;
    mm64h(sA1, sS, o, ti, tj);
    mm64h(sA2, sV, o, ti, tj);
#pragma unroll
    for (int a = 0; a < 4; ++a) {
      const int i = ti + 16 * a;
      const int t = j * 64 + i - pad;
      float ss = o[a][0] * o[a][0] + o[a][1] * o[a][1] + o[a][2] * o[a][2] + o[a][3] * o[a][3];
      ss += __shfl_xor(ss, 1, 64); ss += __shfl_xor(ss, 2, 64); ss += __shfl_xor(ss, 4, 64); ss += __shfl_xor(ss, 8, 64);
      if (t >= 0) {
        const float inv = rsqrtf(ss * (1.f / 64.f) + 1e-6f);
        const size_t row = (size_t)(rowbase + t);
        const uint2 zz = zz_pf[a];
        float y0 = o[a][0] * inv * ng.x * siluf_(bflo(zz.x));
        float y1 = o[a][1] * inv * ng.y * siluf_(bfhi(zz.x));
        float y2 = o[a][2] * inv * ng.z * siluf_(bflo(zz.y));
        float y3 = o[a][3] * inv * ng.w * siluf_(bfhi(zz.y));
        uint2 ov; ov.x = pack2(y0, y1); ov.y = pack2(y2, y3);
        *(uint2*)(BR + row * 1024 + h * 64 + tj * 4) = ov;
      }
    }
    __syncthreads();
#pragma unroll
    for (int a = 0; a < 4; ++a)
#pragma unroll
      for (int c = 0; c < 4; ++c) acc[a][c] = 0.f;
    mm64h(sA0, sV, acc, ti, tj);
#pragma unroll
    for (int a = 0; a < 4; ++a) {
      float4* sp = (float4*)&sS[(ti + 16 * a) * 64 + tj * 4];
      float4 old = *sp;
      *sp = make_float4(gm * old.x + acc[a][0], gm * old.y + acc[a][1], gm * old.z + acc[a][2], gm * old.w + acc[a][3]);
    }
  }
  __syncthreads();
  float* so = st_out(p, O_PDELTA, O_SDELTA, l, s, 4 * 4096) + h * 4096;
  for (int e = tid; e < 4096; e += 256) so[e] = sS[e];
}

DEV void s5_block(const P& p, int l, int s, int gq, float* smem) {
  const int tid = tid_(), lane = tid & 63;
  const int w = __builtin_amdgcn_readfirstlane(tid >> 6);
  const int g = gq * 4 + w;
  float* sC = smem + w * 3248;
  float* sH = sC + 2080;
  float* sU = sH + 1040;
  const int T = (s < 8) ? TP : 8;
  const int rowbase = rowbase_of(s);
  const u16* Zm = (const u16*)(p.ws + OFF_D + D_ZM);
  u16* Y5 = (u16*)(p.ws + OFF_D + D_Y5);
  const int lg_ = l * 16 + g;
  const float lr = p.in[19][lg_ * 64 + lane], li = p.in[20][lg_ * 64 + lane];
  const float dt = expf(p.in[21][lg_]);
  const float mag = expf(lr * dt);
  const float lbr = mag * cosf(li * dt), lbi = mag * sinf(li * dt);
  const float den = lr * lr + li * li;
  const float cfr = ((lbr - 1.f) * lr + lbi * li) / den, cfi = (lbi * lr - (lbr - 1.f) * li) / den;
  float xr_c[16], xi_c[16];
  {
    const float4* br4 = (const float4*)(p.in[22] + ((size_t)lg_ * 64 + lane) * 16);
    const float4* bi4 = (const float4*)(p.in[23] + ((size_t)lg_ * 64 + lane) * 16);
#pragma unroll
    for (int q = 0; q < 4; ++q) {
      float4 a = br4[q], b = bi4[q];
      xr_c[q * 4] = cfr * a.x - cfi * b.x; xi_c[q * 4] = cfr * b.x + cfi * a.x;
      xr_c[q * 4 + 1] = cfr * a.y - cfi * b.y; xi_c[q * 4 + 1] = cfr * b.y + cfi * a.y;
      xr_c[q * 4 + 2] = cfr * a.z - cfi * b.z; xi_c[q * 4 + 2] = cfr * b.z + cfi * a.z;
      xr_c[q * 4 + 3] = cfr * a.w - cfi * b.w; xi_c[q * 4 + 3] = cfr * b.w + cfi * a.w;
    }
  }
  for (int e = lane; e < 1024; e += 64) {
    const int c = e >> 6, pp = e & 63;
    sC[(c * 65 + pp) * 2] = p.in[24][(size_t)lg_ * 1024 + e];
    sC[(c * 65 + pp) * 2 + 1] = p.in[25][(size_t)lg_ * 1024 + e];
  }
  float hr = 0.f, hi = 0.f;
  if (s >= 8) {
    hr = p.in[4][((size_t)(l * 128 + (s - 8)) * 16 + g) * 64 + lane];
    hi = p.in[5][((size_t)(l * 128 + (s - 8)) * 16 + g) * 64 + lane];
  }
  const int ytt = lane >> 3, cp = (lane & 7) * 2;
  const float d0 = p.in[26][l * 256 + g * 16 + cp], d1 = p.in[26][l * 256 + g * 16 + cp + 1];
  const u16* ubase = Zm + (size_t)rowbase * ZW + 1024 + g * 16 + (size_t)(lane >> 1) * ZW + (lane & 1) * 8;
  uint4 pu = make_uint4(0u, 0u, 0u, 0u);
  if (lane < 16) pu = *(const uint4*)(ubase);
  if (lane < 16) {
    float* d = sU + (lane >> 1) * 16 + (lane & 1) * 8;
    *(float4*)(d) = make_float4(bflo(pu.x), bfhi(pu.x), bflo(pu.y), bfhi(pu.y));
    *(float4*)(d + 4) = make_float4(bflo(pu.z), bfhi(pu.z), bflo(pu.w), bfhi(pu.w));
  }
  for (int t0 = 0; t0 < T; t0 += 8) {
    __syncthreads();
    if (lane < 16 && t0 + 8 < T) pu = *(const uint4*)(ubase + (size_t)(t0 + 8) * ZW);
#pragma unroll 2
    for (int tt = 0; tt < 8; ++tt) {
      const float4 u0 = *(const float4*)(sU + tt * 16), u1 = *(const float4*)(sU + tt * 16 + 4), u2 = *(const float4*)(sU + tt * 16 + 8),
                   u3 = *(const float4*)(sU + tt * 16 + 12);
      const float u[16] = {u0.x, u0.y, u0.z, u0.w, u1.x, u1.y, u1.z, u1.w, u2.x, u2.y, u2.z, u2.w, u3.x, u3.y, u3.z, u3.w};
      float xr = 0.f, xi = 0.f;
#pragma unroll
      for (int c = 0; c < 16; ++c) { xr += xr_c[c] * u[c]; xi += xi_c[c] * u[c]; }
      const float nr = lbr * hr - lbi * hi + xr;
      const float ni = lbr * hi + lbi * hr + xi;
      hr = nr; hi = ni;
      *(float2*)&sH[(tt * 65 + lane) * 2] = make_float2(hr, hi);
    }
    __syncthreads();
    float y0 = 0.f, y1 = 0.f;
#pragma unroll 8
    for (int pp = 0; pp < 64; ++pp) {
      const float2 hv = *(const float2*)&sH[(ytt * 65 + pp) * 2];
      const float2 c0 = *(const float2*)&sC[(cp * 65 + pp) * 2];
      const float2 c1 = *(const float2*)&sC[((cp + 1) * 65 + pp) * 2];
      y0 += hv.x * c0.x - hv.y * c0.y;
      y1 += hv.x * c1.x - hv.y * c1.y;
    }
    const size_t row = (size_t)(rowbase + t0 + ytt);
    const float2 uy = *(const float2*)(sU + ytt * 16 + cp);
    y0 = geluf_(y0 + d0 * uy.x);
    y1 = geluf_(y1 + d1 * uy.y);
    *(unsigned*)(Y5 + row * 256 + g * 16 + cp) = pack2(y0, y1);
    if (lane < 16 && t0 + 8 < T) {
      float* d = sU + (lane >> 1) * 16 + (lane & 1) * 8;
      *(float4*)(d) = make_float4(bflo(pu.x), bfhi(pu.x), bflo(pu.y), bfhi(pu.y));
      *(float4*)(d + 4) = make_float4(bflo(pu.z), bfhi(pu.z), bflo(pu.w), bfhi(pu.w));
    }
  }
  st_out(p, O_PS5RE, O_SS5RE, l, s, 1024)[g * 64 + lane] = hr;
  st_out(p, O_PS5IM, O_SS5IM, l, s, 1024)[g * 64 + lane] = hi;
}


DEV void s5_prompt(const P& p, int l, int s, int g, float* smem) {
  const int tid = tid_(), lane = tid & 63;
  const int w = __builtin_amdgcn_readfirstlane(tid >> 6);
  float* sC = smem;
  float* sE = smem + 2080;
  float* sH = smem + 2080 + 512 + w * 1168;
  float* sU = sH + 1040;
  const int rowbase = rowbase_of(s);
  const int tbeg = w * 512, tend = (w == 3) ? TP : tbeg + 512;
  const u16* Zm = (const u16*)(p.ws + OFF_D + D_ZM);
  u16* Y5 = (u16*)(p.ws + OFF_D + D_Y5);
  const int lg_ = l * 16 + g;
  const float lr = p.in[19][lg_ * 64 + lane], li = p.in[20][lg_ * 64 + lane];
  const float dt = expf(p.in[21][lg_]);
  const float mag = expf(lr * dt);
  const float lbr = mag * cosf(li * dt), lbi = mag * sinf(li * dt);
  const float den = lr * lr + li * li;
  const float cfr = ((lbr - 1.f) * lr + lbi * li) / den, cfi = (lbi * lr - (lbr - 1.f) * li) / den;
  float xr_c[16], xi_c[16];
  {
    const float4* br4 = (const float4*)(p.in[22] + ((size_t)lg_ * 64 + lane) * 16);
    const float4* bi4 = (const float4*)(p.in[23] + ((size_t)lg_ * 64 + lane) * 16);
#pragma unroll
    for (int q = 0; q < 4; ++q) {
      float4 a = br4[q], b = bi4[q];
      xr_c[q * 4] = cfr * a.x - cfi * b.x; xi_c[q * 4] = cfr * b.x + cfi * a.x;
      xr_c[q * 4 + 1] = cfr * a.y - cfi * b.y; xi_c[q * 4 + 1] = cfr * b.y + cfi * a.y;
      xr_c[q * 4 + 2] = cfr * a.z - cfi * b.z; xi_c[q * 4 + 2] = cfr * b.z + cfi * a.z;
      xr_c[q * 4 + 3] = cfr * a.w - cfi * b.w; xi_c[q * 4 + 3] = cfr * b.w + cfi * a.w;
    }
  }
  for (int e = tid; e < 1024; e += 256) {
    const int c = e >> 6, pp = e & 63;
    sC[(c * 65 + pp) * 2] = p.in[24][(size_t)lg_ * 1024 + e];
    sC[(c * 65 + pp) * 2 + 1] = p.in[25][(size_t)lg_ * 1024 + e];
  }
  const u16* ubase = Zm + (size_t)rowbase * ZW + 1024 + g * 16 + (size_t)(lane >> 1) * ZW + (lane & 1) * 8;
  float hr = 0.f, hi = 0.f;
  if (w < 3) {
    uint4 pu = make_uint4(0u, 0u, 0u, 0u);
    if (lane < 16) pu = *(const uint4*)(ubase + (size_t)tbeg * ZW);
    for (int t0 = tbeg; t0 < tend; t0 += 8) {
      if (lane < 16) {
        float* d = sU + (lane >> 1) * 16 + (lane & 1) * 8;
        *(float4*)(d) = make_float4(bflo(pu.x), bfhi(pu.x), bflo(pu.y), bfhi(pu.y));
        *(float4*)(d + 4) = make_float4(bflo(pu.z), bfhi(pu.z), bflo(pu.w), bfhi(pu.w));
      }
      if (lane < 16 && t0 + 8 < tend) pu = *(const uint4*)(ubase + (size_t)(t0 + 8) * ZW);
      __builtin_amdgcn_wave_barrier();
#pragma unroll 2
      for (int tt = 0; tt < 8; ++tt) {
        const float4 u0 = *(const float4*)(sU + tt * 16), u1 = *(const float4*)(sU + tt * 16 + 4), u2 = *(const float4*)(sU + tt * 16 + 8),
                     u3 = *(const float4*)(sU + tt * 16 + 12);
        const float u[16] = {u0.x, u0.y, u0.z, u0.w, u1.x, u1.y, u1.z, u1.w, u2.x, u2.y, u2.z, u2.w, u3.x, u3.y, u3.z, u3.w};
        float xr = 0.f, xi = 0.f;
#pragma unroll
        for (int c = 0; c < 16; ++c) { xr += xr_c[c] * u[c]; xi += xi_c[c] * u[c]; }
        const float nr = lbr * hr - lbi * hi + xr;
        const float ni = lbr * hi + lbi * hr + xi;
        hr = nr; hi = ni;
      }
      __builtin_amdgcn_wave_barrier();
    }
    *(float2*)&sE[(w * 64 + lane) * 2] = make_float2(hr, hi);
  }
  __syncthreads();
  {
    const float m512 = expf(lr * dt * 512.f);
    const float pr = m512 * cosf(li * dt * 512.f), pi = m512 * sinf(li * dt * 512.f);
    float Hr = 0.f, Hi = 0.f;
    for (int k = 0; k < w; ++k) {
      const float2 e = *(const float2*)&sE[(k * 64 + lane) * 2];
      const float nr = pr * Hr - pi * Hi + e.x, ni = pr * Hi + pi * Hr + e.y;
      Hr = nr; Hi = ni;
    }
    hr = Hr; hi = Hi;
  }
  const int ytt = lane >> 3, cp = (lane & 7) * 2;
  const float d0 = p.in[26][l * 256 + g * 16 + cp], d1 = p.in[26][l * 256 + g * 16 + cp + 1];
  {
    uint4 pu = make_uint4(0u, 0u, 0u, 0u);
    if (lane < 16) pu = *(const uint4*)(ubase + (size_t)tbeg * ZW);
    for (int t0 = tbeg; t0 < tend; t0 += 8) {
      if (lane < 16) {
        float* d = sU + (lane >> 1) * 16 + (lane & 1) * 8;
        *(float4*)(d) = make_float4(bflo(pu.x), bfhi(pu.x), bflo(pu.y), bfhi(pu.y));
        *(float4*)(d + 4) = make_float4(bflo(pu.z), bfhi(pu.z), bflo(pu.w), bfhi(pu.w));
      }
      if (lane < 16 && t0 + 8 < tend) pu = *(const uint4*)(ubase + (size_t)(t0 + 8) * ZW);
      __builtin_amdgcn_wave_barrier();
#pragma unroll 2
      for (int tt = 0; tt < 8; ++tt) {
        const float4 u0 = *(const float4*)(sU + tt * 16), u1 = *(const float4*)(sU + tt * 16 + 4), u2 = *(const float4*)(sU + tt * 16 + 8),
                     u3 = *(const float4*)(sU + tt * 16 + 12);
        const float u[16] = {u0.x, u0.y, u0.z, u0.w, u1.x, u1.y, u1.z, u1.w, u2.x, u2.y, u2.z, u2.w, u3.x, u3.y, u3.z, u3.w};
        float xr = 0.f, xi = 0.f;
#pragma unroll
        for (int c = 0; c < 16; ++c) { xr += xr_c[c] * u[c]; xi += xi_c[c] * u[c]; }
        const float nr = lbr * hr - lbi * hi + xr;
        const float ni = lbr * hi + lbi * hr + xi;
        hr = nr; hi = ni;
        *(float2*)&sH[(tt * 65 + lane) * 2] = make_float2(hr, hi);
      }
      __builtin_amdgcn_wave_barrier();
      float y0 = 0.f, y1 = 0.f;
#pragma unroll 8
      for (int pp = 0; pp < 64; ++pp) {
        const float2 hv = *(const float2*)&sH[(ytt * 65 + pp) * 2];
        const float2 c0 = *(const float2*)&sC[(cp * 65 + pp) * 2];
        const float2 c1 = *(const float2*)&sC[((cp + 1) * 65 + pp) * 2];
        y0 += hv.x * c0.x - hv.y * c0.y;
        y1 += hv.x * c1.x - hv.y * c1.y;
      }
      const size_t row = (size_t)(rowbase + t0 + ytt);
      const float2 uy = *(const float2*)(sU + ytt * 16 + cp);
      y0 = geluf_(y0 + d0 * uy.x);
      y1 = geluf_(y1 + d1 * uy.y);
      *(unsigned*)(Y5 + row * 256 + g * 16 + cp) = pack2(y0, y1);
      __builtin_amdgcn_wave_barrier();
    }
  }
  if (w == 3) {
    st_out(p, O_PS5RE, O_SS5RE, l, s, 1024)[g * 64 + lane] = hr;
    st_out(p, O_PS5IM, O_SS5IM, l, s, 1024)[g * 64 + lane] = hi;
  }
}

DEV float lru_xin(const P& p, const u16* Zm, int l, int s, int rowbase, int tau, int c) {
  if (tau >= 0) return bf2f(Zm[(size_t)(rowbase + tau) * ZW + 1280 + c]);
  if (s >= 8) return p.in[7][((size_t)(l * 128 + (s - 8)) * 3 + (3 + tau)) * 256 + c];
  return 0.f;
}
DEV void lru_pass1(const P& p, int l, int s, int t0, float* smem) {
  float* sX = smem;
  const int c = tid_();
  const int T = (s < 8) ? TP : 8;
  const int nT = min(32, T - t0);
  const int rowbase = rowbase_of(s);
  const u16* Zm = (const u16*)(p.ws + OFF_D + D_ZM);
  u16* LA = (u16*)(p.ws + OFF_D + D_LA);
  u16* LB = (u16*)(p.ws + OFF_D + D_LB);
  const float w0 = p.in[29][(l * 4 + 0) * 256 + c], w1 = p.in[29][(l * 4 + 1) * 256 + c], w2 = p.in[29][(l * 4 + 2) * 256 + c],
              w3 = p.in[29][(l * 4 + 3) * 256 + c];
  const float cb = p.in[30][l * 256 + c];
  float xm3 = lru_xin(p, Zm, l, s, rowbase, t0 - 3, c), xm2 = lru_xin(p, Zm, l, s, rowbase, t0 - 2, c),
        xm1 = lru_xin(p, Zm, l, s, rowbase, t0 - 1, c);
  u16 xin[32];
#pragma unroll
  for (int tt = 0; tt < 32; ++tt) xin[tt] = (tt < nT) ? Zm[(size_t)(rowbase + t0 + tt) * ZW + 1280 + c] : (u16)0;
#pragma unroll
  for (int tt = 0; tt < 32; ++tt) {
    const float x0 = bf2f(xin[tt]);
    sX[tt * 256 + c] = (tt < nT) ? (w0 * xm3 + w1 * xm2 + w2 * xm1 + w3 * x0 + cb) : 0.f;
    xm3 = xm2; xm2 = xm1; xm1 = x0;
  }
  __syncthreads();
  const int blk = __builtin_amdgcn_readfirstlane(c >> 6), d = c & 63;
  const float* wa = p.in[31] + (size_t)(l * 4 + blk) * 4096;
  const float* wx = p.in[33] + (size_t)(l * 4 + blk) * 4096;
  const float ba = p.in[32][l * 256 + c], bx = p.in[34][l * 256 + c];
  const float sp = softplusf_(-p.in[35][l * 256 + c]);
  for (int b8 = 0; b8 * 8 < nT; ++b8) {
    float ra[8], ia[8];
#pragma unroll
    for (int tt = 0; tt < 8; ++tt) { ra[tt] = 0.f; ia[tt] = 0.f; }
#pragma unroll 4
    for (int k = 0; k < 64; ++k) {
      const float wav = wa[k * 64 + d], wxv = wx[k * 64 + d];
#pragma unroll
      for (int tt = 0; tt < 8; ++tt) {
        const float xv = sX[(b8 * 8 + tt) * 256 + blk * 64 + k];
        ra[tt] += xv * wav; ia[tt] += xv * wxv;
      }
    }
#pragma unroll
    for (int tt = 0; tt < 8; ++tt) {
      const int t = b8 * 8 + tt;
      if (t < nT) {
        const float r = sigm(ra[tt] + ba), ig = sigm(ia[tt] + bx);
        const float la = -8.f * r * sp;
        const float bb = sqrtf(-expm1f(2.f * la)) * (ig * sX[t * 256 + c]);
        const size_t row = (size_t)(rowbase + t0 + t);
        LA[row * 256 + c] = f2bf(la);
        LB[row * 256 + c] = f2bf(bb);
      }
    }
  }
  if (t0 + nT == T) {
    float* o = st_out(p, O_PLRUC, O_SLRUC, l, s, 3 * 256);
#pragma unroll
    for (int r = 0; r < 3; ++r) o[r * 256 + c] = lru_xin(p, Zm, l, s, rowbase, T - 3 + r, c);
  }
}
DEV void lru_pass2(const P& p, int l, int s) {
  const int c = tid_();
  const int T = (s < 8) ? TP : 8;
  const int rowbase = rowbase_of(s);
  const u16* Zm = (const u16*)(p.ws + OFF_D + D_ZM);
  const u16* LA = (const u16*)(p.ws + OFF_D + D_LA);
  const u16* LB = (const u16*)(p.ws + OFF_D + D_LB);
  u16* BR = (u16*)(p.ws + OFF_D + D_BR);
  float h = (s >= 8) ? p.in[6][(size_t)(l * 128 + (s - 8)) * 256 + c] : 0.f;
  u16 na[8], nb[8], ng[8];
#pragma unroll
  for (int tt = 0; tt < 8; ++tt) {
    const size_t row = (size_t)(rowbase + tt);
    na[tt] = LA[row * 256 + c]; nb[tt] = LB[row * 256 + c]; ng[tt] = Zm[row * ZW + 1536 + c];
  }
  for (int t0 = 0; t0 < T; t0 += 8) {
    float la[8], lb[8], lg[8];
#pragma unroll
    for (int tt = 0; tt < 8; ++tt) { la[tt] = bf2f(na[tt]); lb[tt] = bf2f(nb[tt]); lg[tt] = bf2f(ng[tt]); }
    if (t0 + 8 < T) {
#pragma unroll
      for (int tt = 0; tt < 8; ++tt) {
        const size_t row = (size_t)(rowbase + t0 + 8 + tt);
        na[tt] = LA[row * 256 + c]; nb[tt] = LB[row * 256 + c]; ng[tt] = Zm[row * ZW + 1536 + c];
      }
    }
#pragma unroll
    for (int tt = 0; tt < 8; ++tt) {
      h = __expf(la[tt]) * h + lb[tt];
      BR[(size_t)(rowbase + t0 + tt) * 1024 + 512 + c] = f2bf(h * geluf_(lg[tt]));
    }
  }
  st_out(p, O_PLRU, O_SLRU, l, s, 256)[c] = h;
}


DEV void lru_prompt(const P& p, int l, int s, int cg, float* smem) {
  const int tid = tid_(), lane = tid & 63;
  const int w = __builtin_amdgcn_readfirstlane(tid >> 6);
  const int c = cg * 64 + lane;
  float* sE = smem;
  float* sL = smem + 256;
  const int rowbase = rowbase_of(s);
  const int tbeg = w * 512, tend = (w == 3) ? TP : tbeg + 512;
  const u16* Zm = (const u16*)(p.ws + OFF_D + D_ZM);
  const u16* LA = (const u16*)(p.ws + OFF_D + D_LA);
  const u16* LB = (const u16*)(p.ws + OFF_D + D_LB);
  u16* BR = (u16*)(p.ws + OFF_D + D_BR);
  {
    float h = 0.f, sl = 0.f;
    for (int t0 = tbeg; t0 < tend; t0 += 8) {
      u16 na[8], nb[8];
#pragma unroll
      for (int tt = 0; tt < 8; ++tt) { const size_t row = (size_t)(rowbase + t0 + tt); na[tt] = LA[row * 256 + c]; nb[tt] = LB[row * 256 + c]; }
#pragma unroll
      for (int tt = 0; tt < 8; ++tt) { const float la = bf2f(na[tt]); h = __expf(la) * h + bf2f(nb[tt]); sl += la; }
    }
    sE[w * 64 + lane] = h; sL[w * 64 + lane] = sl;
  }
  __syncthreads();
  float h = 0.f;
  for (int k = 0; k < w; ++k) h = __expf(sL[k * 64 + lane]) * h + sE[k * 64 + lane];
  u16 na[8], nb[8], ng[8];
#pragma unroll
  for (int tt = 0; tt < 8; ++tt) {
    const size_t row = (size_t)(rowbase + tbeg + tt);
    na[tt] = LA[row * 256 + c]; nb[tt] = LB[row * 256 + c]; ng[tt] = Zm[row * ZW + 1536 + c];
  }
  for (int t0 = tbeg; t0 < tend; t0 += 8) {
    float la[8], lb[8], lg[8];
#pragma unroll
    for (int tt = 0; tt < 8; ++tt) { la[tt] = bf2f(na[tt]); lb[tt] = bf2f(nb[tt]); lg[tt] = bf2f(ng[tt]); }
    if (t0 + 8 < tend) {
#pragma unroll
      for (int tt = 0; tt < 8; ++tt) {
        const size_t row = (size_t)(rowbase + t0 + 8 + tt);
        na[tt] = LA[row * 256 + c]; nb[tt] = LB[row * 256 + c]; ng[tt] = Zm[row * ZW + 1536 + c];
      }
    }
#pragma unroll
    for (int tt = 0; tt < 8; ++tt) {
      h = __expf(la[tt]) * h + lb[tt];
      BR[(size_t)(rowbase + t0 + tt) * 1024 + 512 + c] = f2bf(h * geluf_(lg[tt]));
    }
  }
  if (w == 3) st_out(p, O_PLRU, O_SLRU, l, s, 256)[c] = h;
}

DEV void conv_item(const P& p, int l, int s, int t0, float* smem) {
  float* sG = smem;
  const int c = tid_(), lane = c & 63, w = c >> 6;
  const int T = (s < 8) ? TP : 8;
  const int nT = min(32, T - t0);
  const int rowbase = rowbase_of(s);
  const u16* Zm = (const u16*)(p.ws + OFF_D + D_ZM);
  u16* BR = (u16*)(p.ws + OFF_D + D_BR);
#pragma unroll 8
  for (int rr = 0; rr < 30 + nT; ++rr) {
    const int tau = t0 - 30 + rr;
    float gl = 0.f;
    if (tau >= 0) {
      const size_t row = (size_t)(rowbase + tau);
      gl = bf2f(Zm[row * ZW + 1792 + c]) * sigm(bf2f(Zm[row * ZW + 2048 + c]));
    } else if (s >= 8) gl = p.in[8][((size_t)(l * 128 + (s - 8)) * 30 + (30 + tau)) * 256 + c];
    sG[rr * 256 + c] = gl;
  }
  if (t0 + nT == T) {
    float* o = st_out(p, O_PCONV, O_SCONV, l, s, 30 * 256);
    for (int r = 0; r < 30; ++r) o[r * 256 + c] = sG[(nT + r) * 256 + c];
  }
  float wv[31];
#pragma unroll
  for (int j = 0; j < 31; ++j) wv[j] = p.in[36][(size_t)(l * 31 + j) * 256 + c];
  const float cb = p.in[37][l * 256 + c];
  for (int tt = 0; tt < nT; ++tt) {
    float y = cb;
#pragma unroll
    for (int j = 0; j < 31; ++j) y += wv[j] * sG[(tt + j) * 256 + c];
    sG[tt * 256 + c] = y;
  }
  __syncthreads();
  const float4 lg4 = *(const float4*)(p.in[38] + l * 256 + lane * 4);
  const float4 lb4 = *(const float4*)(p.in[39] + l * 256 + lane * 4);
  for (int tt = w; tt < nT; tt += 4) {
    const float4 v = *(const float4*)&sG[tt * 256 + lane * 4];
    float s1 = v.x + v.y + v.z + v.w;
    s1 = wave_sum(s1);
    const float mean = s1 * (1.f / 256.f);
    const float a0 = v.x - mean, a1 = v.y - mean, a2 = v.z - mean, a3 = v.w - mean;
    float s2 = a0 * a0 + a1 * a1 + a2 * a2 + a3 * a3;
    s2 = wave_sum(s2);
    const float rstd = rsqrtf(s2 * (1.f / 256.f) + 1e-6f);
    uint2 ov;
    ov.x = pack2(siluf_(a0 * rstd * lg4.x + lb4.x), siluf_(a1 * rstd * lg4.y + lb4.y));
    ov.y = pack2(siluf_(a2 * rstd * lg4.z + lb4.z), siluf_(a3 * rstd * lg4.w + lb4.w));
    *(uint2*)(BR + (size_t)(rowbase + t0 + tt) * 1024 + 768 + lane * 4) = ov;
  }
}


DEV bool tile_of(int t, int G, int N, int NT, int& mt, int& nt) {
  const int r = t / G, b = t - r * G;
  const int q = r * G + (b & 7) * (G >> 3) + (b >> 3);
  if (q >= N) return false;
  const int P = NT >> 3, wl = NT & 7, full = P * MT * 8;
  if (q < full) { const int panel = q / (MT * 8), rem = q - panel * MT * 8; mt = rem >> 3; nt = panel * 8 + (rem & 7); }
  else { const int q2 = q - full; mt = q2 / wl; nt = P * 8 + (q2 - mt * wl); }
  return true;
}
#define TILE_LOOP(NT_, CALL) do { const int N_ = MT * (NT_); const int Nr_ = ((N_ + G - 1) / G) * G; \
    for (int t = B; t < Nr_; t += G) { int mt, nt; if (tile_of(t, G, N_, (NT_), mt, nt)) { CALL; } } } while (0)
__global__ void __launch_bounds__(256, 2) mega(P p) {
  __shared__ __attribute__((aligned(16))) float smem[16128];
  __shared__ int s_item;
  cg::grid_group grid = cg::this_grid();
  u16* sA = (u16*)smem;
  u16* sB = sA + 128 * 72;
  const u16* W = (const u16*)(p.ws + OFF_W);
  const u16* XN = (const u16*)(p.ws + OFF_XN);
  float* X = (float*)(p.ws + OFF_X);
  u16* H = (u16*)(p.ws + OFF_D + D_H);
  u16* Zm = (u16*)(p.ws + OFF_D + D_ZM);
  const u16* M = (const u16*)(p.ws + OFF_D + D_M);
  int* ctr = (int*)p.ws;
  const int G = gridDim.x, B = blockIdx.x;

  for (int l = 0; l < 2; ++l) {
    phase_norm(p, l, 0);
    phase_convw(p, l, smem);
    grid.sync();
    TILE_LOOP(22, dual_tile256(XN, W + W_GU1, mt, nt, H, sA, sB));
    grid.sync();
    TILE_LOOP(8, resid_tile(H, 2816, 2816, W + W_DN1, mt, nt, X, 0.5f, sA, sB));
    grid.sync();
    phase_norm(p, l, 1);
    grid.sync();
    TILE_LOOP(9, zm_tile256(XN, W + W_INM, mt, nt, Zm, sA, sB));
    grid.sync();
    for (;;) {
      __syncthreads();
      if (threadIdx.x == 0) s_item = atomicAdd(&ctr[l * 2], 1);
      __syncthreads();
      const int it = s_item;
      if (it >= 2856) break;
      int ll = l;
      asm volatile("" : "+s"(ll));
      if (it < 128) s5_prompt(p, ll, it >> 4, it & 15, smem);
      else if (it < 1696) delta_pre(p, ll, it - 128, smem);
      else if (it < 2216) { int i = it - 1696; lru_pass1(p, ll, i / 65, (i % 65) * 32, smem); }
      else if (it < 2344) lru_pass1(p, ll, 8 + (it - 2216), 0, smem);
      else { int i = it - 2344; s5_block(p, ll, 8 + (i >> 2), i & 3, smem); }
    }
    grid.sync();
    for (;;) {
      __syncthreads();
      if (threadIdx.x == 0) s_item = atomicAdd(&ctr[l * 2 + 1], 1);
      __syncthreads();
      const int it = s_item;
      if (it >= 1900) break;
      int ll = l;
      asm volatile("" : "+s"(ll));
      if (it < 32) delta_seq(p, ll, it >> 2, it & 3, smem);
      else if (it < 64) { int i = it - 32; lru_prompt(p, ll, i >> 2, i & 3, smem); }
      else if (it < 612) { int i = it - 64; dual_tile<1>((const u16*)(p.ws + OFF_D + D_Y5), 256, 256, W + W_GLU, i % MT, i / MT, (u16*)(p.ws + OFF_D + D_BR), 1024, 256, p.in[28] + ll * 512, sA, sB); }
      else if (it < 1124) { int i = it - 612; delta_seq(p, ll, 8 + (i >> 2), i & 3, smem); }
      else if (it < 1252) lru_pass2(p, ll, 8 + (it - 1124));
      else if (it < 1772) { int i = it - 1252; conv_item(p, ll, i / 65, (i % 65) * 32, smem); }
      else conv_item(p, ll, 8 + (it - 1772), 0, smem);
    }
    grid.sync();
    TILE_LOOP(16, g4_tile(p, mt, nt, sA, sB));
    grid.sync();
    TILE_LOOP(8, resid_tile(M, 1024, 1024, W + W_OUT, mt, nt, X, 1.0f, sA, sB));
    grid.sync();
    phase_norm(p, l, 2);
    grid.sync();
    TILE_LOOP(22, dual_tile256(XN, W + W_GU2, mt, nt, H, sA, sB));
    grid.sync();
    TILE_LOOP(8, resid_tile(H, 2816, 2816, W + W_DN2, mt, nt, X, 0.5f, sA, sB));
    grid.sync();
  }
  phase_norm(p, 0, 3);
}

extern "C" void kernel_launch(void* const* d_in, const int* in_sizes, int n_in, void* d_out, int out_size, void* d_ws,
                              size_t ws_size, hipStream_t stream) {
  P p{};
  for (int i = 0; i < 46; ++i) p.in[i] = (const float*)d_in[i];
  p.out = (float*)d_out;
  p.ws = (char*)d_ws;
  static int grid_blocks = 0;
  if (!grid_blocks) {
    int dev = 0, cus = 0, per = 0;
    hipGetDevice(&dev);
    hipDeviceGetAttribute(&cus, hipDeviceAttributeMultiprocessorCount, dev);
    hipOccupancyMaxActiveBlocksPerMultiprocessor(&per, mega, 256, 0);
    if (per > 2) per = 2;
    if (per < 1) per = 1;
    grid_blocks = cus * per;
  }
  if (ws_size < WS_NEED) fprintf(stderr, "workspace too small: %zu < %zu\n", ws_size, (size_t)WS_NEED);
  hipMemsetAsync(d_ws, 0, 256, stream);
  void* args[] = {&p};
  hipError_t e = hipLaunchCooperativeKernel((void*)mega, dim3(grid_blocks), dim3(256), args, 0, stream);
  if (e != hipSuccess) fprintf(stderr, "cooperative launch failed: %s (grid %d)\n", hipGetErrorString(e), grid_blocks);
}
```

```cpp
#include <hip/hip_runtime.h>
#include <hip/hip_bf16.h>
#include <hip/hip_cooperative_groups.h>
#include <cstdio>
namespace cg = cooperative_groups;

typedef unsigned short u16;
using bf16x8 = __attribute__((ext_vector_type(8))) short;
using f32x4 = __attribute__((ext_vector_type(4))) float;
using u32x4 = __attribute__((ext_vector_type(4))) unsigned int;
#define DEV __device__ __forceinline__

struct P { const float* in[46]; float* out; char* ws; };

constexpr int NTOK = 17536, TP = 2064, NPR = 16512, ZW = 2304, MT = 137;
constexpr size_t OFF_X = 65536;
constexpr size_t OFF_W = OFF_X + (size_t)NTOK * 1024 * 4;
constexpr size_t W_GU1 = 0, W_DN1 = 5767168, W_INM = 8650752, W_ING = 11010048, W_BR = 15204352, W_OUT = 16252928,
                 W_GLU = 17301504, W_GU2 = 17432576, W_DN2 = 23199744, W_END = 26083328;
constexpr size_t OFF_XN = OFF_W + W_END * 2;
constexpr size_t OFF_BA = OFF_XN + (size_t)NTOK * 1024 * 2;
constexpr size_t OFF_D = OFF_BA + (size_t)NTOK * 8 * 4;
constexpr size_t D_H = 0, D_ZM = 0, D_M = 0, D_BR = 80805888, D_LA = 116719616, D_LB = 125698048, D_Y5 = 134676480;
constexpr size_t WS_NEED = OFF_D + 143654912;
constexpr size_t OFF_GAMMA = 1024;
constexpr size_t O_YS = 16777216, O_PDELTA = 17825792, O_PDCONV = 18087936, O_PS5RE = 18124800, O_PS5IM = 18141184,
                 O_PLRU = 18157568, O_PLRUC = 18161664, O_PCONV = 18173952, O_SDELTA = 18296832, O_SDCONV = 22491136,
                 O_SS5RE = 23080960, O_SS5IM = 23343104, O_SLRU = 23605248, O_SLRUC = 23670784, O_SCONV = 23867392;

DEV u16 f2bf(float f) { unsigned u = __float_as_uint(f); u += 0x7fffu + ((u >> 16) & 1u); return (u16)(u >> 16); }
DEV float bf2f(u16 h) { return __uint_as_float(((unsigned)h) << 16); }
DEV float bflo(unsigned u) { return __uint_as_float(u << 16); }
DEV float bfhi(unsigned u) { return __uint_as_float(u & 0xffff0000u); }
DEV unsigned pack2(float a, float b) { return (unsigned)f2bf(a) | ((unsigned)f2bf(b) << 16); }
DEV float sigm(float x) { return 1.f / (1.f + __expf(-x)); }
DEV float siluf_(float x) { return x / (1.f + __expf(-x)); }
DEV float softplusf_(float x) { return fmaxf(x, 0.f) + log1pf(__expf(-fabsf(x))); }
DEV float geluf_(float x) { float u = 0.7978845608028654f * (x + 0.044715f * x * x * x); return 0.5f * x * (1.f + tanhf(u)); }
DEV float wave_sum(float v) {
#pragma unroll
  for (int o = 32; o > 0; o >>= 1) v += __shfl_xor(v, o, 64);
  return v;
}
DEV void unpack16(uint4 a, uint4 b, float (&x)[16]) {
  x[0] = bflo(a.x); x[1] = bfhi(a.x); x[2] = bflo(a.y); x[3] = bfhi(a.y); x[4] = bflo(a.z); x[5] = bfhi(a.z); x[6] = bflo(a.w); x[7] = bfhi(a.w);
  x[8] = bflo(b.x); x[9] = bfhi(b.x); x[10] = bflo(b.y); x[11] = bfhi(b.y); x[12] = bflo(b.z); x[13] = bfhi(b.z); x[14] = bflo(b.w); x[15] = bfhi(b.w);
}
DEV float* st_out(const P& p, size_t offP, size_t offS, int l, int s, int sz) {
  return s < 8 ? p.out + offP + (size_t)(l * 8 + s) * sz : p.out + offS + (size_t)(l * 128 + (s - 8)) * sz;
}
DEV int tid_() { int t = threadIdx.x; asm volatile("" : "+v"(t)); return t; }
DEV int rowbase_of(int s) { return s < 8 ? s * TP : NPR + (s - 8) * 8; }

DEV void phase_norm(const P& p, int l, int kind, float* smem = nullptr) {
  const int tid0 = tid_(); const int lane = tid0 & 63, w = tid0 >> 6;
  float* X = (float*)(p.ws + OFF_X);
  u16* XN = (u16*)(p.ws + OFF_XN);
  float* BA = (float*)(p.ws + OFF_BA);
  const float* gain = kind == 0 ? p.in[10] + l * 1024 : kind == 1 ? p.in[13] + l * 1024 : kind == 2 ? p.in[42] + l * 1024 : p.in[45];
  float4 g4[4];
#pragma unroll
  for (int i = 0; i < 4; ++i) g4[i] = *(const float4*)(gain + i * 256 + lane * 4);
  const bool first = (kind == 0 && l == 0);
  if (kind == 1) {
    const float* wi0 = p.in[14] + (size_t)l * 1024 * 6408 + 1024;
#pragma unroll
    for (int q = 0; q < 4; ++q) {
      const int k = tid0 + 256 * q;
      const float4 a = *(const float4*)(wi0 + (size_t)k * 6408), c = *(const float4*)(wi0 + (size_t)k * 6408 + 4);
      smem[0 * 1024 + k] = a.x; smem[1 * 1024 + k] = a.y; smem[2 * 1024 + k] = a.z; smem[3 * 1024 + k] = a.w;
      smem[4 * 1024 + k] = c.x; smem[5 * 1024 + k] = c.y; smem[6 * 1024 + k] = c.z; smem[7 * 1024 + k] = c.w;
    }
    __syncthreads();
  }
  for (int r = blockIdx.x * 4 + w; r < NTOK; r += gridDim.x * 4) {
    const float* src;
    int b = 0, t = 0;
    if (r < NPR) { b = r / TP; t = r - b * TP; }
    if (first) {
      if (r < NPR) src = t < 16 ? p.in[9] + t * 1024 : p.in[0] + ((size_t)b * 2048 + (t - 16)) * 1024;
      else src = p.in[1] + (size_t)(r - NPR) * 1024;
    } else src = X + (size_t)r * 1024;
    float4 v[4];
    float ss = 0.f;
#pragma unroll
    for (int i = 0; i < 4; ++i) {
      v[i] = *(const float4*)(src + i * 256 + lane * 4);
      ss += v[i].x * v[i].x + v[i].y * v[i].y + v[i].z * v[i].z + v[i].w * v[i].w;
    }
    ss = wave_sum(ss);
    const float inv = rsqrtf(ss * (1.f / 1024.f) + 1e-6f);
    if (first) {
#pragma unroll
      for (int i = 0; i < 4; ++i) *(float4*)(X + (size_t)r * 1024 + i * 256 + lane * 4) = v[i];
    }
#pragma unroll
    for (int i = 0; i < 4; ++i) {
      v[i].x *= inv * g4[i].x; v[i].y *= inv * g4[i].y; v[i].z *= inv * g4[i].z; v[i].w *= inv * g4[i].w;
    }
    if (kind == 3) {
      float* dst;
      if (r < NPR) { if (t < 16) continue; dst = p.out + ((size_t)b * 2048 + (t - 16)) * 1024; }
      else dst = p.out + O_YS + (size_t)(r - NPR) * 1024;
#pragma unroll
      for (int i = 0; i < 4; ++i) *(float4*)(dst + i * 256 + lane * 4) = v[i];
    } else {
#pragma unroll
      for (int i = 0; i < 4; ++i) {
        uint2 o; o.x = pack2(v[i].x, v[i].y); o.y = pack2(v[i].z, v[i].w);
        *(uint2*)(XN + (size_t)r * 1024 + i * 256 + lane * 4) = o;
      }
      if (kind == 1) {
        float acc[8];
#pragma unroll
        for (int j = 0; j < 8; ++j) acc[j] = 0.f;
#pragma unroll
        for (int i = 0; i < 4; ++i) {
#pragma unroll
          for (int j = 0; j < 8; ++j) {
            const float4 wv = *(const float4*)(smem + j * 1024 + i * 256 + lane * 4);
            acc[j] += v[i].x * wv.x + v[i].y * wv.y + v[i].z * wv.z + v[i].w * wv.w;
          }
        }
#pragma unroll
        for (int j = 0; j < 8; ++j) acc[j] = wave_sum(acc[j]);
        if (lane == 0) {
          *(float4*)(BA + (size_t)r * 8) = make_float4(acc[0], acc[1], acc[2], acc[3]);
          *(float4*)(BA + (size_t)r * 8 + 4) = make_float4(acc[4], acc[5], acc[6], acc[7]);
        }
      }
    }
  }
}

DEV int wmap(int mode, int R, int c0, int half) {
  if (mode == 0) return c0 + R;
  if (mode == 1) { int tile = R >> 7, r = R & 127; int type = (r >> 4) & 1; return type * half + tile * 64 + (r >> 5) * 16 + (r & 15); }
  return R < 1024 ? R : R + 8;
}
DEV void convT(const float* __restrict__ src, int ld, int K, int NR, u16* __restrict__ dst, int mode, int c0, int half,
               int& tbase, float* smem) {
  const int tid = tid_(), G = gridDim.x;
  const int kt = K >> 6, ntile = kt * (NR >> 6);
  int start = ((int)blockIdx.x - tbase) % G;
  if (start < 0) start += G;
  for (int t = start; t < ntile; t += G) {
    const int rt = t / kt, k0 = (t - rt * kt) * 64, R0 = rt * 64;
    __syncthreads();
    const int rr = tid & 63;
    const int col = wmap(mode, R0 + rr, c0, half);
#pragma unroll
    for (int i = 0; i < 16; ++i) {
      int kk = i * 4 + (tid >> 6);
      smem[kk * 65 + rr] = src[(size_t)(k0 + kk) * ld + col];
    }
    __syncthreads();
    const int r2 = tid >> 2, seg = (tid & 3) * 16;
    unsigned o[8];
#pragma unroll
    for (int e = 0; e < 8; ++e) o[e] = pack2(smem[(seg + 2 * e) * 65 + r2], smem[(seg + 2 * e + 1) * 65 + r2]);
    uint4* d = (uint4*)(dst + (size_t)(R0 + r2) * K + k0 + seg);
    d[0] = make_uint4(o[0], o[1], o[2], o[3]);
    d[1] = make_uint4(o[4], o[5], o[6], o[7]);
  }
  tbase = (tbase + ntile) % G;
}
DEV void phase_convw(const P& p, int l, float* smem) {
  u16* W = (u16*)(p.ws + OFF_W);
  int tb = 0;
  convT(p.in[11] + (size_t)l * 1024 * 5632, 5632, 1024, 5632, W + W_GU1, 1, 0, 2816, tb, smem);
  convT(p.in[12] + (size_t)l * 2816 * 1024, 1024, 2816, 1024, W + W_DN1, 0, 0, 0, tb, smem);
  convT(p.in[14] + (size_t)l * 1024 * 6408, 6408, 1024, 2304, W + W_INM, 2, 0, 0, tb, smem);
  convT(p.in[14] + (size_t)l * 1024 * 6408, 6408, 1024, 4096, W + W_ING, 0, 2312, 0, tb, smem);
  for (int n = 0; n < 4; ++n)
    convT(p.in[40] + (size_t)(l * 4 + n) * 256 * 1024, 1024, 256, 1024, W + W_BR + (size_t)n * 1024 * 256, 0, 0, 0, tb, smem);
  convT(p.in[41] + (size_t)l * 1024 * 1024, 1024, 1024, 1024, W + W_OUT, 0, 0, 0, tb, smem);
  convT(p.in[27] + (size_t)l * 256 * 512, 512, 256, 512, W + W_GLU, 1, 0, 256, tb, smem);
  convT(p.in[43] + (size_t)l * 1024 * 5632, 5632, 1024, 5632, W + W_GU2, 1, 0, 2816, tb, smem);
  convT(p.in[44] + (size_t)l * 2816 * 1024, 1024, 2816, 1024, W + W_DN2, 0, 0, 0, tb, smem);
}

template <int BN>
DEV void gemm_acc(const u16* __restrict__ A, int lda, const u16* __restrict__ Bt, int ldb, int K, f32x4 (&acc)[4][BN / 32],
                  u16* sA, u16* sB) {
  constexpr int NI = BN / 32;
  const int tid = tid_(), lane = tid & 63, w = tid >> 6, wm = w >> 1, wn = w & 1;
  const int lrow = tid >> 3, lseg = (tid & 7) * 8;
  const u16* ga = A + (size_t)lrow * lda + lseg;
  const u16* gb = Bt + (size_t)lrow * ldb + lseg;
  u16* wa = sA + lrow * 72 + lseg;
  u16* wb = sB + lrow * 72 + lseg;
  const u16* fa = sA + (wm * 64 + (lane & 15)) * 72 + (lane >> 4) * 8;
  const u16* fb = sB + (wn * (BN / 2) + (lane & 15)) * 72 + (lane >> 4) * 8;
  u32x4 pa0, pa1, pa2, pa3, pb0, pb1, pb2, pb3, qa0, qa1, qa2, qa3, qb0, qb1, qb2, qb3;
#define GA_LOAD(X, koff) do { const u16* _ga = ga + (koff); const u16* _gb = gb + (koff); \
    X##a0 = *(const u32x4*)(_ga); X##a1 = *(const u32x4*)(_ga + (size_t)32 * lda); X##a2 = *(const u32x4*)(_ga + (size_t)64 * lda); X##a3 = *(const u32x4*)(_ga + (size_t)96 * lda); \
    X##b0 = *(const u32x4*)(_gb); X##b1 = *(const u32x4*)(_gb + (size_t)32 * ldb); \
    if (BN == 128) { X##b2 = *(const u32x4*)(_gb + (size_t)64 * ldb); X##b3 = *(const u32x4*)(_gb + (size_t)96 * ldb); } } while (0)
#define GA_WRITE(X) do { *(u32x4*)(wa) = X##a0; *(u32x4*)(wa + 32 * 72) = X##a1; *(u32x4*)(wa + 64 * 72) = X##a2; *(u32x4*)(wa + 96 * 72) = X##a3; \
    *(u32x4*)(wb) = X##b0; *(u32x4*)(wb + 32 * 72) = X##b1; \
    if (BN == 128) { *(u32x4*)(wb + 64 * 72) = X##b2; *(u32x4*)(wb + 96 * 72) = X##b3; } } while (0)
#define GA_COMPUTE() do { _Pragma("unroll") for (int kk = 0; kk < 64; kk += 32) { bf16x8 a[4], b[NI]; \
    _Pragma("unroll") for (int mi = 0; mi < 4; ++mi) a[mi] = *(const bf16x8*)(fa + mi * 16 * 72 + kk); \
    _Pragma("unroll") for (int ni = 0; ni < NI; ++ni) b[ni] = *(const bf16x8*)(fb + ni * 16 * 72 + kk); \
    _Pragma("unroll") for (int mi = 0; mi < 4; ++mi) _Pragma("unroll") for (int ni = 0; ni < NI; ++ni) \
      acc[mi][ni] = __builtin_amdgcn_mfma_f32_16x16x32_bf16(b[ni], a[mi], acc[mi][ni], 0, 0, 0); } } while (0)
  GA_LOAD(p, 0);
  if (K > 64) GA_LOAD(q, 64);
  for (int k0 = 0; k0 < K; k0 += 128) {
    __syncthreads();
    GA_WRITE(p);
    __syncthreads();
    if (k0 + 128 < K) GA_LOAD(p, k0 + 128);
    GA_COMPUTE();
    if (k0 + 64 >= K) break;
    __syncthreads();
    GA_WRITE(q);
    __syncthreads();
    if (k0 + 192 < K) GA_LOAD(q, k0 + 192);
    GA_COMPUTE();
  }
#undef GA_LOAD
#undef GA_WRITE
#undef GA_COMPUTE
}

template <int MODE>
DEV void dual_tile(const u16* A, int lda, int K, const u16* Wt, int mt, int nt, u16* out, int ldo, int ocol0, const float* bias,
                   u16* sA, u16* sB) {
  f32x4 acc[4][4];
#pragma unroll
  for (int i = 0; i < 4; ++i)
#pragma unroll
    for (int j = 0; j < 4; ++j) acc[i][j] = (f32x4){0.f, 0.f, 0.f, 0.f};
  gemm_acc<128>(A + (size_t)mt * 128 * lda, lda, Wt + (size_t)nt * 128 * K, K, K, acc, sA, sB);
  const int tid0 = tid_(); const int lane = tid0 & 63, w = tid0 >> 6, wm = w >> 1, wn = w & 1;
#pragma unroll
  for (int np = 0; np < 2; ++np) {
    const int col = nt * 64 + (wn * 2 + np) * 16 + (lane >> 4) * 4;
    float4 b0 = make_float4(0.f, 0.f, 0.f, 0.f), b1 = b0;
    if (MODE == 1) { b0 = *(const float4*)(bias + col); b1 = *(const float4*)(bias + 256 + col); }
#pragma unroll
    for (int mi = 0; mi < 4; ++mi) {
      const int row = mt * 128 + wm * 64 + mi * 16 + (lane & 15);
      const f32x4 g = acc[mi][2 * np], u = acc[mi][2 * np + 1];
      float v0, v1, v2, v3;
      if (MODE == 0) { v0 = siluf_(g[0]) * u[0]; v1 = siluf_(g[1]) * u[1]; v2 = siluf_(g[2]) * u[2]; v3 = siluf_(g[3]) * u[3]; }
      else { v0 = (g[0] + b0.x) * sigm(u[0] + b1.x); v1 = (g[1] + b0.y) * sigm(u[1] + b1.y); v2 = (g[2] + b0.z) * sigm(u[2] + b1.z); v3 = (g[3] + b0.w) * sigm(u[3] + b1.w); }
      uint2 o; o.x = pack2(v0, v1); o.y = pack2(v2, v3);
      *(uint2*)(out + (size_t)row * ldo + ocol0 + col) = o;
    }
  }
}
DEV void resid_tile(const u16* A, int lda, int K, const u16* Wt, int mt, int nt, float* X, float scale, u16* sA, u16* sB) {
  f32x4 acc[4][4];
#pragma unroll
  for (int i = 0; i < 4; ++i)
#pragma unroll
    for (int j = 0; j < 4; ++j) acc[i][j] = (f32x4){0.f, 0.f, 0.f, 0.f};
  gemm_acc<128>(A + (size_t)mt * 128 * lda, lda, Wt + (size_t)nt * 128 * K, K, K, acc, sA, sB);
  const int tid0 = tid_(); const int lane = tid0 & 63, w = tid0 >> 6, wm = w >> 1, wn = w & 1;
#pragma unroll
  for (int mi = 0; mi < 4; ++mi) {
    const int row = mt * 128 + wm * 64 + mi * 16 + (lane & 15);
    float* rp = X + (size_t)row * 1024 + nt * 128 + wn * 64 + (lane >> 4) * 4;
#pragma unroll
    for (int ni = 0; ni < 4; ++ni) { f32x4* q = (f32x4*)(rp + ni * 16); *q = *q + scale * acc[mi][ni]; }
  }
}
DEV void zm_tile(const u16* A, const u16* Wt, int mt, int nt, u16* Zm, u16* sA, u16* sB) {
  f32x4 acc[4][4];
#pragma unroll
  for (int i = 0; i < 4; ++i)
#pragma unroll
    for (int j = 0; j < 4; ++j) acc[i][j] = (f32x4){0.f, 0.f, 0.f, 0.f};
  gemm_acc<128>(A + (size_t)mt * 128 * 1024, 1024, Wt + (size_t)nt * 128 * 1024, 1024, 1024, acc, sA, sB);
  const int tid0 = tid_(); const int lane = tid0 & 63, w = tid0 >> 6, wm = w >> 1, wn = w & 1;
#pragma unroll
  for (int mi = 0; mi < 4; ++mi)
#pragma unroll
    for (int ni = 0; ni < 4; ++ni) {
      const int row = mt * 128 + wm * 64 + mi * 16 + (lane & 15);
      const int col = nt * 128 + wn * 64 + ni * 16 + (lane >> 4) * 4;
      uint2 o; o.x = pack2(acc[mi][ni][0], acc[mi][ni][1]); o.y = pack2(acc[mi][ni][2], acc[mi][ni][3]);
      *(uint2*)(Zm + (size_t)row * ZW + col) = o;
    }
}

DEV void gemm_acc256(const u16* __restrict__ A, int lda, const u16* __restrict__ Bt, int ldb, int K, f32x4 (&acc)[4][8],
                     u16* sA, u16* sB) {
  const int tid = tid_(), lane = tid & 63, w = tid >> 6, wm = w >> 1, wn = w & 1;
  const int lrow = tid >> 3, lseg = (tid & 7) * 8;
  const u16* ga = A + (size_t)lrow * lda + lseg;
  const u16* gb = Bt + (size_t)lrow * ldb + lseg;
  u16* wa = sA + lrow * 72 + lseg;
  u16* wb = sB + lrow * 72 + lseg;
  const u16* fa = sA + (wm * 64 + (lane & 15)) * 72 + (lane >> 4) * 8;
  const u16* fb = sB + (wn * 128 + (lane & 15)) * 72 + (lane >> 4) * 8;
  u32x4 ra0, ra1, ra2, ra3, rb0, rb1, rb2, rb3, rb4, rb5, rb6, rb7;
  ra0 = *(const u32x4*)(ga);
  ra1 = *(const u32x4*)(ga + (size_t)32 * lda);
  ra2 = *(const u32x4*)(ga + (size_t)64 * lda);
  ra3 = *(const u32x4*)(ga + (size_t)96 * lda);
  rb0 = *(const u32x4*)(gb);
  rb1 = *(const u32x4*)(gb + (size_t)32 * ldb);
  rb2 = *(const u32x4*)(gb + (size_t)64 * ldb);
  rb3 = *(const u32x4*)(gb + (size_t)96 * ldb);
  rb4 = *(const u32x4*)(gb + (size_t)128 * ldb);
  rb5 = *(const u32x4*)(gb + (size_t)160 * ldb);
  rb6 = *(const u32x4*)(gb + (size_t)192 * ldb);
  rb7 = *(const u32x4*)(gb + (size_t)224 * ldb);
  for (int k0 = 0; k0 < K; k0 += 64) {
    __syncthreads();
    *(u32x4*)(wa) = ra0; *(u32x4*)(wa + 32 * 72) = ra1; *(u32x4*)(wa + 64 * 72) = ra2; *(u32x4*)(wa + 96 * 72) = ra3;
    *(u32x4*)(wb) = rb0; *(u32x4*)(wb + 32 * 72) = rb1; *(u32x4*)(wb + 64 * 72) = rb2; *(u32x4*)(wb + 96 * 72) = rb3;
    *(u32x4*)(wb + 128 * 72) = rb4; *(u32x4*)(wb + 160 * 72) = rb5; *(u32x4*)(wb + 192 * 72) = rb6; *(u32x4*)(wb + 224 * 72) = rb7;
    __syncthreads();
    if (k0 + 64 < K) {
      const u16* ga2 = ga + k0 + 64;
      const u16* gb2 = gb + k0 + 64;
      ra0 = *(const u32x4*)(ga2);
      ra1 = *(const u32x4*)(ga2 + (size_t)32 * lda);
      ra2 = *(const u32x4*)(ga2 + (size_t)64 * lda);
      ra3 = *(const u32x4*)(ga2 + (size_t)96 * lda);
      rb0 = *(const u32x4*)(gb2);
      rb1 = *(const u32x4*)(gb2 + (size_t)32 * ldb);
      rb2 = *(const u32x4*)(gb2 + (size_t)64 * ldb);
      rb3 = *(const u32x4*)(gb2 + (size_t)96 * ldb);
      rb4 = *(const u32x4*)(gb2 + (size_t)128 * ldb);
      rb5 = *(const u32x4*)(gb2 + (size_t)160 * ldb);
      rb6 = *(const u32x4*)(gb2 + (size_t)192 * ldb);
      rb7 = *(const u32x4*)(gb2 + (size_t)224 * ldb);
    }
#pragma unroll
    for (int kk = 0; kk < 64; kk += 32) {
      bf16x8 a[4];
#pragma unroll
      for (int mi = 0; mi < 4; ++mi) a[mi] = *(const bf16x8*)(fa + mi * 16 * 72 + kk);
#pragma unroll
      for (int nh = 0; nh < 2; ++nh) {
        bf16x8 b[4];
#pragma unroll
        for (int ni = 0; ni < 4; ++ni) b[ni] = *(const bf16x8*)(fb + (nh * 4 + ni) * 16 * 72 + kk);
#pragma unroll
        for (int mi = 0; mi < 4; ++mi)
#pragma unroll
          for (int ni = 0; ni < 4; ++ni)
            acc[mi][nh * 4 + ni] = __builtin_amdgcn_mfma_f32_16x16x32_bf16(b[ni], a[mi], acc[mi][nh * 4 + ni], 0, 0, 0);
      }
    }
  }
}
DEV void dual_tile256(const u16* A, const u16* Wt, int mt, int nt, u16* out, u16* sA, u16* sB) {
  f32x4 acc[4][8];
#pragma unroll
  for (int i = 0; i < 4; ++i)
#pragma unroll
    for (int j = 0; j < 8; ++j) acc[i][j] = (f32x4){0.f, 0.f, 0.f, 0.f};
  gemm_acc256(A + (size_t)mt * 128 * 1024, 1024, Wt + (size_t)nt * 256 * 1024, 1024, 1024, acc, sA, sB);
  const int tid0 = tid_(); const int lane = tid0 & 63, w = tid0 >> 6, wm = w >> 1, wn = w & 1;
#pragma unroll
  for (int mi = 0; mi < 4; ++mi) {
    const int row = mt * 128 + wm * 64 + mi * 16 + (lane & 15);
#pragma unroll
    for (int np = 0; np < 4; ++np) {
      const int col = (nt * 2 + wn) * 64 + np * 16 + (lane >> 4) * 4;
      const f32x4 g = acc[mi][2 * np], u = acc[mi][2 * np + 1];
      uint2 o; o.x = pack2(siluf_(g[0]) * u[0], siluf_(g[1]) * u[1]); o.y = pack2(siluf_(g[2]) * u[2], siluf_(g[3]) * u[3]);
      *(uint2*)(out + (size_t)row * 2816 + col) = o;
    }
  }
}
DEV void zm_tile256(const u16* A, const u16* Wt, int mt, int nt, u16* Zm, u16* sA, u16* sB) {
  f32x4 acc[4][8];
#pragma unroll
  for (int i = 0; i < 4; ++i)
#pragma unroll
    for (int j = 0; j < 8; ++j) acc[i][j] = (f32x4){0.f, 0.f, 0.f, 0.f};
  gemm_acc256(A + (size_t)mt * 128 * 1024, 1024, Wt + (size_t)nt * 256 * 1024, 1024, 1024, acc, sA, sB);
  const int tid0 = tid_(); const int lane = tid0 & 63, w = tid0 >> 6, wm = w >> 1, wn = w & 1;
#pragma unroll
  for (int mi = 0; mi < 4; ++mi) {
    const int row = mt * 128 + wm * 64 + mi * 16 + (lane & 15);
#pragma unroll
    for (int ni = 0; ni < 8; ++ni) {
      const int col = nt * 256 + wn * 128 + ni * 16 + (lane >> 4) * 4;
      uint2 o; o.x = pack2(acc[mi][ni][0], acc[mi][ni][1]); o.y = pack2(acc[mi][ni][2], acc[mi][ni][3]);
      *(uint2*)(Zm + (size_t)row * ZW + col) = o;
    }
  }
}
DEV void g4_tile(const P& p, int mt, int nt, u16* sA, u16* sB) {
  const u16* BR = (const u16*)(p.ws + OFF_D + D_BR);
  const u16* XN = (const u16*)(p.ws + OFF_XN);
  const u16* Wb = (const u16*)(p.ws + OFF_W) + W_BR;
  const u16* Wg = (const u16*)(p.ws + OFF_W) + W_ING;
  u16* M = (u16*)(p.ws + OFF_D + D_M);
  f32x4 accM[4][2];
#pragma unroll
  for (int i = 0; i < 4; ++i)
#pragma unroll
    for (int j = 0; j < 2; ++j) accM[i][j] = (f32x4){0.f, 0.f, 0.f, 0.f};
#pragma unroll 1
  for (int n = 0; n < 4; ++n) {
    unsigned gate[4][2][2];
    {
      f32x4 accG[4][2];
#pragma unroll
      for (int i = 0; i < 4; ++i)
#pragma unroll
        for (int j = 0; j < 2; ++j) accG[i][j] = (f32x4){0.f, 0.f, 0.f, 0.f};
      gemm_acc<64>(XN + (size_t)mt * 128 * 1024, 1024, Wg + ((size_t)n * 1024 + nt * 64) * 1024, 1024, 1024, accG, sA, sB);
#pragma unroll
      for (int i = 0; i < 4; ++i)
#pragma unroll
        for (int j = 0; j < 2; ++j) {
          gate[i][j][0] = pack2(sigm(accG[i][j][0]), sigm(accG[i][j][1]));
          gate[i][j][1] = pack2(sigm(accG[i][j][2]), sigm(accG[i][j][3]));
        }
    }
    f32x4 accP[4][2];
#pragma unroll
    for (int i = 0; i < 4; ++i)
#pragma unroll
      for (int j = 0; j < 2; ++j) accP[i][j] = (f32x4){0.f, 0.f, 0.f, 0.f};
    gemm_acc<64>(BR + (size_t)mt * 128 * 1024 + n * 256, 1024, Wb + ((size_t)n * 1024 + nt * 64) * 256, 256, 256, accP, sA, sB);
#pragma unroll
    for (int i = 0; i < 4; ++i)
#pragma unroll
      for (int j = 0; j < 2; ++j) {
        accM[i][j][0] += bflo(gate[i][j][0]) * accP[i][j][0];
        accM[i][j][1] += bfhi(gate[i][j][0]) * accP[i][j][1];
        accM[i][j][2] += bflo(gate[i][j][1]) * accP[i][j][2];
        accM[i][j][3] += bfhi(gate[i][j][1]) * accP[i][j][3];
      }
  }
  const int tid0 = tid_(); const int lane = tid0 & 63, w = tid0 >> 6, wm = w >> 1, wn = w & 1;
#pragma unroll
  for (int mi = 0; mi < 4; ++mi) {
    const int row = mt * 128 + wm * 64 + mi * 16 + (lane & 15);
#pragma unroll
    for (int ni = 0; ni < 2; ++ni) {
      const int col = nt * 64 + wn * 32 + ni * 16 + (lane >> 4) * 4;
      uint2 o; o.x = pack2(accM[mi][ni][0], accM[mi][ni][1]); o.y = pack2(accM[mi][ni][2], accM[mi][ni][3]);
      *(uint2*)(M + (size_t)row * 1024 + col) = o;
    }
  }
}

DEV void dn_conv16(const u16* __restrict__ Zm, const float* __restrict__ buf, const float* __restrict__ cw, int rowbase, int t, int c,
                   float (&o)[16]) {
#pragma unroll
  for (int e = 0; e < 16; ++e) o[e] = 0.f;
#pragma unroll
  for (int tap = 0; tap < 4; ++tap) {
    const int tau = t - 3 + tap;
    float x[16];
    if (tau >= 0) {
      const uint4* z = (const uint4*)(Zm + (size_t)(rowbase + tau) * ZW + c);
      unpack16(z[0], z[1], x);
    } else if (buf) {
      const float4* bb = (const float4*)(buf + (3 + tau) * 768 + c);
#pragma unroll
      for (int q = 0; q < 4; ++q) { float4 f = bb[q]; x[q * 4] = f.x; x[q * 4 + 1] = f.y; x[q * 4 + 2] = f.z; x[q * 4 + 3] = f.w; }
    } else {
#pragma unroll
      for (int e = 0; e < 16; ++e) x[e] = 0.f;
    }
    const float4* w4 = (const float4*)(cw + tap * 768 + c);
#pragma unroll
    for (int q = 0; q < 4; ++q) {
      float4 f = w4[q];
      o[q * 4] += f.x * x[q * 4]; o[q * 4 + 1] += f.y * x[q * 4 + 1]; o[q * 4 + 2] += f.z * x[q * 4 + 2]; o[q * 4 + 3] += f.w * x[q * 4 + 3];
    }
  }
#pragma unroll
  for (int e = 0; e < 16; ++e) o[e] = siluf_(o[e]);
}

DEV void delta_pre(const P& p, int l, int idx, float* smem) {
  float* sq = smem;
  float* sk = smem + 64 * 68;
  float* sL = smem + 2 * 64 * 68;
  float* sbeta = sL + 4096;
  float* sg = sbeta + 64;
  float* sgc = sg + 64;
  int s, h, j, pad, T;
  if (idx < 1056) { s = idx / 132; int r = idx - s * 132; h = r / 33; j = r - h * 33; pad = 48; T = TP; }
  else { int r = idx - 1056; s = 8 + (r >> 2); h = r & 3; j = 0; pad = 56; T = 8; }
  const int tid = tid_();
  const u16* Zm = (const u16*)(p.ws + OFF_D + D_ZM);
  const float* BA = (const float*)(p.ws + OFF_BA);
  const float* cw = p.in[15] + l * 4 * 768;
  const float* buf = (s >= 8) ? p.in[3] + (size_t)(l * 128 + (s - 8)) * 3 * 768 : nullptr;
  const int rowbase = rowbase_of(s);
  u16* wsb = (u16*)p.out + (size_t)idx * 20480;
  float* gamma = (float*)(p.ws + OFF_GAMMA);
  {
    const int i = tid >> 2, dq = (tid & 3) * 16;
    const int t = j * 64 + i - pad;
    float qv[16], kv[16];
    float sq_ = 0.f, sk_ = 0.f;
    if (t >= 0) {
      dn_conv16(Zm, buf, cw, rowbase, t, h * 64 + dq, qv);
      dn_conv16(Zm, buf, cw, rowbase, t, 256 + h * 64 + dq, kv);
#pragma unroll
      for (int e = 0; e < 16; ++e) { sq_ += qv[e] * qv[e]; sk_ += kv[e] * kv[e]; }
    } else {
#pragma unroll
      for (int e = 0; e < 16; ++e) { qv[e] = 0.f; kv[e] = 0.f; }
    }
    sq_ += __shfl_xor(sq_, 1, 64); sq_ += __shfl_xor(sq_, 2, 64);
    sk_ += __shfl_xor(sk_, 1, 64); sk_ += __shfl_xor(sk_, 2, 64);
    const float qs = rsqrtf(sq_ + 1e-6f) * 0.125f, ks = rsqrtf(sk_ + 1e-6f);
#pragma unroll
    for (int e = 0; e < 16; ++e) { sq[i * 68 + dq + e] = qv[e] * qs; sk[i * 68 + dq + e] = kv[e] * ks; }
  }
  if (tid < 64) {
    const int t = j * 64 + tid - pad;
    float be = 0.f, g = 0.f;
    if (t >= 0) {
      const float* ba = BA + (size_t)(rowbase + t) * 8;
      be = sigm(ba[h]);
      float a = ba[4 + h] + p.in[17][l * 4 + h];
      g = -expf(p.in[16][l * 4 + h]) * softplusf_(a);
    }
    sbeta[tid] = be;
    sg[tid] = g;
  }
  __syncthreads();
  if (tid < 64) {
    float c = 0.f;
    for (int i2 = 0; i2 <= tid; ++i2) c += sg[i2];
    sgc[tid] = c;
  }
  __syncthreads();
  {
    const int ti = tid >> 4, tj = tid & 15;
    float aL[4][4], aI[4][4];
#pragma unroll
    for (int a = 0; a < 4; ++a)
#pragma unroll
      for (int b = 0; b < 4; ++b) { aL[a][b] = 0.f; aI[a][b] = 0.f; }
    for (int d = 0; d < 64; d += 4) {
      float4 qa[4], ka[4], kb[4];
#pragma unroll
      for (int a = 0; a < 4; ++a) { qa[a] = *(const float4*)&sq[(ti + 16 * a) * 68 + d]; ka[a] = *(const float4*)&sk[(ti + 16 * a) * 68 + d]; }
#pragma unroll
      for (int b = 0; b < 4; ++b) kb[b] = *(const float4*)&sk[(tj + 16 * b) * 68 + d];
#pragma unroll
      for (int a = 0; a < 4; ++a)
#pragma unroll
        for (int b = 0; b < 4; ++b) {
          aL[a][b] += ka[a].x * kb[b].x + ka[a].y * kb[b].y + ka[a].z * kb[b].z + ka[a].w * kb[b].w;
          aI[a][b] += qa[a].x * kb[b].x + qa[a].y * kb[b].y + qa[a].z * kb[b].z + qa[a].w * kb[b].w;
        }
    }
#pragma unroll
    for (int a = 0; a < 4; ++a)
#pragma unroll
      for (int b = 0; b < 4; ++b) {
        const int i = ti + 16 * a, jj = tj + 16 * b;
        const float dec = (jj <= i) ? __expf(sgc[i] - sgc[jj]) : 0.f;
        sL[i * 64 + jj] = (jj < i) ? aL[a][b] * sbeta[i] * dec : 0.f;
        wsb[3 * 4096 + i * 64 + jj] = f2bf(aI[a][b] * dec);
      }
  }
  for (int e = tid; e < 4096; e += 256) {
    const int i = e >> 6, d = e & 63;
    wsb[2 * 4096 + e] = f2bf(sq[i * 68 + d] * __expf(sgc[i]));
  }
  for (int e = tid; e < 4096; e += 256) {
    const int d = e >> 6, i = e & 63;
    wsb[4 * 4096 + e] = f2bf(sk[i * 68 + d] * __expf(sgc[63] - sgc[i]));
  }
  if (tid == 0) gamma[idx] = __expf(sgc[63]);
  __syncthreads();
  {
    const int i = tid >> 2, dq = (tid & 3) * 16;
    const int t = j * 64 + i - pad;
    float vv[16];
    if (t >= 0) dn_conv16(Zm, buf, cw, rowbase, t, 512 + h * 64 + dq, vv);
    else {
#pragma unroll
      for (int e = 0; e < 16; ++e) vv[e] = 0.f;
    }
    const float be = sbeta[i], eg = be * __expf(sgc[i]);
#pragma unroll
    for (int e = 0; e < 16; ++e) { sq[i * 68 + dq + e] = vv[e] * be; sk[i * 68 + dq + e] *= eg; }
  }
  __syncthreads();
  {
    float* arr = (tid < 128) ? sq : sk;
    const int col = (tid >> 1) & 63, hf = tid & 1;
    for (int i = 1; i < 64; ++i) {
      float acc = 0.f;
      for (int j0 = hf * 4; j0 < i; j0 += 8) {
        const float4 l4 = *(const float4*)&sL[i * 64 + j0];
        acc -= l4.x * arr[j0 * 68 + col] + l4.y * arr[(j0 + 1) * 68 + col] + l4.z * arr[(j0 + 2) * 68 + col] + l4.w * arr[(j0 + 3) * 68 + col];
      }
      acc += __shfl_xor(acc, 1, 64);
      if (hf == 0) arr[i * 68 + col] += acc;
    }
  }
  __syncthreads();
  for (int e = tid; e < 4096; e += 256) {
    const int i = e >> 6, d = e & 63;
    wsb[e] = f2bf(sq[i * 68 + d]);
    wsb[4096 + e] = f2bf(sk[i * 68 + d]);
  }
  if (h == 0 && j == (s < 8 ? 32 : 0)) {
    float* o = st_out(p, O_PDCONV, O_SDCONV, l, s, 3 * 768);
    for (int e = tid; e < 3 * 768; e += 256) {
      const int r = e / 768, c = e - r * 768;
      o[e] = bf2f(Zm[(size_t)(rowbase + T - 3 + r) * ZW + c]);
    }
  }
}

DEV void mm64(const float* __restrict__ A, const float* __restrict__ B, float (&acc)[4][4], int ti, int tj) {
#pragma unroll 4
  for (int kk = 0; kk < 64; kk += 4) {
    float4 a[4], b[4];
#pragma unroll
    for (int x = 0; x < 4; ++x) a[x] = *(const float4*)&A[(ti + 16 * x) * 68 + kk];
#pragma unroll
    for (int y = 0; y < 4; ++y) b[y] = *(const float4*)&B[(kk + y) * 64 + tj * 4];
#pragma unroll
    for (int x = 0; x < 4; ++x) {
      acc[x][0] += a[x].x * b[0].x + a[x].y * b[1].x + a[x].z * b[2].x + a[x].w * b[3].x;
      acc[x][1] += a[x].x * b[0].y + a[x].y * b[1].y + a[x].z * b[2].y + a[x].w * b[3].y;
      acc[x][2] += a[x].x * b[0].z + a[x].y * b[1].z + a[x].z * b[2].z + a[x].w * b[3].z;
      acc[x][3] += a[x].x * b[0].w + a[x].y * b[1].w + a[x].z * b[2].w + a[x].w * b[3].w;
    }
  }
}
DEV void storeA16(float* sA, uint4 r0, uint4 r1) {
  const int tid = tid_();
  float x[16];
  unpack16(r0, r1, x);
  float* d = sA + (tid >> 2) * 68 + (tid & 3) * 16;
#pragma unroll
  for (int q = 0; q < 4; ++q) *(float4*)(d + q * 4) = make_float4(x[q * 4], x[q * 4 + 1], x[q * 4 + 2], x[q * 4 + 3]);
}

DEV void mm64h(const u16* __restrict__ A, const float* __restrict__ B, float (&acc)[4][4], int ti, int tj) {
#pragma unroll 4
  for (int kk = 0; kk < 64; kk += 4) {
    float4 a[4], b[4];
#pragma unroll
    for (int x = 0; x < 4; ++x) {
      const uint2 av = *(const uint2*)&A[(ti + 16 * x) * 72 + kk];
      a[x] = make_float4(bflo(av.x), bfhi(av.x), bflo(av.y), bfhi(av.y));
    }
#pragma unroll
    for (int y = 0; y < 4; ++y) b[y] = *(const float4*)&B[(kk + y) * 64 + tj * 4];
#pragma unroll
    for (int x = 0; x < 4; ++x) {
      acc[x][0] += a[x].x * b[0].x + a[x].y * b[1].x + a[x].z * b[2].x + a[x].w * b[3].x;
      acc[x][1] += a[x].x * b[0].y + a[x].y * b[1].y + a[x].z * b[2].y + a[x].w * b[3].y;
      acc[x][2] += a[x].x * b[0].z + a[x].y * b[1].z + a[x].z * b[2].z + a[x].w * b[3].z;
      acc[x][3] += a[x].x * b[0].w + a[x].y * b[1].w + a[x].z * b[2].w + a[x].w * b[3].w;
    }
  }
}
DEV void store16h(u16* sA, uint4 r0, uint4 r1) {
  const int tid = tid_();
  uint4* d = (uint4*)(sA + (tid >> 2) * 72 + (tid & 3) * 16);
  d[0] = r0; d[1] = r1;
}

DEV void delta_seq(const P& p, int l, int s, int h, float* smem) {
  float* sS = smem;
  float* sV = smem + 4096;
  u16* sA0 = (u16*)(smem + 8192);
  u16* sA1 = sA0 + 64 * 72;
  u16* sA2 = sA1 + 64 * 72;
  const int tid = tid_(), ti = tid >> 4, tj = tid & 15;
  const int n = (s < 8) ? 33 : 1, pad = (s < 8) ? 48 : 56;
  const int item0 = (s < 8) ? (s * 4 + h) * 33 : 1056 + (s - 8) * 4 + h;
  const int rowbase = rowbase_of(s);
  const float* s0 = (s >= 8) ? p.in[2] + (size_t)((l * 128 + (s - 8)) * 4 + h) * 4096 : nullptr;
  for (int e = tid; e < 4096; e += 256) sS[e] = s0 ? s0[e] : 0.f;
  const u16* wsb = (const u16*)p.out + (size_t)item0 * 20480;
  const float* gamma = (const float*)(p.ws + OFF_GAMMA) + item0;
  const u16* Zm = (const u16*)(p.ws + OFF_D + D_ZM);
  u16* BR = (u16*)(p.ws + OFF_D + D_BR);
  const float4 ng = *(const float4*)(p.in[18] + l * 64 + tj * 4);
  uint4 rw0, rw1, rq0, rq1, ri0, ri1, rk0, rk1;
  {
    const uint4* src = (const uint4*)(wsb + tid * 16);
    rw0 = src[512]; rw1 = src[513];
    rq0 = src[1024]; rq1 = src[1025];
    ri0 = src[1536]; ri1 = src[1537];
    rk0 = src[2048]; rk1 = src[2049];
  }
  for (int j = 0; j < n; ++j) {
    const u16* it = wsb + (size_t)j * 20480;
    uint2 uu_pf[4], zz_pf[4];
#pragma unroll
    for (int a = 0; a < 4; ++a) {
      const int i = ti + 16 * a;
      uu_pf[a] = *(const uint2*)(it + i * 64 + tj * 4);
      const int t = j * 64 + i - pad;
      zz_pf[a] = (t >= 0) ? *(const uint2*)(Zm + (size_t)(rowbase + t) * ZW + 768 + h * 64 + tj * 4) : make_uint2(0u, 0u);
    }
    const float gm = gamma[j];
    __syncthreads();
    store16h(sA0, rw0, rw1); store16h(sA1, rq0, rq1); store16h(sA2, ri0, ri1);
    __syncthreads();
    if (j + 1 < n) {
      const uint4* src = (const uint4*)(it + 20480 + tid * 16);
      rw0 = src[512]; rw1 = src[513]; rq0 = src[1024]; rq1 = src[1025]; ri0 = src[1536]; ri1 = src[1537];
    }
    float acc[4][4];
#pragma unroll
    for (int a = 0; a < 4; ++a)
#pragma unroll
      for (int c = 0; c < 4; ++c) acc[a][c] = 0.f;
    mm64h(sA0, sS, acc, ti, tj);
#pragma unroll
    for (int a = 0; a < 4; ++a) {
      const int i = ti + 16 * a;
      const uint2 uu = uu_pf[a];
      *(float4*)&sV[i * 64 + tj * 4] = make_float4(bflo(uu.x) - acc[a][0], bfhi(uu.x) - acc[a][1], bflo(uu.y) - acc[a][2], bfhi(uu.y) - acc[a][3]);
    }
    __syncthreads();
    store16h(sA0, rk0, rk1);
    if (j + 1 < n) { const uint4* src = (const uint4*)(it + 20480 + tid * 16); rk0 = src[2048]; rk1 = src[2049]; }
    float o[4][4];
#pragma unroll
    for (int a = 0; a < 4; ++a)
#pragma unroll
      for (int c = 0; c < 4; ++c) o[a][c] = 0.f;
    mm64h(sA1, sS, o, ti, tj);
    mm64h(sA2, sV, o, ti, tj);
#pragma unroll
    for (int a = 0; a < 4; ++a) {
      const int i = ti + 16 * a;
      const int t = j * 64 + i - pad;
      float ss = o[a][0] * o[a][0] + o[a][1] * o[a][1] + o[a][2] * o[a][2] + o[a][3] * o[a][3];
      ss += __shfl_xor(ss, 1, 64); ss += __shfl_xor(ss, 2, 64); ss += __shfl_xor(ss, 4, 64); ss += __shfl_xor(ss, 8, 64);
      if (t >= 0) {
        const float inv = rsqrtf(ss * (1.f / 64.f) + 1e-6f);
        const size_t row = (size_t)(rowbase + t);
        const uint2 zz = zz_pf[a];
        float y0 = o[a][0] * inv * ng.x * siluf_(bflo(zz.x));
        float y1 = o[a][1] * inv * ng.y * siluf_(bfhi(zz.x));
        float y2 = o[a][2] * inv * ng.z * siluf_(bflo(zz.y));
        float y3 = o[a][3] * inv * ng.w * siluf_(bfhi(zz.y));
        uint2 ov; ov.x = pack2(y0, y1); ov.y = pack2(y2, y3);
        *(uint2*)(BR + row * 1024 + h * 64 + tj * 4) = ov;
      }
    }
    __syncthreads();
#pragma unroll
    for (int a = 0; a < 4; ++a)
#pragma unroll
      for (int c = 0; c < 4; ++c) acc[a][c] = 0.f;
    mm64h(sA0, sV, acc, ti, tj);
#pragma unroll
    for (int a = 0; a < 4; ++a) {
      float4* sp = (float4*)&sS[(ti + 16 * a) * 64 + tj * 4];
      float4 old = *sp;
      *sp = make_float4(gm * old.x + acc[a][0], gm * old.y + acc[a][1], gm * old.z + acc[a][2], gm * old.w + acc[a][3]);
    }
  }
  __syncthreads();
  float* so = st_out(p, O_PDELTA, O_SDELTA, l, s, 4 * 4096) + h * 4096;
  for (int e = tid; e < 4096; e += 256) so[e] = sS[e];
}

DEV void s5_block(const P& p, int l, int s, int gq, float* smem) {
  const int tid = tid_(), lane = tid & 63;
  const int w = __builtin_amdgcn_readfirstlane(tid >> 6);
  const int g = gq * 4 + w;
  float* sC = smem + w * 3248;
  float* sH = sC + 2080;
  float* sU = sH + 1040;
  const int T = (s < 8) ? TP : 8;
  const int rowbase = rowbase_of(s);
  const u16* Zm = (const u16*)(p.ws + OFF_D + D_ZM);
  u16* Y5 = (u16*)(p.ws + OFF_D + D_Y5);
  const int lg_ = l * 16 + g;
  const float lr = p.in[19][lg_ * 64 + lane], li = p.in[20][lg_ * 64 + lane];
  const float dt = expf(p.in[21][lg_]);
  const float mag = expf(lr * dt);
  const float lbr = mag * cosf(li * dt), lbi = mag * sinf(li * dt);
  const float den = lr * lr + li * li;
  const float cfr = ((lbr - 1.f) * lr + lbi * li) / den, cfi = (lbi * lr - (lbr - 1.f) * li) / den;
  float xr_c[16], xi_c[16];
  {
    const float4* br4 = (const float4*)(p.in[22] + ((size_t)lg_ * 64 + lane) * 16);
    const float4* bi4 = (const float4*)(p.in[23] + ((size_t)lg_ * 64 + lane) * 16);
#pragma unroll
    for (int q = 0; q < 4; ++q) {
      float4 a = br4[q], b = bi4[q];
      xr_c[q * 4] = cfr * a.x - cfi * b.x; xi_c[q * 4] = cfr * b.x + cfi * a.x;
      xr_c[q * 4 + 1] = cfr * a.y - cfi * b.y; xi_c[q * 4 + 1] = cfr * b.y + cfi * a.y;
      xr_c[q * 4 + 2] = cfr * a.z - cfi * b.z; xi_c[q * 4 + 2] = cfr * b.z + cfi * a.z;
      xr_c[q * 4 + 3] = cfr * a.w - cfi * b.w; xi_c[q * 4 + 3] = cfr * b.w + cfi * a.w;
    }
  }
  for (int e = lane; e < 1024; e += 64) {
    const int c = e >> 6, pp = e & 63;
    sC[(c * 65 + pp) * 2] = p.in[24][(size_t)lg_ * 1024 + e];
    sC[(c * 65 + pp) * 2 + 1] = p.in[25][(size_t)lg_ * 1024 + e];
  }
  float hr = 0.f, hi = 0.f;
  if (s >= 8) {
    hr = p.in[4][((size_t)(l * 128 + (s - 8)) * 16 + g) * 64 + lane];
    hi = p.in[5][((size_t)(l * 128 + (s - 8)) * 16 + g) * 64 + lane];
  }
  const int ytt = lane >> 3, cp = (lane & 7) * 2;
  const float d0 = p.in[26][l * 256 + g * 16 + cp], d1 = p.in[26][l * 256 + g * 16 + cp + 1];
  const u16* ubase = Zm + (size_t)rowbase * ZW + 1024 + g * 16 + (size_t)(lane >> 1) * ZW + (lane & 1) * 8;
  uint4 pu = make_uint4(0u, 0u, 0u, 0u);
  if (lane < 16) pu = *(const uint4*)(ubase);
  if (lane < 16) {
    float* d = sU + (lane >> 1) * 16 + (lane & 1) * 8;
    *(float4*)(d) = make_float4(bflo(pu.x), bfhi(pu.x), bflo(pu.y), bfhi(pu.y));
    *(float4*)(d + 4) = make_float4(bflo(pu.z), bfhi(pu.z), bflo(pu.w), bfhi(pu.w));
  }
  for (int t0 = 0; t0 < T; t0 += 8) {
    __syncthreads();
    if (lane < 16 && t0 + 8 < T) pu = *(const uint4*)(ubase + (size_t)(t0 + 8) * ZW);
#pragma unroll 2
    for (int tt = 0; tt < 8; ++tt) {
      const float4 u0 = *(const float4*)(sU + tt * 16), u1 = *(const float4*)(sU + tt * 16 + 4), u2 = *(const float4*)(sU + tt * 16 + 8),
                   u3 = *(const float4*)(sU + tt * 16 + 12);
      const float u[16] = {u0.x, u0.y, u0.z, u0.w, u1.x, u1.y, u1.z, u1.w, u2.x, u2.y, u2.z, u2.w, u3.x, u3.y, u3.z, u3.w};
      float xr = 0.f, xi = 0.f;
#pragma unroll
      for (int c = 0; c < 16; ++c) { xr += xr_c[c] * u[c]; xi += xi_c[c] * u[c]; }
      const float nr = lbr * hr - lbi * hi + xr;
      const float ni = lbr * hi + lbi * hr + xi;
      hr = nr; hi = ni;
      *(float2*)&sH[(tt * 65 + lane) * 2] = make_float2(hr, hi);
    }
    __syncthreads();
    float y0 = 0.f, y1 = 0.f;
#pragma unroll 8
    for (int pp = 0; pp < 64; ++pp) {
      const float2 hv = *(const float2*)&sH[(ytt * 65 + pp) * 2];
      const float2 c0 = *(const float2*)&sC[(cp * 65 + pp) * 2];
      const float2 c1 = *(const float2*)&sC[((cp + 1) * 65 + pp) * 2];
      y0 += hv.x * c0.x - hv.y * c0.y;
      y1 += hv.x * c1.x - hv.y * c1.y;
    }
    const size_t row = (size_t)(rowbase + t0 + ytt);
    const float2 uy = *(const float2*)(sU + ytt * 16 + cp);
    y0 = geluf_(y0 + d0 * uy.x);
    y1 = geluf_(y1 + d1 * uy.y);
    *(unsigned*)(Y5 + row * 256 + g * 16 + cp) = pack2(y0, y1);
    if (lane < 16 && t0 + 8 < T) {
      float* d = sU + (lane >> 1) * 16 + (lane & 1) * 8;
      *(float4*)(d) = make_float4(bflo(pu.x), bfhi(pu.x), bflo(pu.y), bfhi(pu.y));
      *(float4*)(d + 4) = make_float4(bflo(pu.z), bfhi(pu.z), bflo(pu.w), bfhi(pu.w));
    }
  }
  st_out(p, O_PS5RE, O_SS5RE, l, s, 1024)[g * 64 + lane] = hr;
  st_out(p, O_PS5IM, O_SS5IM, l, s, 1024)[g * 64 + lane] = hi;
}


DEV void s5_prompt(const P& p, int l, int s, int g, float* smem) {
  const int tid = tid_(), lane = tid & 63;
  const int w = __builtin_amdgcn_readfirstlane(tid >> 6);
  float* sC = smem;
  float* sE = smem + 2080;
  float* sH = smem + 2080 + 512 + w * 1168;
  float* sU = sH + 1040;
  const int rowbase = rowbase_of(s);
  const int tbeg = w * 512, tend = (w == 3) ? TP : tbeg + 512;
  const u16* Zm = (const u16*)(p.ws + OFF_D + D_ZM);
  u16* Y5 = (u16*)(p.ws + OFF_D + D_Y5);
  const int lg_ = l * 16 + g;
  const float lr = p.in[19][lg_ * 64 + lane], li = p.in[20][lg_ * 64 + lane];
  const float dt = expf(p.in[21][lg_]);
  const float mag = expf(lr * dt);
  const float lbr = mag * cosf(li * dt), lbi = mag * sinf(li * dt);
  const float den = lr * lr + li * li;
  const float cfr = ((lbr - 1.f) * lr + lbi * li) / den, cfi = (lbi * lr - (lbr - 1.f) * li) / den;
  float xr_c[16], xi_c[16];
  {
    const float4* br4 = (const float4*)(p.in[22] + ((size_t)lg_ * 64 + lane) * 16);
    const float4* bi4 = (const float4*)(p.in[23] + ((size_t)lg_ * 64 + lane) * 16);
#pragma unroll
    for (int q = 0; q < 4; ++q) {
      float4 a = br4[q], b = bi4[q];
      xr_c[q * 4] = cfr * a.x - cfi * b.x; xi_c[q * 4] = cfr * b.x + cfi * a.x;
      xr_c[q * 4 + 1] = cfr * a.y - cfi * b.y; xi_c[q * 4 + 1] = cfr * b.y + cfi * a.y;
      xr_c[q * 4 + 2] = cfr * a.z - cfi * b.z; xi_c[q * 4 + 2] = cfr * b.z + cfi * a.z;
      xr_c[q * 4 + 3] = cfr * a.w - cfi * b.w; xi_c[q * 4 + 3] = cfr * b.w + cfi * a.w;
    }
  }
  for (int e = tid; e < 1024; e += 256) {
    const int c = e >> 6, pp = e & 63;
    sC[(c * 65 + pp) * 2] = p.in[24][(size_t)lg_ * 1024 + e];
    sC[(c * 65 + pp) * 2 + 1] = p.in[25][(size_t)lg_ * 1024 + e];
  }
  const u16* ubase = Zm + (size_t)rowbase * ZW + 1024 + g * 16 + (size_t)(lane >> 1) * ZW + (lane & 1) * 8;
  float hr = 0.f, hi = 0.f;
  if (w < 3) {
    uint4 pu = make_uint4(0u, 0u, 0u, 0u);
    if (lane < 16) pu = *(const uint4*)(ubase + (size_t)tbeg * ZW);
    for (int t0 = tbeg; t0 < tend; t0 += 8) {
      if (lane < 16) {
        float* d = sU + (lane >> 1) * 16 + (lane & 1) * 8;
        *(float4*)(d) = make_float4(bflo(pu.x), bfhi(pu.x), bflo(pu.y), bfhi(pu.y));
        *(float4*)(d + 4) = make_float4(bflo(pu.z), bfhi(pu.z), bflo(pu.w), bfhi(pu.w));
      }
      if (lane < 16 && t0 + 8 < tend) pu = *(const uint4*)(ubase + (size_t)(t0 + 8) * ZW);
      __builtin_amdgcn_wave_barrier();
#pragma unroll 2
      for (int tt = 0; tt < 8; ++tt) {
        const float4 u0 = *(const float4*)(sU + tt * 16), u1 = *(const float4*)(sU + tt * 16 + 4), u2 = *(const float4*)(sU + tt * 16 + 8),
                     u3 = *(const float4*)(sU + tt * 16 + 12);
        const float u[16] = {u0.x, u0.y, u0.z, u0.w, u1.x, u1.y, u1.z, u1.w, u2.x, u2.y, u2.z, u2.w, u3.x, u3.y, u3.z, u3.w};
        float xr = 0.f, xi = 0.f;
#pragma unroll
        for (int c = 0; c < 16; ++c) { xr += xr_c[c] * u[c]; xi += xi_c[c] * u[c]; }
        const float nr = lbr * hr - lbi * hi + xr;
        const float ni = lbr * hi + lbi * hr + xi;
        hr = nr; hi = ni;
      }
      __builtin_amdgcn_wave_barrier();
    }
    *(float2*)&sE[(w * 64 + lane) * 2] = make_float2(hr, hi);
  }
  __syncthreads();
  {
    const float m512 = expf(lr * dt * 512.f);
    const float pr = m512 * cosf(li * dt * 512.f), pi = m512 * sinf(li * dt * 512.f);
    float Hr = 0.f, Hi = 0.f;
    for (int k = 0; k < w; ++k) {
      const float2 e = *(const float2*)&sE[(k * 64 + lane) * 2];
      const float nr = pr * Hr - pi * Hi + e.x, ni = pr * Hi + pi * Hr + e.y;
      Hr = nr; Hi = ni;
    }
    hr = Hr; hi = Hi;
  }
  const int ytt = lane >> 3, cp = (lane & 7) * 2;
  const float d0 = p.in[26][l * 256 + g * 16 + cp], d1 = p.in[26][l * 256 + g * 16 + cp + 1];
  {
    uint4 pu = make_uint4(0u, 0u, 0u, 0u);
    if (lane < 16) pu = *(const uint4*)(ubase + (size_t)tbeg * ZW);
    for (int t0 = tbeg; t0 < tend; t0 += 8) {
      if (lane < 16) {
        float* d = sU + (lane >> 1) * 16 + (lane & 1) * 8;
        *(float4*)(d) = make_float4(bflo(pu.x), bfhi(pu.x), bflo(pu.y), bfhi(pu.y));
        *(float4*)(d + 4) = make_float4(bflo(pu.z), bfhi(pu.z), bflo(pu.w), bfhi(pu.w));
      }
      if (lane < 16 && t0 + 8 < tend) pu = *(const uint4*)(ubase + (size_t)(t0 + 8) * ZW);
      __builtin_amdgcn_wave_barrier();
#pragma unroll 2
      for (int tt = 0; tt < 8; ++tt) {
        const float4 u0 = *(const float4*)(sU + tt * 16), u1 = *(const float4*)(sU + tt * 16 + 4), u2 = *(const float4*)(sU + tt * 16 + 8),
                     u3 = *(const float4*)(sU + tt * 16 + 12);
        const float u[16] = {u0.x, u0.y, u0.z, u0.w, u1.x, u1.y, u1.z, u1.w, u2.x, u2.y, u2.z, u2.w, u3.x, u3.y, u3.z, u3.w};
        float xr = 0.f, xi = 0.f;
#pragma unroll
        for (int c = 0; c < 16; ++c) { xr += xr_c[c] * u[c]; xi += xi_c[c] * u[c]; }
        const float nr = lbr * hr - lbi * hi + xr;
        const float ni = lbr * hi + lbi * hr + xi;
        hr = nr; hi = ni;
        *(float2*)&sH[(tt * 65 + lane) * 2] = make_float2(hr, hi);
      }
      __builtin_amdgcn_wave_barrier();
      float y0 = 0.f, y1 = 0.f;
#pragma unroll 8
      for (int pp = 0; pp < 64; ++pp) {
        const float2 hv = *(const float2*)&sH[(ytt * 65 + pp) * 2];
        const float2 c0 = *(const float2*)&sC[(cp * 65 + pp) * 2];
        const float2 c1 = *(const float2*)&sC[((cp + 1) * 65 + pp) * 2];
        y0 += hv.x * c0.x - hv.y * c0.y;
        y1 += hv.x * c1.x - hv.y * c1.y;
      }
      const size_t row = (size_t)(rowbase + t0 + ytt);
      const float2 uy = *(const float2*)(sU + ytt * 16 + cp);
      y0 = geluf_(y0 + d0 * uy.x);
      y1 = geluf_(y1 + d1 * uy.y);
      *(unsigned*)(Y5 + row * 256 + g * 16 + cp) = pack2(y0, y1);
      __builtin_amdgcn_wave_barrier();
    }
  }
  if (w == 3) {
    st_out(p, O_PS5RE, O_SS5RE, l, s, 1024)[g * 64 + lane] = hr;
    st_out(p, O_PS5IM, O_SS5IM, l, s, 1024)[g * 64 + lane] = hi;
  }
}

DEV float lru_xin(const P& p, const u16* Zm, int l, int s, int rowbase, int tau, int c) {
  if (tau >= 0) return bf2f(Zm[(size_t)(rowbase + tau) * ZW + 1280 + c]);
  if (s >= 8) return p.in[7][((size_t)(l * 128 + (s - 8)) * 3 + (3 + tau)) * 256 + c];
  return 0.f;
}
DEV void lru_pass1(const P& p, int l, int s, int t0, float* smem) {
  float* sX = smem;
  const int c = tid_();
  const int T = (s < 8) ? TP : 8;
  const int nT = min(32, T - t0);
  const int rowbase = rowbase_of(s);
  const u16* Zm = (const u16*)(p.ws + OFF_D + D_ZM);
  u16* LA = (u16*)(p.ws + OFF_D + D_LA);
  u16* LB = (u16*)(p.ws + OFF_D + D_LB);
  const float w0 = p.in[29][(l * 4 + 0) * 256 + c], w1 = p.in[29][(l * 4 + 1) * 256 + c], w2 = p.in[29][(l * 4 + 2) * 256 + c],
              w3 = p.in[29][(l * 4 + 3) * 256 + c];
  const float cb = p.in[30][l * 256 + c];
  float xm3 = lru_xin(p, Zm, l, s, rowbase, t0 - 3, c), xm2 = lru_xin(p, Zm, l, s, rowbase, t0 - 2, c),
        xm1 = lru_xin(p, Zm, l, s, rowbase, t0 - 1, c);
  u16 xin[32];
#pragma unroll
  for (int tt = 0; tt < 32; ++tt) xin[tt] = (tt < nT) ? Zm[(size_t)(rowbase + t0 + tt) * ZW + 1280 + c] : (u16)0;
#pragma unroll
  for (int tt = 0; tt < 32; ++tt) {
    const float x0 = bf2f(xin[tt]);
    sX[tt * 256 + c] = (tt < nT) ? (w0 * xm3 + w1 * xm2 + w2 * xm1 + w3 * x0 + cb) : 0.f;
    xm3 = xm2; xm2 = xm1; xm1 = x0;
  }
  __syncthreads();
  const int blk = __builtin_amdgcn_readfirstlane(c >> 6), d = c & 63;
  const float* wa = p.in[31] + (size_t)(l * 4 + blk) * 4096;
  const float* wx = p.in[33] + (size_t)(l * 4 + blk) * 4096;
  const float ba = p.in[32][l * 256 + c], bx = p.in[34][l * 256 + c];
  const float sp = softplusf_(-p.in[35][l * 256 + c]);
  for (int b8 = 0; b8 * 8 < nT; ++b8) {
    float ra[8], ia[8];
#pragma unroll
    for (int tt = 0; tt < 8; ++tt) { ra[tt] = 0.f; ia[tt] = 0.f; }
#pragma unroll 4
    for (int k = 0; k < 64; ++k) {
      const float wav = wa[k * 64 + d], wxv = wx[k * 64 + d];
#pragma unroll
      for (int tt = 0; tt < 8; ++tt) {
        const float xv = sX[(b8 * 8 + tt) * 256 + blk * 64 + k];
        ra[tt] += xv * wav; ia[tt] += xv * wxv;
      }
    }
#pragma unroll
    for (int tt = 0; tt < 8; ++tt) {
      const int t = b8 * 8 + tt;
      if (t < nT) {
        const float r = sigm(ra[tt] + ba), ig = sigm(ia[tt] + bx);
        const float la = -8.f * r * sp;
        const float bb = sqrtf(-expm1f(2.f * la)) * (ig * sX[t * 256 + c]);
        const size_t row = (size_t)(rowbase + t0 + t);
        LA[row * 256 + c] = f2bf(la);
        LB[row * 256 + c] = f2bf(bb);
      }
    }
  }
  if (t0 + nT == T) {
    float* o = st_out(p, O_PLRUC, O_SLRUC, l, s, 3 * 256);
#pragma unroll
    for (int r = 0; r < 3; ++r) o[r * 256 + c] = lru_xin(p, Zm, l, s, rowbase, T - 3 + r, c);
  }
}
DEV void lru_pass2(const P& p, int l, int s) {
  const int c = tid_();
  const int T = (s < 8) ? TP : 8;
  const int rowbase = rowbase_of(s);
  const u16* Zm = (const u16*)(p.ws + OFF_D + D_ZM);
  const u16* LA = (const u16*)(p.ws + OFF_D + D_LA);
  const u16* LB = (const u16*)(p.ws + OFF_D + D_LB);
  u16* BR = (u16*)(p.ws + OFF_D + D_BR);
  float h = (s >= 8) ? p.in[6][(size_t)(l * 128 + (s - 8)) * 256 + c] : 0.f;
  u16 na[8], nb[8], ng[8];
#pragma unroll
  for (int tt = 0; tt < 8; ++tt) {
    const size_t row = (size_t)(rowbase + tt);
    na[tt] = LA[row * 256 + c]; nb[tt] = LB[row * 256 + c]; ng[tt] = Zm[row * ZW + 1536 + c];
  }
  for (int t0 = 0; t0 < T; t0 += 8) {
    float la[8], lb[8], lg[8];
#pragma unroll
    for (int tt = 0; tt < 8; ++tt) { la[tt] = bf2f(na[tt]); lb[tt] = bf2f(nb[tt]); lg[tt] = bf2f(ng[tt]); }
    if (t0 + 8 < T) {
#pragma unroll
      for (int tt = 0; tt < 8; ++tt) {
        const size_t row = (size_t)(rowbase + t0 + 8 + tt);
        na[tt] = LA[row * 256 + c]; nb[tt] = LB[row * 256 + c]; ng[tt] = Zm[row * ZW + 1536 + c];
      }
    }
#pragma unroll
    for (int tt = 0; tt < 8; ++tt) {
      h = __expf(la[tt]) * h + lb[tt];
      BR[(size_t)(rowbase + t0 + tt) * 1024 + 512 + c] = f2bf(h * geluf_(lg[tt]));
    }
  }
  st_out(p, O_PLRU, O_SLRU, l, s, 256)[c] = h;
}


DEV void lru_prompt(const P& p, int l, int s, int cg, float* smem) {
  const int tid = tid_(), lane = tid & 63;
  const int w = __builtin_amdgcn_readfirstlane(tid >> 6);
  const int c = cg * 64 + lane;
  float* sE = smem;
  float* sL = smem + 256;
  const int rowbase = rowbase_of(s);
  const int tbeg = w * 512, tend = (w == 3) ? TP : tbeg + 512;
  const u16* Zm = (const u16*)(p.ws + OFF_D + D_ZM);
  const u16* LA = (const u16*)(p.ws + OFF_D + D_LA);
  const u16* LB = (const u16*)(p.ws + OFF_D + D_LB);
  u16* BR = (u16*)(p.ws + OFF_D + D_BR);
  {
    float h = 0.f, sl = 0.f;
    for (int t0 = tbeg; t0 < tend; t0 += 8) {
      u16 na[8], nb[8];
#pragma unroll
      for (int tt = 0; tt < 8; ++tt) { const size_t row = (size_t)(rowbase + t0 + tt); na[tt] = LA[row * 256 + c]; nb[tt] = LB[row * 256 + c]; }
#pragma unroll
      for (int tt = 0; tt < 8; ++tt) { const float la = bf2f(na[tt]); h = __expf(la) * h + bf2f(nb[tt]); sl += la; }
    }
    sE[w * 64 + lane] = h; sL[w * 64 + lane] = sl;
  }
  __syncthreads();
  float h = 0.f;
  for (int k = 0; k < w; ++k) h = __expf(sL[k * 64 + lane]) * h + sE[k * 64 + lane];
  u16 na[8], nb[8], ng[8];
#pragma unroll
  for (int tt = 0; tt < 8; ++tt) {
    const size_t row = (size_t)(rowbase + tbeg + tt);
    na[tt] = LA[row * 256 + c]; nb[tt] = LB[row * 256 + c]; ng[tt] = Zm[row * ZW + 1536 + c];
  }
  for (int t0 = tbeg; t0 < tend; t0 += 8) {
    float la[8], lb[8], lg[8];
#pragma unroll
    for (int tt = 0; tt < 8; ++tt) { la[tt] = bf2f(na[tt]); lb[tt] = bf2f(nb[tt]); lg[tt] = bf2f(ng[tt]); }
    if (t0 + 8 < tend) {
#pragma unroll
      for (int tt = 0; tt < 8; ++tt) {
        const size_t row = (size_t)(rowbase + t0 + 8 + tt);
        na[tt] = LA[row * 256 + c]; nb[tt] = LB[row * 256 + c]; ng[tt] = Zm[row * ZW + 1536 + c];
      }
    }
#pragma unroll
    for (int tt = 0; tt < 8; ++tt) {
      h = __expf(la[tt]) * h + lb[tt];
      BR[(size_t)(rowbase + t0 + tt) * 1024 + 512 + c] = f2bf(h * geluf_(lg[tt]));
    }
  }
  if (w == 3) st_out(p, O_PLRU, O_SLRU, l, s, 256)[c] = h;
}

DEV void conv_item(const P& p, int l, int s, int t0, float* smem) {
  float* sG = smem;
  const int c = tid_(), lane = c & 63, w = c >> 6;
  const int T = (s < 8) ? TP : 8;
  const int nT = min(32, T - t0);
  const int rowbase = rowbase_of(s);
  const u16* Zm = (const u16*)(p.ws + OFF_D + D_ZM);
  u16* BR = (u16*)(p.ws + OFF_D + D_BR);
#pragma unroll 8
  for (int rr = 0; rr < 30 + nT; ++rr) {
    const int tau = t0 - 30 + rr;
    float gl = 0.f;
    if (tau >= 0) {
      const size_t row = (size_t)(rowbase + tau);
      gl = bf2f(Zm[row * ZW + 1792 + c]) * sigm(bf2f(Zm[row * ZW + 2048 + c]));
    } else if (s >= 8) gl = p.in[8][((size_t)(l * 128 + (s - 8)) * 30 + (30 + tau)) * 256 + c];
    sG[rr * 256 + c] = gl;
  }
  if (t0 + nT == T) {
    float* o = st_out(p, O_PCONV, O_SCONV, l, s, 30 * 256);
    for (int r = 0; r < 30; ++r) o[r * 256 + c] = sG[(nT + r) * 256 + c];
  }
  float wv[31];
#pragma unroll
  for (int j = 0; j < 31; ++j) wv[j] = p.in[36][(size_t)(l * 31 + j) * 256 + c];
  const float cb = p.in[37][l * 256 + c];
  for (int tt = 0; tt < nT; ++tt) {
    float y = cb;
#pragma unroll
    for (int j = 0; j < 31; ++j) y += wv[j] * sG[(tt + j) * 256 + c];
    sG[tt * 256 + c] = y;
  }
  __syncthreads();
  const float4 lg4 = *(const float4*)(p.in[38] + l * 256 + lane * 4);
  const float4 lb4 = *(const float4*)(p.in[39] + l * 256 + lane * 4);
  for (int tt = w; tt < nT; tt += 4) {
    const float4 v = *(const float4*)&sG[tt * 256 + lane * 4];
    float s1 = v.x + v.y + v.z + v.w;
    s1 = wave_sum(s1);
    const float mean = s1 * (1.f / 256.f);
    const float a0 = v.x - mean, a1 = v.y - mean, a2 = v.z - mean, a3 = v.w - mean;
    float s2 = a0 * a0 + a1 * a1 + a2 * a2 + a3 * a3;
    s2 = wave_sum(s2);
    const float rstd = rsqrtf(s2 * (1.f / 256.f) + 1e-6f);
    uint2 ov;
    ov.x = pack2(siluf_(a0 * rstd * lg4.x + lb4.x), siluf_(a1 * rstd * lg4.y + lb4.y));
    ov.y = pack2(siluf_(a2 * rstd * lg4.z + lb4.z), siluf_(a3 * rstd * lg4.w + lb4.w));
    *(uint2*)(BR + (size_t)(rowbase + t0 + tt) * 1024 + 768 + lane * 4) = ov;
  }
}


DEV bool tile_of(int t, int G, int N, int NT, int& mt, int& nt) {
  const int r = t / G, b = t - r * G;
  const int q = r * G + (b & 7) * (G >> 3) + (b >> 3);
  if (q >= N) return false;
  const int P = NT >> 3, wl = NT & 7, full = P * MT * 8;
  if (q < full) { const int panel = q / (MT * 8), rem = q - panel * MT * 8; mt = rem >> 3; nt = panel * 8 + (rem & 7); }
  else { const int q2 = q - full; mt = q2 / wl; nt = P * 8 + (q2 - mt * wl); }
  return true;
}
#define TILE_LOOP(NT_, CALL) do { const int N_ = MT * (NT_); const int Nr_ = ((N_ + G - 1) / G) * G; \
    for (int t = B; t < Nr_; t += G) { int mt, nt; if (tile_of(t, G, N_, (NT_), mt, nt)) { CALL; } } } while (0)
__global__ void __launch_bounds__(256, 2) mega(P p) {
  __shared__ __attribute__((aligned(16))) float smem[16128];
  __shared__ int s_item;
  cg::grid_group grid = cg::this_grid();
  u16* sA = (u16*)smem;
  u16* sB = sA + 128 * 72;
  const u16* W = (const u16*)(p.ws + OFF_W);
  const u16* XN = (const u16*)(p.ws + OFF_XN);
  float* X = (float*)(p.ws + OFF_X);
  u16* H = (u16*)(p.ws + OFF_D + D_H);
  u16* Zm = (u16*)(p.ws + OFF_D + D_ZM);
  const u16* M = (const u16*)(p.ws + OFF_D + D_M);
  int* ctr = (int*)p.ws;
  const int G = gridDim.x, B = blockIdx.x;

  for (int l = 0; l < 2; ++l) {
    phase_norm(p, l, 0);
    phase_convw(p, l, smem);
    grid.sync();
    TILE_LOOP(22, dual_tile256(XN, W + W_GU1, mt, nt, H, sA, sB));
    grid.sync();
    TILE_LOOP(8, resid_tile(H, 2816, 2816, W + W_DN1, mt, nt, X, 0.5f, sA, sB));
    grid.sync();
    phase_norm(p, l, 1, smem);
    grid.sync();
    TILE_LOOP(9, zm_tile256(XN, W + W_INM, mt, nt, Zm, sA, sB));
    grid.sync();
    for (;;) {
      __syncthreads();
      if (threadIdx.x == 0) s_item = atomicAdd(&ctr[l * 2], 1);
      __syncthreads();
      const int it = s_item;
      if (it >= 2856) break;
      int ll = l;
      asm volatile("" : "+s"(ll));
      if (it < 128) s5_prompt(p, ll, it >> 4, it & 15, smem);
      else if (it < 1696) delta_pre(p, ll, it - 128, smem);
      else if (it < 2216) { int i = it - 1696; lru_pass1(p, ll, i / 65, (i % 65) * 32, smem); }
      else if (it < 2344) lru_pass1(p, ll, 8 + (it - 2216), 0, smem);
      else { int i = it - 2344; s5_block(p, ll, 8 + (i >> 2), i & 3, smem); }
    }
    grid.sync();
    for (;;) {
      __syncthreads();
      if (threadIdx.x == 0) s_item = atomicAdd(&ctr[l * 2 + 1], 1);
      __syncthreads();
      const int it = s_item;
      if (it >= 1900) break;
      int ll = l;
      asm volatile("" : "+s"(ll));
      if (it < 32) delta_seq(p, ll, it >> 2, it & 3, smem);
      else if (it < 64) { int i = it - 32; lru_prompt(p, ll, i >> 2, i & 3, smem); }
      else if (it < 612) { int i = it - 64; dual_tile<1>((const u16*)(p.ws + OFF_D + D_Y5), 256, 256, W + W_GLU, i % MT, i / MT, (u16*)(p.ws + OFF_D + D_BR), 1024, 256, p.in[28] + ll * 512, sA, sB); }
      else if (it < 1124) { int i = it - 612; delta_seq(p, ll, 8 + (i >> 2), i & 3, smem); }
      else if (it < 1252) lru_pass2(p, ll, 8 + (it - 1124));
      else if (it < 1772) { int i = it - 1252; conv_item(p, ll, i / 65, (i % 65) * 32, smem); }
      else conv_item(p, ll, 8 + (it - 1772), 0, smem);
    }
    grid.sync();
    TILE_LOOP(16, g4_tile(p, mt, nt, sA, sB));
    grid.sync();
    TILE_LOOP(8, resid_tile(M, 1024, 1024, W + W_OUT, mt, nt, X, 1.0f, sA, sB));
    grid.sync();
    phase_norm(p, l, 2);
    grid.sync();
    TILE_LOOP(22, dual_tile256(XN, W + W_GU2, mt, nt, H, sA, sB));
    grid.sync();
    TILE_LOOP(8, resid_tile(H, 2816, 2816, W + W_DN2, mt, nt, X, 0.5f, sA, sB));
    grid.sync();
  }
  phase_norm(p, 0, 3);
}

extern "C" void kernel_launch(void* const* d_in, const int* in_sizes, int n_in, void* d_out, int out_size, void* d_ws,
                              size_t ws_size, hipStream_t stream) {
  P p{};
  for (int i = 0; i < 46; ++i) p.in[i] = (const float*)d_in[i];
  p.out = (float*)d_out;
  p.ws = (char*)d_ws;
  static int grid_blocks = 0;
  if (!grid_blocks) {
    int dev = 0, cus = 0, per = 0;
    hipGetDevice(&dev);
    hipDeviceGetAttribute(&cus, hipDeviceAttributeMultiprocessorCount, dev);
    hipOccupancyMaxActiveBlocksPerMultiprocessor(&per, mega, 256, 0);
    if (per > 2) per = 2;
    if (per < 1) per = 1;
    grid_blocks = cus * per;
  }
  if (ws_size < WS_NEED) fprintf(stderr, "workspace too small: %zu < %zu\n", ws_size, (size_t)WS_NEED);
  hipMemsetAsync(d_ws, 0, 256, stream);
  void* args[] = {&p};
  hipError_t e = hipLaunchCooperativeKernel((void*)mega, dim3(grid_blocks), dim3(256), args, 0, stream);
  if (e != hipSuccess) fprintf(stderr, "cooperative launch failed: %s (grid %d)\n", hipGetErrorString(e), grid_blocks);
}
```

```cpp
#include <hip/hip_runtime.h>
#include <hip/hip_bf16.h>
#include <hip/hip_cooperative_groups.h>
#include <cstdio>
namespace cg = cooperative_groups;

typedef unsigned short u16;
using bf16x8 = __attribute__((ext_vector_type(8))) short;
using f32x4 = __attribute__((ext_vector_type(4))) float;
using u32x4 = __attribute__((ext_vector_type(4))) unsigned int;
#define DEV __device__ __forceinline__

struct P { const float* in[46]; float* out; char* ws; };

constexpr int NTOK = 17536, TP = 2064, NPR = 16512, ZW = 2304, MT = 137;
constexpr size_t OFF_X = 65536;
constexpr size_t OFF_W = OFF_X + (size_t)NTOK * 1024 * 4;
constexpr size_t W_GU1 = 0, W_DN1 = 5767168, W_INM = 8650752, W_ING = 11010048, W_BR = 15204352, W_OUT = 16252928,
                 W_GLU = 17301504, W_GU2 = 17432576, W_DN2 = 23199744, W_END = 26083328;
constexpr size_t OFF_XN = OFF_W + W_END * 2;
constexpr size_t OFF_BA = OFF_XN + (size_t)NTOK * 1024 * 2;
constexpr size_t OFF_D = OFF_BA + (size_t)NTOK * 8 * 4;
constexpr size_t D_H = 0, D_ZM = 0, D_M = 0, D_BR = 80805888, D_LA = 116719616, D_LB = 125698048, D_Y5 = 134676480;
constexpr size_t WS_NEED = OFF_D + 143654912;
constexpr size_t OFF_GAMMA = 1024;
constexpr size_t O_YS = 16777216, O_PDELTA = 17825792, O_PDCONV = 18087936, O_PS5RE = 18124800, O_PS5IM = 18141184,
                 O_PLRU = 18157568, O_PLRUC = 18161664, O_PCONV = 18173952, O_SDELTA = 18296832, O_SDCONV = 22491136,
                 O_SS5RE = 23080960, O_SS5IM = 23343104, O_SLRU = 23605248, O_SLRUC = 23670784, O_SCONV = 23867392;

DEV u16 f2bf(float f) { unsigned u = __float_as_uint(f); u += 0x7fffu + ((u >> 16) & 1u); return (u16)(u >> 16); }
DEV float bf2f(u16 h) { return __uint_as_float(((unsigned)h) << 16); }
DEV float bflo(unsigned u) { return __uint_as_float(u << 16); }
DEV float bfhi(unsigned u) { return __uint_as_float(u & 0xffff0000u); }
DEV unsigned pack2(float a, float b) { return (unsigned)f2bf(a) | ((unsigned)f2bf(b) << 16); }
DEV float sigm(float x) { return 1.f / (1.f + __expf(-x)); }
DEV float siluf_(float x) { return x / (1.f + __expf(-x)); }
DEV float softplusf_(float x) { return fmaxf(x, 0.f) + log1pf(__expf(-fabsf(x))); }
DEV float geluf_(float x) { float u = 0.7978845608028654f * (x + 0.044715f * x * x * x); return 0.5f * x * (1.f + tanhf(u)); }
DEV float wave_sum(float v) {
#pragma unroll
  for (int o = 32; o > 0; o >>= 1) v += __shfl_xor(v, o, 64);
  return v;
}
DEV void unpack16(uint4 a, uint4 b, float (&x)[16]) {
  x[0] = bflo(a.x); x[1] = bfhi(a.x); x[2] = bflo(a.y); x[3] = bfhi(a.y); x[4] = bflo(a.z); x[5] = bfhi(a.z); x[6] = bflo(a.w); x[7] = bfhi(a.w);
  x[8] = bflo(b.x); x[9] = bfhi(b.x); x[10] = bflo(b.y); x[11] = bfhi(b.y); x[12] = bflo(b.z); x[13] = bfhi(b.z); x[14] = bflo(b.w); x[15] = bfhi(b.w);
}
DEV float* st_out(const P& p, size_t offP, size_t offS, int l, int s, int sz) {
  return s < 8 ? p.out + offP + (size_t)(l * 8 + s) * sz : p.out + offS + (size_t)(l * 128 + (s - 8)) * sz;
}
DEV int tid_() { int t = threadIdx.x; asm volatile("" : "+v"(t)); return t; }
DEV int rowbase_of(int s) { return s < 8 ? s * TP : NPR + (s - 8) * 8; }

DEV void phase_norm(const P& p, int l, int kind, float* smem = nullptr) {
  const int tid0 = tid_(); const int lane = tid0 & 63, w = tid0 >> 6;
  float* X = (float*)(p.ws + OFF_X);
  u16* XN = (u16*)(p.ws + OFF_XN);
  float* BA = (float*)(p.ws + OFF_BA);
  const float* gain = kind == 0 ? p.in[10] + l * 1024 : kind == 1 ? p.in[13] + l * 1024 : kind == 2 ? p.in[42] + l * 1024 : p.in[45];
  float4 g4[4];
#pragma unroll
  for (int i = 0; i < 4; ++i) g4[i] = *(const float4*)(gain + i * 256 + lane * 4);
  const bool first = (kind == 0 && l == 0);
  if (kind == 1) {
    const float* wi0 = p.in[14] + (size_t)l * 1024 * 6408 + 1024;
#pragma unroll
    for (int q = 0; q < 4; ++q) {
      const int k = tid0 + 256 * q;
      const float4 a = *(const float4*)(wi0 + (size_t)k * 6408), c = *(const float4*)(wi0 + (size_t)k * 6408 + 4);
      smem[0 * 1024 + k] = a.x; smem[1 * 1024 + k] = a.y; smem[2 * 1024 + k] = a.z; smem[3 * 1024 + k] = a.w;
      smem[4 * 1024 + k] = c.x; smem[5 * 1024 + k] = c.y; smem[6 * 1024 + k] = c.z; smem[7 * 1024 + k] = c.w;
    }
    __syncthreads();
  }
  for (int r = blockIdx.x * 4 + w; r < NTOK; r += gridDim.x * 4) {
    const float* src;
    int b = 0, t = 0;
    if (r < NPR) { b = r / TP; t = r - b * TP; }
    if (first) {
      if (r < NPR) src = t < 16 ? p.in[9] + t * 1024 : p.in[0] + ((size_t)b * 2048 + (t - 16)) * 1024;
      else src = p.in[1] + (size_t)(r - NPR) * 1024;
    } else src = X + (size_t)r * 1024;
    float4 v[4];
    float ss = 0.f;
#pragma unroll
    for (int i = 0; i < 4; ++i) {
      v[i] = *(const float4*)(src + i * 256 + lane * 4);
      ss += v[i].x * v[i].x + v[i].y * v[i].y + v[i].z * v[i].z + v[i].w * v[i].w;
    }
    ss = wave_sum(ss);
    const float inv = rsqrtf(ss * (1.f / 1024.f) + 1e-6f);
    if (first) {
#pragma unroll
      for (int i = 0; i < 4; ++i) *(float4*)(X + (size_t)r * 1024 + i * 256 + lane * 4) = v[i];
    }
#pragma unroll
    for (int i = 0; i < 4; ++i) {
      v[i].x *= inv * g4[i].x; v[i].y *= inv * g4[i].y; v[i].z *= inv * g4[i].z; v[i].w *= inv * g4[i].w;
    }
    if (kind == 3) {
      float* dst;
      if (r < NPR) { if (t < 16) continue; dst = p.out + ((size_t)b * 2048 + (t - 16)) * 1024; }
      else dst = p.out + O_YS + (size_t)(r - NPR) * 1024;
#pragma unroll
      for (int i = 0; i < 4; ++i) *(float4*)(dst + i * 256 + lane * 4) = v[i];
    } else {
#pragma unroll
      for (int i = 0; i < 4; ++i) {
        uint2 o; o.x = pack2(v[i].x, v[i].y); o.y = pack2(v[i].z, v[i].w);
        *(uint2*)(XN + (size_t)r * 1024 + i * 256 + lane * 4) = o;
      }
      if (kind == 1) {
        float acc[8];
#pragma unroll
        for (int j = 0; j < 8; ++j) acc[j] = 0.f;
#pragma unroll
        for (int i = 0; i < 4; ++i) {
#pragma unroll
          for (int j = 0; j < 8; ++j) {
            const float4 wv = *(const float4*)(smem + j * 1024 + i * 256 + lane * 4);
            acc[j] += v[i].x * wv.x + v[i].y * wv.y + v[i].z * wv.z + v[i].w * wv.w;
          }
        }
#pragma unroll
        for (int j = 0; j < 8; ++j) acc[j] = wave_sum(acc[j]);
        if (lane == 0) {
          *(float4*)(BA + (size_t)r * 8) = make_float4(acc[0], acc[1], acc[2], acc[3]);
          *(float4*)(BA + (size_t)r * 8 + 4) = make_float4(acc[4], acc[5], acc[6], acc[7]);
        }
      }
    }
  }
}

DEV int wmap(int mode, int R, int c0, int half) {
  if (mode == 0) return c0 + R;
  if (mode == 1) { int tile = R >> 7, r = R & 127; int type = (r >> 4) & 1; return type * half + tile * 64 + (r >> 5) * 16 + (r & 15); }
  return R < 1024 ? R : R + 8;
}
DEV void convT(const float* __restrict__ src, int ld, int K, int NR, u16* __restrict__ dst, int mode, int c0, int half,
               int& tbase, float* smem) {
  const int tid = tid_(), G = gridDim.x;
  const int kt = K >> 6, ntile = kt * (NR >> 6);
  int start = ((int)blockIdx.x - tbase) % G;
  if (start < 0) start += G;
  for (int t = start; t < ntile; t += G) {
    const int rt = t / kt, k0 = (t - rt * kt) * 64, R0 = rt * 64;
    __syncthreads();
    const int rr = tid & 63;
    const int col = wmap(mode, R0 + rr, c0, half);
#pragma unroll
    for (int i = 0; i < 16; ++i) {
      int kk = i * 4 + (tid >> 6);
      smem[kk * 65 + rr] = src[(size_t)(k0 + kk) * ld + col];
    }
    __syncthreads();
    const int r2 = tid >> 2, seg = (tid & 3) * 16;
    unsigned o[8];
#pragma unroll
    for (int e = 0; e < 8; ++e) o[e] = pack2(smem[(seg + 2 * e) * 65 + r2], smem[(seg + 2 * e + 1) * 65 + r2]);
    uint4* d = (uint4*)(dst + (size_t)(R0 + r2) * K + k0 + seg);
    d[0] = make_uint4(o[0], o[1], o[2], o[3]);
    d[1] = make_uint4(o[4], o[5], o[6], o[7]);
  }
  tbase = (tbase + ntile) % G;
}
DEV void phase_convw(const P& p, int l, float* smem) {
  u16* W = (u16*)(p.ws + OFF_W);
  int tb = 0;
  convT(p.in[11] + (size_t)l * 1024 * 5632, 5632, 1024, 5632, W + W_GU1, 1, 0, 2816, tb, smem);
  convT(p.in[12] + (size_t)l * 2816 * 1024, 1024, 2816, 1024, W + W_DN1, 0, 0, 0, tb, smem);
  convT(p.in[14] + (size_t)l * 1024 * 6408, 6408, 1024, 2304, W + W_INM, 2, 0, 0, tb, smem);
  convT(p.in[14] + (size_t)l * 1024 * 6408, 6408, 1024, 4096, W + W_ING, 0, 2312, 0, tb, smem);
  for (int n = 0; n < 4; ++n)
    convT(p.in[40] + (size_t)(l * 4 + n) * 256 * 1024, 1024, 256, 1024, W + W_BR + (size_t)n * 1024 * 256, 0, 0, 0, tb, smem);
  convT(p.in[41] + (size_t)l * 1024 * 1024, 1024, 1024, 1024, W + W_OUT, 0, 0, 0, tb, smem);
  convT(p.in[27] + (size_t)l * 256 * 512, 512, 256, 512, W + W_GLU, 1, 0, 256, tb, smem);
  convT(p.in[43] + (size_t)l * 1024 * 5632, 5632, 1024, 5632, W + W_GU2, 1, 0, 2816, tb, smem);
  convT(p.in[44] + (size_t)l * 2816 * 1024, 1024, 2816, 1024, W + W_DN2, 0, 0, 0, tb, smem);
}

template <int BN>
DEV void gemm_acc(const u16* __restrict__ A, int lda, const u16* __restrict__ Bt, int ldb, int K, f32x4 (&acc)[4][BN / 32],
                  u16* sA, u16* sB) {
  constexpr int NI = BN / 32;
  const int tid = tid_(), lane = tid & 63, w = tid >> 6, wm = w >> 1, wn = w & 1;
  const int lrow = tid >> 3, lseg = (tid & 7) * 8;
  const u16* ga = A + (size_t)lrow * lda + lseg;
  const u16* gb = Bt + (size_t)lrow * ldb + lseg;
  u16* wa = sA + lrow * 72 + lseg;
  u16* wb = sB + lrow * 72 + lseg;
  const u16* fa = sA + (wm * 64 + (lane & 15)) * 72 + (lane >> 4) * 8;
  const u16* fb = sB + (wn * (BN / 2) + (lane & 15)) * 72 + (lane >> 4) * 8;
  u32x4 pa0, pa1, pa2, pa3, pb0, pb1, pb2, pb3, qa0, qa1, qa2, qa3, qb0, qb1, qb2, qb3;
#define GA_LOAD(X, koff) do { const u16* _ga = ga + (koff); const u16* _gb = gb + (koff); \
    X##a0 = *(const u32x4*)(_ga); X##a1 = *(const u32x4*)(_ga + (size_t)32 * lda); X##a2 = *(const u32x4*)(_ga + (size_t)64 * lda); X##a3 = *(const u32x4*)(_ga + (size_t)96 * lda); \
    X##b0 = *(const u32x4*)(_gb); X##b1 = *(const u32x4*)(_gb + (size_t)32 * ldb); \
    if (BN == 128) { X##b2 = *(const u32x4*)(_gb + (size_t)64 * ldb); X##b3 = *(const u32x4*)(_gb + (size_t)96 * ldb); } } while (0)
#define GA_WRITE(X) do { *(u32x4*)(wa) = X##a0; *(u32x4*)(wa + 32 * 72) = X##a1; *(u32x4*)(wa + 64 * 72) = X##a2; *(u32x4*)(wa + 96 * 72) = X##a3; \
    *(u32x4*)(wb) = X##b0; *(u32x4*)(wb + 32 * 72) = X##b1; \
    if (BN == 128) { *(u32x4*)(wb + 64 * 72) = X##b2; *(u32x4*)(wb + 96 * 72) = X##b3; } } while (0)
#define GA_COMPUTE() do { _Pragma("unroll") for (int kk = 0; kk < 64; kk += 32) { bf16x8 a[4], b[NI]; \
    _Pragma("unroll") for (int mi = 0; mi < 4; ++mi) a[mi] = *(const bf16x8*)(fa + mi * 16 * 72 + kk); \
    _Pragma("unroll") for (int ni = 0; ni < NI; ++ni) b[ni] = *(const bf16x8*)(fb + ni * 16 * 72 + kk); \
    _Pragma("unroll") for (int mi = 0; mi < 4; ++mi) _Pragma("unroll") for (int ni = 0; ni < NI; ++ni) \
      acc[mi][ni] = __builtin_amdgcn_mfma_f32_16x16x32_bf16(b[ni], a[mi], acc[mi][ni], 0, 0, 0); } } while (0)
  GA_LOAD(p, 0);
  if (K > 64) GA_LOAD(q, 64);
  for (int k0 = 0; k0 < K; k0 += 128) {
    __syncthreads();
    GA_WRITE(p);
    __syncthreads();
    if (k0 + 128 < K) GA_LOAD(p, k0 + 128);
    GA_COMPUTE();
    if (k0 + 64 >= K) break;
    __syncthreads();
    GA_WRITE(q);
    __syncthreads();
    if (k0 + 192 < K) GA_LOAD(q, k0 + 192);
    GA_COMPUTE();
  }
#undef GA_LOAD
#undef GA_WRITE
#undef GA_COMPUTE
}

template <int MODE>
DEV void dual_tile(const u16* A, int lda, int K, const u16* Wt, int mt, int nt, u16* out, int ldo, int ocol0, const float* bias,
                   u16* sA, u16* sB) {
  f32x4 acc[4][4];
#pragma unroll
  for (int i = 0; i < 4; ++i)
#pragma unroll
    for (int j = 0; j < 4; ++j) acc[i][j] = (f32x4){0.f, 0.f, 0.f, 0.f};
  gemm_acc<128>(A + (size_t)mt * 128 * lda, lda, Wt + (size_t)nt * 128 * K, K, K, acc, sA, sB);
  const int tid0 = tid_(); const int lane = tid0 & 63, w = tid0 >> 6, wm = w >> 1, wn = w & 1;
#pragma unroll
  for (int np = 0; np < 2; ++np) {
    const int col = nt * 64 + (wn * 2 + np) * 16 + (lane >> 4) * 4;
    float4 b0 = make_float4(0.f, 0.f, 0.f, 0.f), b1 = b0;
    if (MODE == 1) { b0 = *(const float4*)(bias + col); b1 = *(const float4*)(bias + 256 + col); }
#pragma unroll
    for (int mi = 0; mi < 4; ++mi) {
      const int row = mt * 128 + wm * 64 + mi * 16 + (lane & 15);
      const f32x4 g = acc[mi][2 * np], u = acc[mi][2 * np + 1];
      float v0, v1, v2, v3;
      if (MODE == 0) { v0 = siluf_(g[0]) * u[0]; v1 = siluf_(g[1]) * u[1]; v2 = siluf_(g[2]) * u[2]; v3 = siluf_(g[3]) * u[3]; }
      else { v0 = (g[0] + b0.x) * sigm(u[0] + b1.x); v1 = (g[1] + b0.y) * sigm(u[1] + b1.y); v2 = (g[2] + b0.z) * sigm(u[2] + b1.z); v3 = (g[3] + b0.w) * sigm(u[3] + b1.w); }
      uint2 o; o.x = pack2(v0, v1); o.y = pack2(v2, v3);
      *(uint2*)(out + (size_t)row * ldo + ocol0 + col) = o;
    }
  }
}
DEV void resid_tile(const u16* A, int lda, int K, const u16* Wt, int mt, int nt, float* X, float scale, u16* sA, u16* sB) {
  f32x4 acc[4][4];
#pragma unroll
  for (int i = 0; i < 4; ++i)
#pragma unroll
    for (int j = 0; j < 4; ++j) acc[i][j] = (f32x4){0.f, 0.f, 0.f, 0.f};
  gemm_acc<128>(A + (size_t)mt * 128 * lda, lda, Wt + (size_t)nt * 128 * K, K, K, acc, sA, sB);
  const int tid0 = tid_(); const int lane = tid0 & 63, w = tid0 >> 6, wm = w >> 1, wn = w & 1;
#pragma unroll
  for (int mi = 0; mi < 4; ++mi) {
    const int row = mt * 128 + wm * 64 + mi * 16 + (lane & 15);
    float* rp = X + (size_t)row * 1024 + nt * 128 + wn * 64 + (lane >> 4) * 4;
#pragma unroll
    for (int ni = 0; ni < 4; ++ni) { f32x4* q = (f32x4*)(rp + ni * 16); *q = *q + scale * acc[mi][ni]; }
  }
}
DEV void zm_tile(const u16* A, const u16* Wt, int mt, int nt, u16* Zm, u16* sA, u16* sB) {
  f32x4 acc[4][4];
#pragma unroll
  for (int i = 0; i < 4; ++i)
#pragma unroll
    for (int j = 0; j < 4; ++j) acc[i][j] = (f32x4){0.f, 0.f, 0.f, 0.f};
  gemm_acc<128>(A + (size_t)mt * 128 * 1024, 1024, Wt + (size_t)nt * 128 * 1024, 1024, 1024, acc, sA, sB);
  const int tid0 = tid_(); const int lane = tid0 & 63, w = tid0 >> 6, wm = w >> 1, wn = w & 1;
#pragma unroll
  for (int mi = 0; mi < 4; ++mi)
#pragma unroll
    for (int ni = 0; ni < 4; ++ni) {
      const int row = mt * 128 + wm * 64 + mi * 16 + (lane & 15);
      const int col = nt * 128 + wn * 64 + ni * 16 + (lane >> 4) * 4;
      uint2 o; o.x = pack2(acc[mi][ni][0], acc[mi][ni][1]); o.y = pack2(acc[mi][ni][2], acc[mi][ni][3]);
      *(uint2*)(Zm + (size_t)row * ZW + col) = o;
    }
}

DEV void gemm_acc256(const u16* __restrict__ A, int lda, const u16* __restrict__ Bt, int ldb, int K, f32x4 (&acc)[4][8],
                     u16* sA, u16* sB) {
  const int tid = tid_(), lane = tid & 63, w = tid >> 6, wm = w >> 1, wn = w & 1;
  const int lrow = tid >> 3, lseg = (tid & 7) * 8;
  const u16* ga = A + (size_t)lrow * lda + lseg;
  const u16* gb = Bt + (size_t)lrow * ldb + lseg;
  u16* wa = sA + lrow * 72 + lseg;
  u16* wb = sB + lrow * 72 + lseg;
  const u16* fa = sA + (wm * 64 + (lane & 15)) * 72 + (lane >> 4) * 8;
  const u16* fb = sB + (wn * 128 + (lane & 15)) * 72 + (lane >> 4) * 8;
  u32x4 ra0, ra1, ra2, ra3, rb0, rb1, rb2, rb3, rb4, rb5, rb6, rb7;
  ra0 = *(const u32x4*)(ga);
  ra1 = *(const u32x4*)(ga + (size_t)32 * lda);
  ra2 = *(const u32x4*)(ga + (size_t)64 * lda);
  ra3 = *(const u32x4*)(ga + (size_t)96 * lda);
  rb0 = *(const u32x4*)(gb);
  rb1 = *(const u32x4*)(gb + (size_t)32 * ldb);
  rb2 = *(const u32x4*)(gb + (size_t)64 * ldb);
  rb3 = *(const u32x4*)(gb + (size_t)96 * ldb);
  rb4 = *(const u32x4*)(gb + (size_t)128 * ldb);
  rb5 = *(const u32x4*)(gb + (size_t)160 * ldb);
  rb6 = *(const u32x4*)(gb + (size_t)192 * ldb);
  rb7 = *(const u32x4*)(gb + (size_t)224 * ldb);
  for (int k0 = 0; k0 < K; k0 += 64) {
    __syncthreads();
    *(u32x4*)(wa) = ra0; *(u32x4*)(wa + 32 * 72) = ra1; *(u32x4*)(wa + 64 * 72) = ra2; *(u32x4*)(wa + 96 * 72) = ra3;
    *(u32x4*)(wb) = rb0; *(u32x4*)(wb + 32 * 72) = rb1; *(u32x4*)(wb + 64 * 72) = rb2; *(u32x4*)(wb + 96 * 72) = rb3;
    *(u32x4*)(wb + 128 * 72) = rb4; *(u32x4*)(wb + 160 * 72) = rb5; *(u32x4*)(wb + 192 * 72) = rb6; *(u32x4*)(wb + 224 * 72) = rb7;
    __syncthreads();
    if (k0 + 64 < K) {
      const u16* ga2 = ga + k0 + 64;
      const u16* gb2 = gb + k0 + 64;
      ra0 = *(const u32x4*)(ga2);
      ra1 = *(const u32x4*)(ga2 + (size_t)32 * lda);
      ra2 = *(const u32x4*)(ga2 + (size_t)64 * lda);
      ra3 = *(const u32x4*)(ga2 + (size_t)96 * lda);
      rb0 = *(const u32x4*)(gb2);
      rb1 = *(const u32x4*)(gb2 + (size_t)32 * ldb);
      rb2 = *(const u32x4*)(gb2 + (size_t)64 * ldb);
      rb3 = *(const u32x4*)(gb2 + (size_t)96 * ldb);
      rb4 = *(const u32x4*)(gb2 + (size_t)128 * ldb);
      rb5 = *(const u32x4*)(gb2 + (size_t)160 * ldb);
      rb6 = *(const u32x4*)(gb2 + (size_t)192 * ldb);
      rb7 = *(const u32x4*)(gb2 + (size_t)224 * ldb);
    }
#pragma unroll
    for (int kk = 0; kk < 64; kk += 32) {
      bf16x8 a[4];
#pragma unroll
      for (int mi = 0; mi < 4; ++mi) a[mi] = *(const bf16x8*)(fa + mi * 16 * 72 + kk);
#pragma unroll
      for (int nh = 0; nh < 2; ++nh) {
        bf16x8 b[4];
#pragma unroll
        for (int ni = 0; ni < 4; ++ni) b[ni] = *(const bf16x8*)(fb + (nh * 4 + ni) * 16 * 72 + kk);
#pragma unroll
        for (int mi = 0; mi < 4; ++mi)
#pragma unroll
          for (int ni = 0; ni < 4; ++ni)
            acc[mi][nh * 4 + ni] = __builtin_amdgcn_mfma_f32_16x16x32_bf16(b[ni], a[mi], acc[mi][nh * 4 + ni], 0, 0, 0);
      }
    }
  }
}
DEV void dual_tile256(const u16* A, const u16* Wt, int mt, int nt, u16* out, u16* sA, u16* sB) {
  f32x4 acc[4][8];
#pragma unroll
  for (int i = 0; i < 4; ++i)
#pragma unroll
    for (int j = 0; j < 8; ++j) acc[i][j] = (f32x4){0.f, 0.f, 0.f, 0.f};
  gemm_acc256(A + (size_t)mt * 128 * 1024, 1024, Wt + (size_t)nt * 256 * 1024, 1024, 1024, acc, sA, sB);
  const int tid0 = tid_(); const int lane = tid0 & 63, w = tid0 >> 6, wm = w >> 1, wn = w & 1;
#pragma unroll
  for (int mi = 0; mi < 4; ++mi) {
    const int row = mt * 128 + wm * 64 + mi * 16 + (lane & 15);
#pragma unroll
    for (int np = 0; np < 4; ++np) {
      const int col = (nt * 2 + wn) * 64 + np * 16 + (lane >> 4) * 4;
      const f32x4 g = acc[mi][2 * np], u = acc[mi][2 * np + 1];
      uint2 o; o.x = pack2(siluf_(g[0]) * u[0], siluf_(g[1]) * u[1]); o.y = pack2(siluf_(g[2]) * u[2], siluf_(g[3]) * u[3]);
      *(uint2*)(out + (size_t)row * 2816 + col) = o;
    }
  }
}
DEV void zm_tile256(const u16* A, const u16* Wt, int mt, int nt, u16* Zm, u16* sA, u16* sB) {
  f32x4 acc[4][8];
#pragma unroll
  for (int i = 0; i < 4; ++i)
#pragma unroll
    for (int j = 0; j < 8; ++j) acc[i][j] = (f32x4){0.f, 0.f, 0.f, 0.f};
  gemm_acc256(A + (size_t)mt * 128 * 1024, 1024, Wt + (size_t)nt * 256 * 1024, 1024, 1024, acc, sA, sB);
  const int tid0 = tid_(); const int lane = tid0 & 63, w = tid0 >> 6, wm = w >> 1, wn = w & 1;
#pragma unroll
  for (int mi = 0; mi < 4; ++mi) {
    const int row = mt * 128 + wm * 64 + mi * 16 + (lane & 15);
#pragma unroll
    for (int ni = 0; ni < 8; ++ni) {
      const int col = nt * 256 + wn * 128 + ni * 16 + (lane >> 4) * 4;
      uint2 o; o.x = pack2(acc[mi][ni][0], acc[mi][ni][1]); o.y = pack2(acc[mi][ni][2], acc[mi][ni][3]);
      *(uint2*)(Zm + (size_t)row * ZW + col) = o;
    }
  }
}
DEV void g4_tile(const P& p, int mt, int nt, u16* sA, u16* sB) {
  const u16* BR = (const u16*)(p.ws + OFF_D + D_BR);
  const u16* XN = (const u16*)(p.ws + OFF_XN);
  const u16* Wb = (const u16*)(p.ws + OFF_W) + W_BR;
  const u16* Wg = (const u16*)(p.ws + OFF_W) + W_ING;
  u16* M = (u16*)(p.ws + OFF_D + D_M);
  f32x4 accM[4][2];
#pragma unroll
  for (int i = 0; i < 4; ++i)
#pragma unroll
    for (int j = 0; j < 2; ++j) accM[i][j] = (f32x4){0.f, 0.f, 0.f, 0.f};
#pragma unroll 1
  for (int n = 0; n < 4; ++n) {
    unsigned gate[4][2][2];
    {
      f32x4 accG[4][2];
#pragma unroll
      for (int i = 0; i < 4; ++i)
#pragma unroll
        for (int j = 0; j < 2; ++j) accG[i][j] = (f32x4){0.f, 0.f, 0.f, 0.f};
      gemm_acc<64>(XN + (size_t)mt * 128 * 1024, 1024, Wg + ((size_t)n * 1024 + nt * 64) * 1024, 1024, 1024, accG, sA, sB);
#pragma unroll
      for (int i = 0; i < 4; ++i)
#pragma unroll
        for (int j = 0; j < 2; ++j) {
          gate[i][j][0] = pack2(sigm(accG[i][j][0]), sigm(accG[i][j][1]));
          gate[i][j][1] = pack2(sigm(accG[i][j][2]), sigm(accG[i][j][3]));
        }
    }
    f32x4 accP[4][2];
#pragma unroll
    for (int i = 0; i < 4; ++i)
#pragma unroll
      for (int j = 0; j < 2; ++j) accP[i][j] = (f32x4){0.f, 0.f, 0.f, 0.f};
    gemm_acc<64>(BR + (size_t)mt * 128 * 1024 + n * 256, 1024, Wb + ((size_t)n * 1024 + nt * 64) * 256, 256, 256, accP, sA, sB);
#pragma unroll
    for (int i = 0; i < 4; ++i)
#pragma unroll
      for (int j = 0; j < 2; ++j) {
        accM[i][j][0] += bflo(gate[i][j][0]) * accP[i][j][0];
        accM[i][j][1] += bfhi(gate[i][j][0]) * accP[i][j][1];
        accM[i][j][2] += bflo(gate[i][j][1]) * accP[i][j][2];
        accM[i][j][3] += bfhi(gate[i][j][1]) * accP[i][j][3];
      }
  }
  const int tid0 = tid_(); const int lane = tid0 & 63, w = tid0 >> 6, wm = w >> 1, wn = w & 1;
#pragma unroll
  for (int mi = 0; mi < 4; ++mi) {
    const int row = mt * 128 + wm * 64 + mi * 16 + (lane & 15);
#pragma unroll
    for (int ni = 0; ni < 2; ++ni) {
      const int col = nt * 64 + wn * 32 + ni * 16 + (lane >> 4) * 4;
      uint2 o; o.x = pack2(accM[mi][ni][0], accM[mi][ni][1]); o.y = pack2(accM[mi][ni][2], accM[mi][ni][3]);
      *(uint2*)(M + (size_t)row * 1024 + col) = o;
    }
  }
}

DEV void dn_conv16(const u16* __restrict__ Zm, const float* __restrict__ buf, const float* __restrict__ cw, int rowbase, int t, int c,
                   float (&o)[16]) {
#pragma unroll
  for (int e = 0; e < 16; ++e) o[e] = 0.f;
#pragma unroll
  for (int tap = 0; tap < 4; ++tap) {
    const int tau = t - 3 + tap;
    float x[16];
    if (tau >= 0) {
      const uint4* z = (const uint4*)(Zm + (size_t)(rowbase + tau) * ZW + c);
      unpack16(z[0], z[1], x);
    } else if (buf) {
      const float4* bb = (const float4*)(buf + (3 + tau) * 768 + c);
#pragma unroll
      for (int q = 0; q < 4; ++q) { float4 f = bb[q]; x[q * 4] = f.x; x[q * 4 + 1] = f.y; x[q * 4 + 2] = f.z; x[q * 4 + 3] = f.w; }
    } else {
#pragma unroll
      for (int e = 0; e < 16; ++e) x[e] = 0.f;
    }
    const float4* w4 = (const float4*)(cw + tap * 768 + c);
#pragma unroll
    for (int q = 0; q < 4; ++q) {
      float4 f = w4[q];
      o[q * 4] += f.x * x[q * 4]; o[q * 4 + 1] += f.y * x[q * 4 + 1]; o[q * 4 + 2] += f.z * x[q * 4 + 2]; o[q * 4 + 3] += f.w * x[q * 4 + 3];
    }
  }
#pragma unroll
  for (int e = 0; e < 16; ++e) o[e] = siluf_(o[e]);
}

DEV void delta_pre(const P& p, int l, int idx, float* smem) {
  float* sq = smem;
  float* sk = smem + 64 * 68;
  float* sL = smem + 2 * 64 * 68;
  float* sbeta = sL + 4096;
  float* sg = sbeta + 64;
  float* sgc = sg + 64;
  int s, h, j, pad, T;
  if (idx < 1056) { s = idx / 132; int r = idx - s * 132; h = r / 33; j = r - h * 33; pad = 48; T = TP; }
  else { int r = idx - 1056; s = 8 + (r >> 2); h = r & 3; j = 0; pad = 56; T = 8; }
  const int tid = tid_();
  const u16* Zm = (const u16*)(p.ws + OFF_D + D_ZM);
  const float* BA = (const float*)(p.ws + OFF_BA);
  const float* cw = p.in[15] + l * 4 * 768;
  const float* buf = (s >= 8) ? p.in[3] + (size_t)(l * 128 + (s - 8)) * 3 * 768 : nullptr;
  const int rowbase = rowbase_of(s);
  u16* wsb = (u16*)p.out + (size_t)idx * 20480;
  float* gamma = (float*)(p.ws + OFF_GAMMA);
  {
    const int i = tid >> 2, dq = (tid & 3) * 16;
    const int t = j * 64 + i - pad;
    float qv[16], kv[16];
    float sq_ = 0.f, sk_ = 0.f;
    if (t >= 0) {
      dn_conv16(Zm, buf, cw, rowbase, t, h * 64 + dq, qv);
      dn_conv16(Zm, buf, cw, rowbase, t, 256 + h * 64 + dq, kv);
#pragma unroll
      for (int e = 0; e < 16; ++e) { sq_ += qv[e] * qv[e]; sk_ += kv[e] * kv[e]; }
    } else {
#pragma unroll
      for (int e = 0; e < 16; ++e) { qv[e] = 0.f; kv[e] = 0.f; }
    }
    sq_ += __shfl_xor(sq_, 1, 64); sq_ += __shfl_xor(sq_, 2, 64);
    sk_ += __shfl_xor(sk_, 1, 64); sk_ += __shfl_xor(sk_, 2, 64);
    const float qs = rsqrtf(sq_ + 1e-6f) * 0.125f, ks = rsqrtf(sk_ + 1e-6f);
#pragma unroll
    for (int e = 0; e < 16; ++e) { sq[i * 68 + dq + e] = qv[e] * qs; sk[i * 68 + dq + e] = kv[e] * ks; }
  }
  if (tid < 64) {
    const int t = j * 64 + tid - pad;
    float be = 0.f, g = 0.f;
    if (t >= 0) {
      const float* ba = BA + (size_t)(rowbase + t) * 8;
      be = sigm(ba[h]);
      float a = ba[4 + h] + p.in[17][l * 4 + h];
      g = -expf(p.in[16][l * 4 + h]) * softplusf_(a);
    }
    sbeta[tid] = be;
    sg[tid] = g;
  }
  __syncthreads();
  if (tid < 64) {
    float c = 0.f;
    for (int i2 = 0; i2 <= tid; ++i2) c += sg[i2];
    sgc[tid] = c;
  }
  __syncthreads();
  {
    const int ti = tid >> 4, tj = tid & 15;
    float aL[4][4], aI[4][4];
#pragma unroll
    for (int a = 0; a < 4; ++a)
#pragma unroll
      for (int b = 0; b < 4; ++b) { aL[a][b] = 0.f; aI[a][b] = 0.f; }
    for (int d = 0; d < 64; d += 4) {
      float4 qa[4], ka[4], kb[4];
#pragma unroll
      for (int a = 0; a < 4; ++a) { qa[a] = *(const float4*)&sq[(ti + 16 * a) * 68 + d]; ka[a] = *(const float4*)&sk[(ti + 16 * a) * 68 + d]; }
#pragma unroll
      for (int b = 0; b < 4; ++b) kb[b] = *(const float4*)&sk[(tj + 16 * b) * 68 + d];
#pragma unroll
      for (int a = 0; a < 4; ++a)
#pragma unroll
        for (int b = 0; b < 4; ++b) {
          aL[a][b] += ka[a].x * kb[b].x + ka[a].y * kb[b].y + ka[a].z * kb[b].z + ka[a].w * kb[b].w;
          aI[a][b] += qa[a].x * kb[b].x + qa[a].y * kb[b].y + qa[a].z * kb[b].z + qa[a].w * kb[b].w;
        }
    }
#pragma unroll
    for (int a = 0; a < 4; ++a)
#pragma unroll
      for (int b = 0; b < 4; ++b) {
        const int i = ti + 16 * a, jj = tj + 16 * b;
        const float dec = (jj <= i) ? __expf(sgc[i] - sgc[jj]) : 0.f;
        sL[i * 64 + jj] = (jj < i) ? aL[a][b] * sbeta[i] * dec : 0.f;
        wsb[3 * 4096 + i * 64 + jj] = f2bf(aI[a][b] * dec);
      }
  }
  for (int e = tid; e < 4096; e += 256) {
    const int i = e >> 6, d = e & 63;
    wsb[2 * 4096 + e] = f2bf(sq[i * 68 + d] * __expf(sgc[i]));
  }
  for (int e = tid; e < 4096; e += 256) {
    const int d = e >> 6, i = e & 63;
    wsb[4 * 4096 + e] = f2bf(sk[i * 68 + d] * __expf(sgc[63] - sgc[i]));
  }
  if (tid == 0) gamma[idx] = __expf(sgc[63]);
  __syncthreads();
  {
    const int i = tid >> 2, dq = (tid & 3) * 16;
    const int t = j * 64 + i - pad;
    float vv[16];
    if (t >= 0) dn_conv16(Zm, buf, cw, rowbase, t, 512 + h * 64 + dq, vv);
    else {
#pragma unroll
      for (int e = 0; e < 16; ++e) vv[e] = 0.f;
    }
    const float be = sbeta[i], eg = be * __expf(sgc[i]);
#pragma unroll
    for (int e = 0; e < 16; ++e) { sq[i * 68 + dq + e] = vv[e] * be; sk[i * 68 + dq + e] *= eg; }
  }
  __syncthreads();
  {
    float* arr = (tid < 128) ? sq : sk;
    const int col = (tid >> 1) & 63, hf = tid & 1;
    for (int i = 1; i < 64; ++i) {
      float acc = 0.f;
      for (int j0 = hf * 4; j0 < i; j0 += 8) {
        const float4 l4 = *(const float4*)&sL[i * 64 + j0];
        acc -= l4.x * arr[j0 * 68 + col] + l4.y * arr[(j0 + 1) * 68 + col] + l4.z * arr[(j0 + 2) * 68 + col] + l4.w * arr[(j0 + 3) * 68 + col];
      }
      acc += __shfl_xor(acc, 1, 64);
      if (hf == 0) arr[i * 68 + col] += acc;
    }
  }
  __syncthreads();
  for (int e = tid; e < 4096; e += 256) {
    const int i = e >> 6, d = e & 63;
    wsb[e] = f2bf(sq[i * 68 + d]);
    wsb[4096 + e] = f2bf(sk[i * 68 + d]);
  }
  if (h == 0 && j == (s < 8 ? 32 : 0)) {
    float* o = st_out(p, O_PDCONV, O_SDCONV, l, s, 3 * 768);
    for (int e = tid; e < 3 * 768; e += 256) {
      const int r = e / 768, c = e - r * 768;
      o[e] = bf2f(Zm[(size_t)(rowbase + T - 3 + r) * ZW + c]);
    }
  }
}

DEV void mm64(const float* __restrict__ A, const float* __restrict__ B, float (&acc)[4][4], int ti, int tj) {
#pragma unroll 4
  for (int kk = 0; kk < 64; kk += 4) {
    float4 a[4], b[4];
#pragma unroll
    for (int x = 0; x < 4; ++x) a[x] = *(const float4*)&A[(ti + 16 * x) * 68 + kk];
#pragma unroll
    for (int y = 0; y < 4; ++y) b[y] = *(const float4*)&B[(kk + y) * 64 + tj * 4];
#pragma unroll
    for (int x = 0; x < 4; ++x) {
      acc[x][0] += a[x].x * b[0].x + a[x].y * b[1].x + a[x].z * b[2].x + a[x].w * b[3].x;
      acc[x][1] += a[x].x * b[0].y + a[x].y * b[1].y + a[x].z * b[2].y + a[x].w * b[3].y;
      acc[x][2] += a[x].x * b[0].z + a[x].y * b[1].z + a[x].z * b[2].z + a[x].w * b[3].z;
      acc[x][3] += a[x].x * b[0].w + a[x].y * b[1].w + a[x].z * b[2].w + a[x].w * b[3].w;
    }
  }
}
DEV void storeA16(float* sA, uint4 r0, uint4 r1) {
  const int tid = tid_();
  float x[16];
  unpack16(r0, r1, x);
  float* d = sA + (tid >> 2) * 68 + (tid & 3) * 16;
#pragma unroll
  for (int q = 0; q < 4; ++q) *(float4*)(d + q * 4) = make_float4(x[q * 4], x[q * 4 + 1], x[q * 4 + 2], x[q * 4 + 3]);
}

DEV void mm64h(const u16* __restrict__ A, const float* __restrict__ B, float (&acc)[4][4], int ti, int tj) {
#pragma unroll 4
  for (int kk = 0; kk < 64; kk += 4) {
    float4 a[4], b[4];
#pragma unroll
    for (int x = 0; x < 4; ++x) {
      const uint2 av = *(const uint2*)&A[(ti + 16 * x) * 72 + kk];
      a[x] = make_float4(bflo(av.x), bfhi(av.x), bflo(av.y), bfhi(av.y));
    }
#pragma unroll
    for (int y = 0; y < 4; ++y) b[y] = *(const float4*)&B[(kk + y) * 64 + tj * 4];
#pragma unroll
    for (int x = 0; x < 4; ++x) {
      acc[x][0] += a[x].x * b[0].x + a[x].y * b[1].x + a[x].z * b[2].x + a[x].w * b[3].x;
      acc[x][1] += a[x].x * b[0].y + a[x].y * b[1].y + a[x].z * b[2].y + a[x].w * b[3].y;
      acc[x][2] += a[x].x * b[0].z + a[x].y * b[1].z + a[x].z * b[2].z + a[x].w * b[3].z;
      acc[x][3] += a[x].x * b[0].w + a[x].y * b[1].w + a[x].z * b[2].w + a[x].w * b[3].w;
    }
  }
}
DEV void store16h(u16* sA, uint4 r0, uint4 r1) {
  const int tid = tid_();
  uint4* d = (uint4*)(sA + (tid >> 2) * 72 + (tid & 3) * 16);
  d[0] = r0; d[1] = r1;
}

DEV void delta_seq(const P& p, int l, int s, int h, float* smem) {
  float* sS = smem;
  float* sV = smem + 4096;
  u16* sA0 = (u16*)(smem + 8192);
  u16* sA1 = sA0 + 64 * 72;
  u16* sA2 = sA1 + 64 * 72;
  const int tid = tid_(), ti = tid >> 4, tj = tid & 15;
  const int n = (s < 8) ? 33 : 1, pad = (s < 8) ? 48 : 56;
  const int item0 = (s < 8) ? (s * 4 + h) * 33 : 1056 + (s - 8) * 4 + h;
  const int rowbase = rowbase_of(s);
  const float* s0 = (s >= 8) ? p.in[2] + (size_t)((l * 128 + (s - 8)) * 4 + h) * 4096 : nullptr;
  for (int e = tid; e < 4096; e += 256) sS[e] = s0 ? s0[e] : 0.f;
  const u16* wsb = (const u16*)p.out + (size_t)item0 * 20480;
  const float* gamma = (const float*)(p.ws + OFF_GAMMA) + item0;
  const u16* Zm = (const u16*)(p.ws + OFF_D + D_ZM);
  u16* BR = (u16*)(p.ws + OFF_D + D_BR);
  const float4 ng = *(const float4*)(p.in[18] + l * 64 + tj * 4);
  uint4 rw0, rw1, rq0, rq1, ri0, ri1, rk0, rk1;
  {
    const uint4* src = (const uint4*)(wsb + tid * 16);
    rw0 = src[512]; rw1 = src[513];
    rq0 = src[1024]; rq1 = src[1025];
    ri0 = src[1536]; ri1 = src[1537];
    rk0 = src[2048]; rk1 = src[2049];
  }
  for (int j = 0; j < n; ++j) {
    const u16* it = wsb + (size_t)j * 20480;
    uint2 uu_pf[4], zz_pf[4];
#pragma unroll
    for (int a = 0; a < 4; ++a) {
      const int i = ti + 16 * a;
      uu_pf[a] = *(const uint2*)(it + i * 64 + tj * 4);
      const int t = j * 64 + i - pad;
      zz_pf[a] = (t >= 0) ? *(const uint2*)(Zm + (size_t)(rowbase + t) * ZW + 768 + h * 64 + tj * 4) : make_uint2(0u, 0u);
    }
    const float gm = gamma[j];
    __syncthreads();
    store16h(sA0, rw0, rw1); store16h(sA1, rq0, rq1); store16h(sA2, ri0, ri1);
    __syncthreads();
    if (j + 1 < n) {
      const uint4* src = (const uint4*)(it + 20480 + tid * 16);
      rw0 = src[512]; rw1 = src[513]; rq0 = src[1024]; rq1 = src[1025]; ri0 = src[1536]; ri1 = src[1537];
    }
    float acc[4][4];
#pragma unroll
    for (int a = 0; a < 4; ++a)
#pragma unroll
      for (int c = 0; c < 4; ++c) acc[a][c] = 0.f;
    mm64h(sA0, sS, acc, ti, tj);
#pragma unroll
    for (int a = 0; a < 4; ++a) {
      const int i = ti + 16 * a;
      const uint2 uu = uu_pf[a];
      *(float4*)&sV[i * 64 + tj * 4] = make_float4(bflo(uu.x) - acc[a][0], bfhi(uu.x) - acc[a][1], bflo(uu.y) - acc[a][2], bfhi(uu.y) - acc[a][3]);
    }
    __syncthreads();
    store16h(sA0, rk0, rk1);
    if (j + 1 < n) { const uint4* src = (const uint4*)(it + 20480 + tid * 16); rk0 = src[2048]; rk1 = src[2049]; }
    float o[4][4];
#pragma unroll
    for (int a = 0; a < 4; ++a)
#pragma unroll
      for (int c = 0; c < 4; ++c) o[a][c] = 0.f;
    mm64h(sA1, sS, o, ti, tj);
    mm64h(sA2, sV, o, ti, tj);
#pragma unroll
    for (int a = 0; a < 4; ++a) {
      const int i = ti + 16 * a;
      const int t = j * 64 + i - pad;
      float ss = o[a][0] * o[a][0] + o[a][1] * o[a][1] + o[a][2] * o[a][2] + o[a][3] * o[a][3];
      ss += __shfl_xor(ss, 1, 64); ss += __shfl_xor(ss, 2, 64); ss += __shfl_xor(ss, 4, 64); ss += __shfl_xor(ss, 8, 64);
      if (t >= 0) {
        const float inv = rsqrtf(ss * (1.f / 64.f) + 1e-6f);
        const size_t row = (size_t)(rowbase + t);
        const uint2 zz = zz_pf[a];
        float y0 = o[a][0] * inv * ng.x * siluf_(bflo(zz.x));
        float y1 = o[a][1] * inv * ng.y * siluf_(bfhi(zz.x));
        float y2 = o[a][2] * inv * ng.z * siluf_(bflo(zz.y));
        float y3 = o[a][3] * inv * ng.w * siluf_(bfhi(zz.y));
        uint2 ov; ov.x = pack2(y0, y1); ov.y = pack2(y2, y3);
        *(uint2*)(BR + row * 1024 + h * 64 + tj * 4) = ov;
      }
    }
    __syncthreads();
#pragma unroll
    for (int a = 0; a < 4; ++a)
#pragma unroll
      for (int c = 0; c < 4; ++c) acc[a][c] = 0.f;
    mm64h(sA0, sV, acc, ti, tj);
#pragma unroll
    for (int a = 0; a < 4; ++a) {
      float4* sp = (float4*)&sS[(ti + 16 * a) * 64 + tj * 4];
      float4 old = *sp;
      *sp = make_float4(gm * old.x + acc[a][0], gm * old.y + acc[a][1], gm * old.z + acc[a][2], gm * old.w + acc[a][3]);
    }
  }
  __syncthreads();
  float* so = st_out(p, O_PDELTA, O_SDELTA, l, s, 4 * 4096) + h * 4096;
  for (int e = tid; e < 4096; e += 256) so[e] = sS[e];
}

DEV void s5_block(const P& p, int l, int s, int gq, float* smem) {
  const int tid = tid_(), lane = tid & 63;
  const int w = __builtin_amdgcn_readfirstlane(tid >> 6);
  const int g = gq * 4 + w;
  float* sC = smem + w * 3248;
  float* sH = sC + 2080;
  float* sU = sH + 1040;
  const int T = (s < 8) ? TP : 8;
  const int rowbase = rowbase_of(s);
  const u16* Zm = (const u16*)(p.ws + OFF_D + D_ZM);
  u16* Y5 = (u16*)(p.ws + OFF_D + D_Y5);
  const int lg_ = l * 16 + g;
  const float lr = p.in[19][lg_ * 64 + lane], li = p.in[20][lg_ * 64 + lane];
  const float dt = expf(p.in[21][lg_]);
  const float mag = expf(lr * dt);
  const float lbr = mag * cosf(li * dt), lbi = mag * sinf(li * dt);
  const float den = lr * lr + li * li;
  const float cfr = ((lbr - 1.f) * lr + lbi * li) / den, cfi = (lbi * lr - (lbr - 1.f) * li) / den;
  float xr_c[16], xi_c[16];
  {
    const float4* br4 = (const float4*)(p.in[22] + ((size_t)lg_ * 64 + lane) * 16);
    const float4* bi4 = (const float4*)(p.in[23] + ((size_t)lg_ * 64 + lane) * 16);
#pragma unroll
    for (int q = 0; q < 4; ++q) {
      float4 a = br4[q], b = bi4[q];
      xr_c[q * 4] = cfr * a.x - cfi * b.x; xi_c[q * 4] = cfr * b.x + cfi * a.x;
      xr_c[q * 4 + 1] = cfr * a.y - cfi * b.y; xi_c[q * 4 + 1] = cfr * b.y + cfi * a.y;
      xr_c[q * 4 + 2] = cfr * a.z - cfi * b.z; xi_c[q * 4 + 2] = cfr * b.z + cfi * a.z;
      xr_c[q * 4 + 3] = cfr * a.w - cfi * b.w; xi_c[q * 4 + 3] = cfr * b.w + cfi * a.w;
    }
  }
  for (int e = lane; e < 1024; e += 64) {
    const int c = e >> 6, pp = e & 63;
    sC[(c * 65 + pp) * 2] = p.in[24][(size_t)lg_ * 1024 + e];
    sC[(c * 65 + pp) * 2 + 1] = p.in[25][(size_t)lg_ * 1024 + e];
  }
  float hr = 0.f, hi = 0.f;
  if (s >= 8) {
    hr = p.in[4][((size_t)(l * 128 + (s - 8)) * 16 + g) * 64 + lane];
    hi = p.in[5][((size_t)(l * 128 + (s - 8)) * 16 + g) * 64 + lane];
  }
  const int ytt = lane >> 3, cp = (lane & 7) * 2;
  const float d0 = p.in[26][l * 256 + g * 16 + cp], d1 = p.in[26][l * 256 + g * 16 + cp + 1];
  const u16* ubase = Zm + (size_t)rowbase * ZW + 1024 + g * 16 + (size_t)(lane >> 1) * ZW + (lane & 1) * 8;
  uint4 pu = make_uint4(0u, 0u, 0u, 0u);
  if (lane < 16) pu = *(const uint4*)(ubase);
  if (lane < 16) {
    float* d = sU + (lane >> 1) * 16 + (lane & 1) * 8;
    *(float4*)(d) = make_float4(bflo(pu.x), bfhi(pu.x), bflo(pu.y), bfhi(pu.y));
    *(float4*)(d + 4) = make_float4(bflo(pu.z), bfhi(pu.z), bflo(pu.w), bfhi(pu.w));
  }
  for (int t0 = 0; t0 < T; t0 += 8) {
    __syncthreads();
    if (lane < 16 && t0 + 8 < T) pu = *(const uint4*)(ubase + (size_t)(t0 + 8) * ZW);
#pragma unroll 2
    for (int tt = 0; tt < 8; ++tt) {
      const float4 u0 = *(const float4*)(sU + tt * 16), u1 = *(const float4*)(sU + tt * 16 + 4), u2 = *(const float4*)(sU + tt * 16 + 8),
                   u3 = *(const float4*)(sU + tt * 16 + 12);
      const float u[16] = {u0.x, u0.y, u0.z, u0.w, u1.x, u1.y, u1.z, u1.w, u2.x, u2.y, u2.z, u2.w, u3.x, u3.y, u3.z, u3.w};
      float xr = 0.f, xi = 0.f;
#pragma unroll
      for (int c = 0; c < 16; ++c) { xr += xr_c[c] * u[c]; xi += xi_c[c] * u[c]; }
      const float nr = lbr * hr - lbi * hi + xr;
      const float ni = lbr * hi + lbi * hr + xi;
      hr = nr; hi = ni;
      *(float2*)&sH[(tt * 65 + lane) * 2] = make_float2(hr, hi);
    }
    __syncthreads();
    float y0 = 0.f, y1 = 0.f;
#pragma unroll 8
    for (int pp = 0; pp < 64; ++pp) {
      const float2 hv = *(const float2*)&sH[(ytt * 65 + pp) * 2];
      const float2 c0 = *(const float2*)&sC[(cp * 65 + pp) * 2];
      const float2 c1 = *(const float2*)&sC[((cp + 1) * 65 + pp) * 2];
      y0 += hv.x * c0.x - hv.y * c0.y;
      y1 += hv.x * c1.x - hv.y * c1.y;
    }
    const size_t row = (size_t)(rowbase + t0 + ytt);
    const float2 uy = *(const float2*)(sU + ytt * 16 + cp);
    y0 = geluf_(y0 + d0 * uy.x);
    y1 = geluf_(y1 + d1 * uy.y);
    *(unsigned*)(Y5 + row * 256 + g * 16 + cp) = pack2(y0, y1);
    if (lane < 16 && t0 + 8 < T) {
      float* d = sU + (lane >> 1) * 16 + (lane & 1) * 8;
      *(float4*)(d) = make_float4(bflo(pu.x), bfhi(pu.x), bflo(pu.y), bfhi(pu.y));
      *(float4*)(d + 4) = make_float4(bflo(pu.z), bfhi(pu.z), bflo(pu.w), bfhi(pu.w));
    }
  }
  st_out(p, O_PS5RE, O_SS5RE, l, s, 1024)[g * 64 + lane] = hr;
  st_out(p, O_PS5IM, O_SS5IM, l, s, 1024)[g * 64 + lane] = hi;
}


DEV void s5_prompt(const P& p, int l, int s, int g, float* smem) {
  const int tid = tid_(), lane = tid & 63;
  const int w = __builtin_amdgcn_readfirstlane(tid >> 6);
  float* sC = smem;
  float* sE = smem + 2080;
  float* sH = smem + 2080 + 512 + w * 1168;
  float* sU = sH + 1040;
  const int rowbase = rowbase_of(s);
  const int tbeg = w * 512, tend = (w == 3) ? TP : tbeg + 512;
  const u16* Zm = (const u16*)(p.ws + OFF_D + D_ZM);
  u16* Y5 = (u16*)(p.ws + OFF_D + D_Y5);
  const int lg_ = l * 16 + g;
  const float lr = p.in[19][lg_ * 64 + lane], li = p.in[20][lg_ * 64 + lane];
  const float dt = expf(p.in[21][lg_]);
  const float mag = expf(lr * dt);
  const float lbr = mag * cosf(li * dt), lbi = mag * sinf(li * dt);
  const float den = lr * lr + li * li;
  const float cfr = ((lbr - 1.f) * lr + lbi * li) / den, cfi = (lbi * lr - (lbr - 1.f) * li) / den;
  float xr_c[16], xi_c[16];
  {
    const float4* br4 = (const float4*)(p.in[22] + ((size_t)lg_ * 64 + lane) * 16);
    const float4* bi4 = (const float4*)(p.in[23] + ((size_t)lg_ * 64 + lane) * 16);
#pragma unroll
    for (int q = 0; q < 4; ++q) {
      float4 a = br4[q], b = bi4[q];
      xr_c[q * 4] = cfr * a.x - cfi * b.x; xi_c[q * 4] = cfr * b.x + cfi * a.x;
      xr_c[q * 4 + 1] = cfr * a.y - cfi * b.y; xi_c[q * 4 + 1] = cfr * b.y + cfi * a.y;
      xr_c[q * 4 + 2] = cfr * a.z - cfi * b.z; xi_c[q * 4 + 2] = cfr * b.z + cfi * a.z;
      xr_c[q * 4 + 3] = cfr * a.w - cfi * b.w; xi_c[q * 4 + 3] = cfr * b.w + cfi * a.w;
    }
  }
  for (int e = tid; e < 1024; e += 256) {
    const int c = e >> 6, pp = e & 63;
    sC[(c * 65 + pp) * 2] = p.in[24][(size_t)lg_ * 1024 + e];
    sC[(c * 65 + pp) * 2 + 1] = p.in[25][(size_t)lg_ * 1024 + e];
  }
  const u16* ubase = Zm + (size_t)rowbase * ZW + 1024 + g * 16 + (size_t)(lane >> 1) * ZW + (lane & 1) * 8;
  float hr = 0.f, hi = 0.f;
  if (w < 3) {
    uint4 pu = make_uint4(0u, 0u, 0u, 0u);
    if (lane < 16) pu = *(const uint4*)(ubase + (size_t)tbeg * ZW);
    for (int t0 = tbeg; t0 < tend; t0 += 8) {
      if (lane < 16) {
        float* d = sU + (lane >> 1) * 16 + (lane & 1) * 8;
        *(float4*)(d) = make_float4(bflo(pu.x), bfhi(pu.x), bflo(pu.y), bfhi(pu.y));
        *(float4*)(d + 4) = make_float4(bflo(pu.z), bfhi(pu.z), bflo(pu.w), bfhi(pu.w));
      }
      if (lane < 16 && t0 + 8 < tend) pu = *(const uint4*)(ubase + (size_t)(t0 + 8) * ZW);
      __builtin_amdgcn_wave_barrier();
#pragma unroll 2
      for (int tt = 0; tt < 8; ++tt) {
        const float4 u0 = *(const float4*)(sU + tt * 16), u1 = *(const float4*)(sU + tt * 16 + 4), u2 = *(const float4*)(sU + tt * 16 + 8),
                     u3 = *(const float4*)(sU + tt * 16 + 12);
        const float u[16] = {u0.x, u0.y, u0.z, u0.w, u1.x, u1.y, u1.z, u1.w, u2.x, u2.y, u2.z, u2.w, u3.x, u3.y, u3.z, u3.w};
        float xr = 0.f, xi = 0.f;
#pragma unroll
        for (int c = 0; c < 16; ++c) { xr += xr_c[c] * u[c]; xi += xi_c[c] * u[c]; }
        const float nr = lbr * hr - lbi * hi + xr;
        const float ni = lbr * hi + lbi * hr + xi;
        hr = nr; hi = ni;
      }
      __builtin_amdgcn_wave_barrier();
    }
    *(float2*)&sE[(w * 64 + lane) * 2] = make_float2(hr, hi);
  }
  __syncthreads();
  {
    const float m512 = expf(lr * dt * 512.f);
    const float pr = m512 * cosf(li * dt * 512.f), pi = m512 * sinf(li * dt * 512.f);
    float Hr = 0.f, Hi = 0.f;
    for (int k = 0; k < w; ++k) {
      const float2 e = *(const float2*)&sE[(k * 64 + lane) * 2];
      const float nr = pr * Hr - pi * Hi + e.x, ni = pr * Hi + pi * Hr + e.y;
      Hr = nr; Hi = ni;
    }
    hr = Hr; hi = Hi;
  }
  const int ytt = lane >> 3, cp = (lane & 7) * 2;
  const float d0 = p.in[26][l * 256 + g * 16 + cp], d1 = p.in[26][l * 256 + g * 16 + cp + 1];
  {
    uint4 pu = make_uint4(0u, 0u, 0u, 0u);
    if (lane < 16) pu = *(const uint4*)(ubase + (size_t)tbeg * ZW);
    for (int t0 = tbeg; t0 < tend; t0 += 8) {
      if (lane < 16) {
        float* d = sU + (lane >> 1) * 16 + (lane & 1) * 8;
        *(float4*)(d) = make_float4(bflo(pu.x), bfhi(pu.x), bflo(pu.y), bfhi(pu.y));
        *(float4*)(d + 4) = make_float4(bflo(pu.z), bfhi(pu.z), bflo(pu.w), bfhi(pu.w));
      }
      if (lane < 16 && t0 + 8 < tend) pu = *(const uint4*)(ubase + (size_t)(t0 + 8) * ZW);
      __builtin_amdgcn_wave_barrier();
#pragma unroll 2
      for (int tt = 0; tt < 8; ++tt) {
        const float4 u0 = *(const float4*)(sU + tt * 16), u1 = *(const float4*)(sU + tt * 16 + 4), u2 = *(const float4*)(sU + tt * 16 + 8),
                     u3 = *(const float4*)(sU + tt * 16 + 12);
        const float u[16] = {u0.x, u0.y, u0.z, u0.w, u1.x, u1.y, u1.z, u1.w, u2.x, u2.y, u2.z, u2.w, u3.x, u3.y, u3.z, u3.w};
        float xr = 0.f, xi = 0.f;
#pragma unroll
        for (int c = 0; c < 16; ++c) { xr += xr_c[c] * u[c]; xi += xi_c[c] * u[c]; }
        const float nr = lbr * hr - lbi * hi + xr;
        const float ni = lbr * hi + lbi * hr + xi;
        hr = nr; hi = ni;
        *(float2*)&sH[(tt * 65 + lane) * 2] = make_float2(hr, hi);
      }
      __builtin_amdgcn_wave_barrier();
      float y0 = 0.f, y1 = 0.f;
#pragma unroll 8
      for (int pp = 0; pp < 64; ++pp) {
        const float2 hv = *(const float2*)&sH[(ytt * 65 + pp) * 2];
        const float2 c0 = *(const float2*)&sC[(cp * 65 + pp) * 2];
        const float2 c1 = *(const float2*)&sC[((cp + 1) * 65 + pp) * 2];
        y0 += hv.x * c0.x - hv.y * c0.y;
        y1 += hv.x * c1.x - hv.y * c1.y;
      }
      const size_t row = (size_t)(rowbase + t0 + ytt);
      const float2 uy = *(const float2*)(sU + ytt * 16 + cp);
      y0 = geluf_(y0 + d0 * uy.x);
      y1 = geluf_(y1 + d1 * uy.y);
      *(unsigned*)(Y5 + row * 256 + g * 16 + cp) = pack2(y0, y1);
      __builtin_amdgcn_wave_barrier();
    }
  }
  if (w == 3) {
    st_out(p, O_PS5RE, O_SS5RE, l, s, 1024)[g * 64 + lane] = hr;
    st_out(p, O_PS5IM, O_SS5IM, l, s, 1024)[g * 64 + lane] = hi;
  }
}

DEV float lru_xin(const P& p, const u16* Zm, int l, int s, int rowbase, int tau, int c) {
  if (tau >= 0) return bf2f(Zm[(size_t)(rowbase + tau) * ZW + 1280 + c]);
  if (s >= 8) return p.in[7][((size_t)(l * 128 + (s - 8)) * 3 + (3 + tau)) * 256 + c];
  return 0.f;
}
DEV void lru_pass1(const P& p, int l, int s, int t0, float* smem) {
  float* sX = smem;
  const int c = tid_();
  const int T = (s < 8) ? TP : 8;
  const int nT = min(32, T - t0);
  const int rowbase = rowbase_of(s);
  const u16* Zm = (const u16*)(p.ws + OFF_D + D_ZM);
  u16* LA = (u16*)(p.ws + OFF_D + D_LA);
  u16* LB = (u16*)(p.ws + OFF_D + D_LB);
  const float w0 = p.in[29][(l * 4 + 0) * 256 + c], w1 = p.in[29][(l * 4 + 1) * 256 + c], w2 = p.in[29][(l * 4 + 2) * 256 + c],
              w3 = p.in[29][(l * 4 + 3) * 256 + c];
  const float cb = p.in[30][l * 256 + c];
  float xm3 = lru_xin(p, Zm, l, s, rowbase, t0 - 3, c), xm2 = lru_xin(p, Zm, l, s, rowbase, t0 - 2, c),
        xm1 = lru_xin(p, Zm, l, s, rowbase, t0 - 1, c);
  u16 xin[32];
#pragma unroll
  for (int tt = 0; tt < 32; ++tt) xin[tt] = (tt < nT) ? Zm[(size_t)(rowbase + t0 + tt) * ZW + 1280 + c] : (u16)0;
#pragma unroll
  for (int tt = 0; tt < 32; ++tt) {
    const float x0 = bf2f(xin[tt]);
    sX[tt * 256 + c] = (tt < nT) ? (w0 * xm3 + w1 * xm2 + w2 * xm1 + w3 * x0 + cb) : 0.f;
    xm3 = xm2; xm2 = xm1; xm1 = x0;
  }
  __syncthreads();
  const int blk = __builtin_amdgcn_readfirstlane(c >> 6), d = c & 63;
  const float* wa = p.in[31] + (size_t)(l * 4 + blk) * 4096;
  const float* wx = p.in[33] + (size_t)(l * 4 + blk) * 4096;
  const float ba = p.in[32][l * 256 + c], bx = p.in[34][l * 256 + c];
  const float sp = softplusf_(-p.in[35][l * 256 + c]);
  for (int b8 = 0; b8 * 16 < nT; ++b8) {
    float ra[16], ia[16];
#pragma unroll
    for (int tt = 0; tt < 16; ++tt) { ra[tt] = 0.f; ia[tt] = 0.f; }
#pragma unroll 4
    for (int k = 0; k < 64; ++k) {
      const float wav = wa[k * 64 + d], wxv = wx[k * 64 + d];
#pragma unroll
      for (int tt = 0; tt < 16; ++tt) {
        const float xv = sX[(b8 * 16 + tt) * 256 + blk * 64 + k];
        ra[tt] += xv * wav; ia[tt] += xv * wxv;
      }
    }
#pragma unroll
    for (int tt = 0; tt < 16; ++tt) {
      const int t = b8 * 16 + tt;
      if (t < nT) {
        const float r = sigm(ra[tt] + ba), ig = sigm(ia[tt] + bx);
        const float la = -8.f * r * sp;
        const float bb = sqrtf(-expm1f(2.f * la)) * (ig * sX[t * 256 + c]);
        const size_t row = (size_t)(rowbase + t0 + t);
        LA[row * 256 + c] = f2bf(la);
        LB[row * 256 + c] = f2bf(bb);
      }
    }
  }
  if (t0 + nT == T) {
    float* o = st_out(p, O_PLRUC, O_SLRUC, l, s, 3 * 256);
#pragma unroll
    for (int r = 0; r < 3; ++r) o[r * 256 + c] = lru_xin(p, Zm, l, s, rowbase, T - 3 + r, c);
  }
}
DEV void lru_pass2(const P& p, int l, int s) {
  const int c = tid_();
  const int T = (s < 8) ? TP : 8;
  const int rowbase = rowbase_of(s);
  const u16* Zm = (const u16*)(p.ws + OFF_D + D_ZM);
  const u16* LA = (const u16*)(p.ws + OFF_D + D_LA);
  const u16* LB = (const u16*)(p.ws + OFF_D + D_LB);
  u16* BR = (u16*)(p.ws + OFF_D + D_BR);
  float h = (s >= 8) ? p.in[6][(size_t)(l * 128 + (s - 8)) * 256 + c] : 0.f;
  u16 na[8], nb[8], ng[8];
#pragma unroll
  for (int tt = 0; tt < 8; ++tt) {
    const size_t row = (size_t)(rowbase + tt);
    na[tt] = LA[row * 256 + c]; nb[tt] = LB[row * 256 + c]; ng[tt] = Zm[row * ZW + 1536 + c];
  }
  for (int t0 = 0; t0 < T; t0 += 8) {
    float la[8], lb[8], lg[8];
#pragma unroll
    for (int tt = 0; tt < 8; ++tt) { la[tt] = bf2f(na[tt]); lb[tt] = bf2f(nb[tt]); lg[tt] = bf2f(ng[tt]); }
    if (t0 + 8 < T) {
#pragma unroll
      for (int tt = 0; tt < 8; ++tt) {
        const size_t row = (size_t)(rowbase + t0 + 8 + tt);
        na[tt] = LA[row * 256 + c]; nb[tt] = LB[row * 256 + c]; ng[tt] = Zm[row * ZW + 1536 + c];
      }
    }
#pragma unroll
    for (int tt = 0; tt < 8; ++tt) {
      h = __expf(la[tt]) * h + lb[tt];
      BR[(size_t)(rowbase + t0 + tt) * 1024 + 512 + c] = f2bf(h * geluf_(lg[tt]));
    }
  }
  st_out(p, O_PLRU, O_SLRU, l, s, 256)[c] = h;
}


DEV void lru_prompt(const P& p, int l, int s, int cg, float* smem) {
  const int tid = tid_(), lane = tid & 63;
  const int w = __builtin_amdgcn_readfirstlane(tid >> 6);
  const int c = cg * 64 + lane;
  float* sE = smem;
  float* sL = smem + 256;
  const int rowbase = rowbase_of(s);
  const int tbeg = w * 512, tend = (w == 3) ? TP : tbeg + 512;
  const u16* Zm = (const u16*)(p.ws + OFF_D + D_ZM);
  const u16* LA = (const u16*)(p.ws + OFF_D + D_LA);
  const u16* LB = (const u16*)(p.ws + OFF_D + D_LB);
  u16* BR = (u16*)(p.ws + OFF_D + D_BR);
  {
    float h = 0.f, sl = 0.f;
    for (int t0 = tbeg; t0 < tend; t0 += 8) {
      u16 na[8], nb[8];
#pragma unroll
      for (int tt = 0; tt < 8; ++tt) { const size_t row = (size_t)(rowbase + t0 + tt); na[tt] = LA[row * 256 + c]; nb[tt] = LB[row * 256 + c]; }
#pragma unroll
      for (int tt = 0; tt < 8; ++tt) { const float la = bf2f(na[tt]); h = __expf(la) * h + bf2f(nb[tt]); sl += la; }
    }
    sE[w * 64 + lane] = h; sL[w * 64 + lane] = sl;
  }
  __syncthreads();
  float h = 0.f;
  for (int k = 0; k < w; ++k) h = __expf(sL[k * 64 + lane]) * h + sE[k * 64 + lane];
  u16 na[8], nb[8], ng[8];
#pragma unroll
  for (int tt = 0; tt < 8; ++tt) {
    const size_t row = (size_t)(rowbase + tbeg + tt);
    na[tt] = LA[row * 256 + c]; nb[tt] = LB[row * 256 + c]; ng[tt] = Zm[row * ZW + 1536 + c];
  }
  for (int t0 = tbeg; t0 < tend; t0 += 8) {
    float la[8], lb[8], lg[8];
#pragma unroll
    for (int tt = 0; tt < 8; ++tt) { la[tt] = bf2f(na[tt]); lb[tt] = bf2f(nb[tt]); lg[tt] = bf2f(ng[tt]); }
    if (t0 + 8 < tend) {
#pragma unroll
      for (int tt = 0; tt < 8; ++tt) {
        const size_t row = (size_t)(rowbase + t0 + 8 + tt);
        na[tt] = LA[row * 256 + c]; nb[tt] = LB[row * 256 + c]; ng[tt] = Zm[row * ZW + 1536 + c];
      }
    }
#pragma unroll
    for (int tt = 0; tt < 8; ++tt) {
      h = __expf(la[tt]) * h + lb[tt];
      BR[(size_t)(rowbase + t0 + tt) * 1024 + 512 + c] = f2bf(h * geluf_(lg[tt]));
    }
  }
  if (w == 3) st_out(p, O_PLRU, O_SLRU, l, s, 256)[c] = h;
}

DEV void conv_item(const P& p, int l, int s, int t0, float* smem) {
  float* sG = smem;
  const int c = tid_(), lane = c & 63, w = c >> 6;
  const int T = (s < 8) ? TP : 8;
  const int nT = min(32, T - t0);
  const int rowbase = rowbase_of(s);
  const u16* Zm = (const u16*)(p.ws + OFF_D + D_ZM);
  u16* BR = (u16*)(p.ws + OFF_D + D_BR);
#pragma unroll 8
  for (int rr = 0; rr < 30 + nT; ++rr) {
    const int tau = t0 - 30 + rr;
    float gl = 0.f;
    if (tau >= 0) {
      const size_t row = (size_t)(rowbase + tau);
      gl = bf2f(Zm[row * ZW + 1792 + c]) * sigm(bf2f(Zm[row * ZW + 2048 + c]));
    } else if (s >= 8) gl = p.in[8][((size_t)(l * 128 + (s - 8)) * 30 + (30 + tau)) * 256 + c];
    sG[rr * 256 + c] = gl;
  }
  if (t0 + nT == T) {
    float* o = st_out(p, O_PCONV, O_SCONV, l, s, 30 * 256);
    for (int r = 0; r < 30; ++r) o[r * 256 + c] = sG[(nT + r) * 256 + c];
  }
  float wv[31];
#pragma unroll
  for (int j = 0; j < 31; ++j) wv[j] = p.in[36][(size_t)(l * 31 + j) * 256 + c];
  const float cb = p.in[37][l * 256 + c];
  for (int tt = 0; tt < nT; ++tt) {
    float y = cb;
#pragma unroll
    for (int j = 0; j < 31; ++j) y += wv[j] * sG[(tt + j) * 256 + c];
    sG[tt * 256 + c] = y;
  }
  __syncthreads();
  const float4 lg4 = *(const float4*)(p.in[38] + l * 256 + lane * 4);
  const float4 lb4 = *(const float4*)(p.in[39] + l * 256 + lane * 4);
  for (int tt = w; tt < nT; tt += 4) {
    const float4 v = *(const float4*)&sG[tt * 256 + lane * 4];
    float s1 = v.x + v.y + v.z + v.w;
    s1 = wave_sum(s1);
    const float mean = s1 * (1.f / 256.f);
    const float a0 = v.x - mean, a1 = v.y - mean, a2 = v.z - mean, a3 = v.w - mean;
    float s2 = a0 * a0 + a1 * a1 + a2 * a2 + a3 * a3;
    s2 = wave_sum(s2);
    const float rstd = rsqrtf(s2 * (1.f / 256.f) + 1e-6f);
    uint2 ov;
    ov.x = pack2(siluf_(a0 * rstd * lg4.x + lb4.x), siluf_(a1 * rstd * lg4.y + lb4.y));
    ov.y = pack2(siluf_(a2 * rstd * lg4.z + lb4.z), siluf_(a3 * rstd * lg4.w + lb4.w));
    *(uint2*)(BR + (size_t)(rowbase + t0 + tt) * 1024 + 768 + lane * 4) = ov;
  }
}


DEV bool tile_of(int t, int G, int N, int NT, int& mt, int& nt) {
  const int r = t / G, b = t - r * G;
  const int q = r * G + (b & 7) * (G >> 3) + (b >> 3);
  if (q >= N) return false;
  const int P = NT >> 3, wl = NT & 7, full = P * MT * 8;
  if (q < full) { const int panel = q / (MT * 8), rem = q - panel * MT * 8; mt = rem >> 3; nt = panel * 8 + (rem & 7); }
  else { const int q2 = q - full; mt = q2 / wl; nt = P * 8 + (q2 - mt * wl); }
  return true;
}
#define TILE_LOOP(NT_, CALL) do { const int N_ = MT * (NT_); const int Nr_ = ((N_ + G - 1) / G) * G; \
    for (int t = B; t < Nr_; t += G) { int mt, nt; if (tile_of(t, G, N_, (NT_), mt, nt)) { CALL; } } } while (0)
__global__ void __launch_bounds__(256, 2) mega(P p) {
  __shared__ __attribute__((aligned(16))) float smem[16128];
  __shared__ int s_item;
  cg::grid_group grid = cg::this_grid();
  u16* sA = (u16*)smem;
  u16* sB = sA + 128 * 72;
  const u16* W = (const u16*)(p.ws + OFF_W);
  const u16* XN = (const u16*)(p.ws + OFF_XN);
  float* X = (float*)(p.ws + OFF_X);
  u16* H = (u16*)(p.ws + OFF_D + D_H);
  u16* Zm = (u16*)(p.ws + OFF_D + D_ZM);
  const u16* M = (const u16*)(p.ws + OFF_D + D_M);
  int* ctr = (int*)p.ws;
  const int G = gridDim.x, B = blockIdx.x;

  for (int l = 0; l < 2; ++l) {
    phase_norm(p, l, 0);
    phase_convw(p, l, smem);
    grid.sync();
    TILE_LOOP(22, dual_tile256(XN, W + W_GU1, mt, nt, H, sA, sB));
    grid.sync();
    TILE_LOOP(8, resid_tile(H, 2816, 2816, W + W_DN1, mt, nt, X, 0.5f, sA, sB));
    grid.sync();
    phase_norm(p, l, 1, smem);
    grid.sync();
    TILE_LOOP(9, zm_tile256(XN, W + W_INM, mt, nt, Zm, sA, sB));
    grid.sync();
    for (;;) {
      __syncthreads();
      if (threadIdx.x == 0) s_item = atomicAdd(&ctr[l * 2], 1);
      __syncthreads();
      const int it = s_item;
      if (it >= 2856) break;
      int ll = l;
      asm volatile("" : "+s"(ll));
      if (it < 128) s5_prompt(p, ll, it >> 4, it & 15, smem);
      else if (it < 1696) delta_pre(p, ll, it - 128, smem);
      else if (it < 2216) { int i = it - 1696; lru_pass1(p, ll, i / 65, (i % 65) * 32, smem); }
      else if (it < 2344) lru_pass1(p, ll, 8 + (it - 2216), 0, smem);
      else { int i = it - 2344; s5_block(p, ll, 8 + (i >> 2), i & 3, smem); }
    }
    grid.sync();
    for (;;) {
      __syncthreads();
      if (threadIdx.x == 0) s_item = atomicAdd(&ctr[l * 2 + 1], 1);
      __syncthreads();
      const int it = s_item;
      if (it >= 1900) break;
      int ll = l;
      asm volatile("" : "+s"(ll));
      if (it < 32) delta_seq(p, ll, it >> 2, it & 3, smem);
      else if (it < 64) { int i = it - 32; lru_prompt(p, ll, i >> 2, i & 3, smem); }
      else if (it < 612) { int i = it - 64; dual_tile<1>((const u16*)(p.ws + OFF_D + D_Y5), 256, 256, W + W_GLU, i % MT, i / MT, (u16*)(p.ws + OFF_D + D_BR), 1024, 256, p.in[28] + ll * 512, sA, sB); }
      else if (it < 1124) { int i = it - 612; delta_seq(p, ll, 8 + (i >> 2), i & 3, smem); }
      else if (it < 1252) lru_pass2(p, ll, 8 + (it - 1124));
      else if (it < 1772) { int i = it - 1252; conv_item(p, ll, i / 65, (i % 65) * 32, smem); }
      else conv_item(p, ll, 8 + (it - 1772), 0, smem);
    }
    grid.sync();
    TILE_LOOP(16, g4_tile(p, mt, nt, sA, sB));
    grid.sync();
    TILE_LOOP(8, resid_tile(M, 1024, 1024, W + W_OUT, mt, nt, X, 1.0f, sA, sB));
    grid.sync();
    phase_norm(p, l, 2);
    grid.sync();
    TILE_LOOP(22, dual_tile256(XN, W + W_GU2, mt, nt, H, sA, sB));
    grid.sync();
    TILE_LOOP(8, resid_tile(H, 2816, 2816, W + W_DN2, mt, nt, X, 0.5f, sA, sB));
    grid.sync();
  }
  phase_norm(p, 0, 3);
}

extern "C" void kernel_launch(void* const* d_in, const int* in_sizes, int n_in, void* d_out, int out_size, void* d_ws,
                              size_t ws_size, hipStream_t stream) {
  P p{};
  for (int i = 0; i < 46; ++i) p.in[i] = (const float*)d_in[i];
  p.out = (float*)d_out;
  p.ws = (char*)d_ws;
  static int grid_blocks = 0;
  if (!grid_blocks) {
    int dev = 0, cus = 0, per = 0;
    hipGetDevice(&dev);
    hipDeviceGetAttribute(&cus, hipDeviceAttributeMultiprocessorCount, dev);
    hipOccupancyMaxActiveBlocksPerMultiprocessor(&per, mega, 256, 0);
    if (per > 2) per = 2;
    if (per < 1) per = 1;
    grid_blocks = cus * per;
  }
  if (ws_size < WS_NEED) fprintf(stderr, "workspace too small: %zu < %zu\n", ws_size, (size_t)WS_NEED);
  hipMemsetAsync(d_ws, 0, 256, stream);
  void* args[] = {&p};
  hipError_t e = hipLaunchCooperativeKernel((void*)mega, dim3(grid_blocks), dim3(256), args, 0, stream);
  if (e != hipSuccess) fprintf(stderr, "cooperative launch failed: %s (grid %d)\n", hipGetErrorString(e), grid_blocks);
}
```
